# Optimizing an MI355X kernel written in HIP

```python
import math
import jax
import jax.numpy as jnp
from jax import lax
import numpy as np

D_MODEL = 1024
BATCH = 16
SEQ = 2048
DEPTH = 1

GRID_W = 64
CTX_LEN = 256
D_GLA = 512
D_S5 = 512
GLA_HEADS = 4
GLA_DK_HEAD = 64
GLA_DV_HEAD = D_GLA // GLA_HEADS
GLA_DK = GLA_HEADS * GLA_DK_HEAD
GLA_DV = D_GLA
GLA_GATE_RANK = 16
GLA_GATE_TAU = 16.0
GLA_CHUNK = GRID_W
S5_GROUP_CH = 16
S5_GROUPS = D_S5 // S5_GROUP_CH
S5_STATE = 64
D_IN = 2 * GLA_DK + 2 * GLA_DV + 2 * GLA_GATE_RANK + D_S5
N_EXPERTS = 256
TOP_K = 8
N_EXPERT_GROUPS = 8
TOPK_GROUPS = 4
D_EXPERT = 256
D_SHARED = 256
ROUTE_SCALE = 2.5
MOE_BLOCK = 128
EPS = 1e-6

kernel_name = 'hybrid_gla_s5_moe_prefix_block'


def rmsnorm(x, g):
    xf = x.astype(jnp.float32)
    y = xf * lax.rsqrt(jnp.mean(xf * xf, axis=-1, keepdims=True) + EPS)
    return (y * g.astype(jnp.float32)).astype(x.dtype)


def adaln(cvec, w, b):
    mod = (jax.nn.silu(cvec) @ w + b)[..., None, :]
    return jnp.split(mod, 6, axis=-1)


def modulate(h, shift, scale):
    return h * (1.0 + scale) + shift


def split_heads(t, head_dim):
    b, l, _ = t.shape
    return t.reshape(b, l, -1, head_dim).transpose(0, 2, 1, 3)


def gla_log_gate(lr, w, b):
    return jax.nn.log_sigmoid((lr @ w + b).astype(jnp.float32)) / GLA_GATE_TAU


def gla_chunked(q, k, v, log_a, s0):
    bsz, nh, seq, dk = q.shape
    dv = v.shape[-1]
    n_chunks = seq // GLA_CHUNK
    cshape = (bsz, nh, n_chunks, GLA_CHUNK)
    cum = jnp.cumsum(log_a.reshape(cshape + (dk,)), axis=3)
    cum_last = cum[:, :, :, -1:, :]
    qc = q.reshape(cshape + (dk,)) * jnp.exp(cum)
    kc = k.reshape(cshape + (dk,))
    k_intra = kc * jnp.exp(-cum)
    k_state = kc * jnp.exp(cum_last - cum)
    vc = v.reshape(cshape + (dv,))
    tri = jnp.tril(jnp.ones((GLA_CHUNK, GLA_CHUNK), dtype=bool))
    scores = jnp.where(tri, jnp.einsum('bhncd,bhnsd->bhncs', qc, k_intra), 0.0)
    o_intra = jnp.einsum('bhncs,bhnsv->bhncv', scores, vc)
    decay = jnp.exp(cum_last[:, :, :, 0, :])

    def step(state, inp):
        q_n, k_n, v_n, d_n = inp
        o_n = jnp.einsum('bhcd,bhdv->bhcv', q_n, state)
        state = d_n[..., None] * state + jnp.einsum('bhcd,bhcv->bhdv', k_n, v_n)
        return state, o_n

    xs = tuple(jnp.moveaxis(t, 2, 0) for t in (qc, k_state, vc, decay))
    s_fin, o_inter = lax.scan(step, s0, xs)
    o = o_intra + jnp.moveaxis(o_inter, 0, 2)
    return o.reshape(bsz, nh, seq, dv), s_fin


def s5_discretize(lam_re, lam_im, log_step, b_re, b_im):
    lam_re = lam_re.astype(jnp.float32)
    lam_im = lam_im.astype(jnp.float32)
    step = jnp.exp(log_step.astype(jnp.float32))[:, None]
    mag = jnp.exp(lam_re * step)
    a_re = mag * jnp.cos(lam_im * step)
    a_im = mag * jnp.sin(lam_im * step)
    den = lam_re * lam_re + lam_im * lam_im
    f_re = ((a_re - 1.0) * lam_re + a_im * lam_im) / den
    f_im = (a_im * lam_re - (a_re - 1.0) * lam_im) / den
    b_re = b_re.astype(jnp.float32)
    b_im = b_im.astype(jnp.float32)
    bb_re = f_re[..., None] * b_re - f_im[..., None] * b_im
    bb_im = f_re[..., None] * b_im + f_im[..., None] * b_re
    return (a_re, a_im), (bb_re, bb_im)


def s5_scan(abar, bbar, u_g, x0, reverse):
    a_re, a_im = abar
    u32 = u_g.astype(jnp.float32)
    bu_re = jnp.einsum('blgh,gph->blgp', u32, bbar[0])
    bu_im = jnp.einsum('blgh,gph->blgp', u32, bbar[1])
    if x0 is not None:
        x0_re, x0_im = x0
        pos = -1 if reverse else 0
        bu_re = bu_re.at[:, pos].add(a_re * x0_re - a_im * x0_im)
        bu_im = bu_im.at[:, pos].add(a_re * x0_im + a_im * x0_re)
    seq = bu_re.shape[1]
    ar = jnp.broadcast_to(a_re, (1, seq) + a_re.shape)
    ai = jnp.broadcast_to(a_im, (1, seq) + a_im.shape)

    def combine(earlier, later):
        ar1, ai1, br1, bi1 = earlier
        ar2, ai2, br2, bi2 = later
        return (ar2 * ar1 - ai2 * ai1,
                ar2 * ai1 + ai2 * ar1,
                ar2 * br1 - ai2 * bi1 + br2,
                ar2 * bi1 + ai2 * br1 + bi2)

    _, _, x_re, x_im = lax.associative_scan(combine, (ar, ai, bu_re, bu_im), reverse=reverse, axis=1)
    return x_re, x_im


def s5_readout(xs, c_re, c_im):
    x_re, x_im = xs
    return (jnp.einsum('blgp,ghp->blgh', x_re, c_re.astype(jnp.float32))
            - jnp.einsum('blgp,ghp->blgh', x_im, c_im.astype(jnp.float32)))


def stream_mix(proj, lp, init_states, with_output):
    bsz = proj.shape[0]
    o1 = GLA_DK
    o2 = o1 + GLA_DK
    o3 = o2 + GLA_DV
    o4 = o3 + GLA_DV
    o5 = o4 + GLA_GATE_RANK
    o6 = o5 + GLA_GATE_RANK
    q, k, v, g_out, lr_f, lr_b, u = jnp.split(proj, [o1, o2, o3, o4, o5, o6], axis=-1)
    q = split_heads(q, GLA_DK_HEAD) * (GLA_DK_HEAD ** -0.5)
    k = split_heads(k, GLA_DK_HEAD)
    v = split_heads(v, GLA_DV_HEAD)
    la_f = split_heads(gla_log_gate(lr_f, lp['gla_wa_f'], lp['gla_ba_f']), GLA_DK_HEAD)
    la_b = split_heads(gla_log_gate(lr_b, lp['gla_wa_b'], lp['gla_ba_b']), GLA_DK_HEAD)
    if init_states is None:
        zero = jnp.zeros((bsz, GLA_HEADS, GLA_DK_HEAD, GLA_DV_HEAD), jnp.float32)
        gla_s0_f, gla_s0_b, s5_x0_f, s5_x0_b = zero, zero, None, None
    else:
        gla_s0_f, gla_s0_b, s5_x0_f, s5_x0_b = init_states
    o_f, gla_sf = gla_chunked(q, k, v, la_f, gla_s0_f)
    o_b, gla_sb = gla_chunked(jnp.flip(q, 2), jnp.flip(k, 2), jnp.flip(v, 2), jnp.flip(la_b, 2), gla_s0_b)
    u_g = u.reshape(bsz, -1, S5_GROUPS, S5_GROUP_CH)
    abar_f, bbar_f = s5_discretize(lp['s5_lam_re_f'], lp['s5_lam_im_f'], lp['s5_log_step_f'], lp['s5_b_re'], lp['s5_b_im'])
    abar_b, bbar_b = s5_discretize(lp['s5_lam_re_b'], lp['s5_lam_im_b'], lp['s5_log_step_b'], lp['s5_b_re'], lp['s5_b_im'])
    x_f = s5_scan(abar_f, bbar_f, u_g, s5_x0_f, False)
    x_b = s5_scan(abar_b, bbar_b, u_g, s5_x0_b, True)
    states = (gla_sf, gla_sb, (x_f[0][:, -1], x_f[1][:, -1]), (x_b[0][:, 0], x_b[1][:, 0]))
    if not with_output:
        return None, states
    o = rmsnorm(o_f + jnp.flip(o_b, 2), lp['gla_norm_g'])
    o = o.transpose(0, 2, 1, 3).reshape(bsz, -1, GLA_DV)
    gla_out = o * jax.nn.silu(g_out.astype(jnp.float32))
    y = s5_readout(x_f, lp['s5_c_re_f'], lp['s5_c_im_f']) + s5_readout(x_b, lp['s5_c_re_b'], lp['s5_c_im_b'])
    y = y.reshape(bsz, -1, D_S5) + lp['s5_d'] * u
    z = jax.nn.gelu(y)
    s5_out = z * jax.nn.sigmoid(z @ lp['s5_glu_w'] + lp['s5_glu_b'])
    return jnp.concatenate([gla_out, s5_out], axis=-1).astype(proj.dtype), states


def moe_ffn(h, router_w, router_b, w_gate, w_up, w_down, sh_gate, sh_up, sh_down):
    shp = h.shape
    t = h.reshape(-1, shp[-1])
    n_tok = t.shape[0]
    scores = jax.nn.sigmoid((t @ router_w).astype(jnp.float32))
    biased = scores + router_b.astype(jnp.float32)
    grp = biased.reshape(n_tok, N_EXPERT_GROUPS, N_EXPERTS // N_EXPERT_GROUPS)
    grp_score = lax.top_k(grp, 2)[0].sum(-1)
    _, top_grp = lax.top_k(grp_score, TOPK_GROUPS)
    grp_mask = jax.nn.one_hot(top_grp, N_EXPERT_GROUPS, dtype=jnp.float32).sum(1) > 0
    exp_mask = jnp.repeat(grp_mask, N_EXPERTS // N_EXPERT_GROUPS, axis=1)
    _, top_e = lax.top_k(jnp.where(exp_mask, biased, -jnp.inf), TOP_K)
    wts = jnp.take_along_axis(scores, top_e, axis=1)
    wts = wts / jnp.sum(wts, axis=-1, keepdims=True) * ROUTE_SCALE
    n_assign = n_tok * TOP_K
    flat_e = top_e.reshape(-1)
    order = jnp.argsort(flat_e)
    sorted_e = flat_e[order]
    counts = jnp.bincount(flat_e, length=N_EXPERTS)
    padded = (counts + MOE_BLOCK - 1) // MOE_BLOCK * MOE_BLOCK
    padded_end = jnp.cumsum(padded)
    padded_start = padded_end - padded
    start = jnp.cumsum(counts) - counts
    dest = padded_start[sorted_e] + jnp.arange(n_assign, dtype=jnp.int32) - start[sorted_e]
    n_rows = -(-(n_assign + N_EXPERTS * (MOE_BLOCK - 1)) // MOE_BLOCK) * MOE_BLOCK
    n_blocks = n_rows // MOE_BLOCK
    row_tok = jnp.zeros((n_rows,), jnp.int32).at[dest].set((order // TOP_K).astype(jnp.int32))
    row_w = jnp.zeros((n_rows,), jnp.float32).at[dest].set(wts.reshape(-1)[order])
    blk_e = jnp.minimum(jnp.searchsorted(padded_end, jnp.arange(n_blocks, dtype=jnp.int32) * MOE_BLOCK, side='right'), N_EXPERTS - 1)

    def body(acc, blk):
        tok, w, e = blk
        xb = t[tok]
        hid = jax.nn.silu(xb @ w_gate[e]) * (xb @ w_up[e])
        yb = (hid @ w_down[e]) * w[:, None]
        return acc.at[tok].add(yb.astype(acc.dtype)), None

    routed, _ = lax.scan(body, jnp.zeros_like(t),
                         (row_tok.reshape(n_blocks, MOE_BLOCK), row_w.reshape(n_blocks, MOE_BLOCK), blk_e))
    shared = (jax.nn.silu(t @ sh_gate) * (t @ sh_up)) @ sh_down
    return (routed + shared).reshape(shp)


def setup_inputs(seed: int = 0) -> dict:
    key = jax.random.key(seed)
    ks = iter(jax.random.split(key, 64))

    def nrm(shape, scale):
        return jax.random.normal(next(ks), shape, jnp.float32) * scale

    def gain(shape):
        return 1.0 + 0.02 * jax.random.normal(next(ks), shape, jnp.float32)

    lam_im_base = jnp.pi * jnp.arange(S5_STATE, dtype=jnp.float32)
    log_lo, log_hi = math.log(1e-3), math.log(1e-1)
    return {
        'x': nrm((BATCH, SEQ, D_MODEL), 1.0),
        'c': nrm((BATCH, D_MODEL), 1.0),
        'ctx': nrm((BATCH, CTX_LEN, D_MODEL), 1.0),
        'c_ctx': nrm((D_MODEL,), 1.0),
        'ada_w': nrm((DEPTH, D_MODEL, 6 * D_MODEL), 0.5 * D_MODEL ** -0.5),
        'ada_b': nrm((DEPTH, 6 * D_MODEL), 0.02),
        'norm1_g': gain((DEPTH, D_MODEL)),
        'norm2_g': gain((DEPTH, D_MODEL)),
        'w_in': nrm((DEPTH, D_MODEL, D_IN), D_MODEL ** -0.5),
        'gla_wa_f': nrm((DEPTH, GLA_GATE_RANK, GLA_DK), GLA_GATE_RANK ** -0.5),
        'gla_ba_f': nrm((DEPTH, GLA_DK), 0.1),
        'gla_wa_b': nrm((DEPTH, GLA_GATE_RANK, GLA_DK), GLA_GATE_RANK ** -0.5),
        'gla_ba_b': nrm((DEPTH, GLA_DK), 0.1),
        'gla_norm_g': gain((DEPTH, GLA_DV_HEAD)),
        's5_lam_re_f': -0.5 + nrm((DEPTH, S5_GROUPS, S5_STATE), 0.01),
        's5_lam_im_f': lam_im_base + nrm((DEPTH, S5_GROUPS, S5_STATE), 0.01),
        's5_log_step_f': jax.random.uniform(next(ks), (DEPTH, S5_GROUPS), jnp.float32, log_lo, log_hi),
        's5_lam_re_b': -0.5 + nrm((DEPTH, S5_GROUPS, S5_STATE), 0.01),
        's5_lam_im_b': lam_im_base + nrm((DEPTH, S5_GROUPS, S5_STATE), 0.01),
        's5_log_step_b': jax.random.uniform(next(ks), (DEPTH, S5_GROUPS), jnp.float32, log_lo, log_hi),
        's5_b_re': nrm((DEPTH, S5_GROUPS, S5_STATE, S5_GROUP_CH), (2.0 * S5_GROUP_CH) ** -0.5),
        's5_b_im': nrm((DEPTH, S5_GROUPS, S5_STATE, S5_GROUP_CH), (2.0 * S5_GROUP_CH) ** -0.5),
        's5_c_re_f': nrm((DEPTH, S5_GROUPS, S5_GROUP_CH, S5_STATE), (2.0 * S5_STATE) ** -0.5),
        's5_c_im_f': nrm((DEPTH, S5_GROUPS, S5_GROUP_CH, S5_STATE), (2.0 * S5_STATE) ** -0.5),
        's5_c_re_b': nrm((DEPTH, S5_GROUPS, S5_GROUP_CH, S5_STATE), (2.0 * S5_STATE) ** -0.5),
        's5_c_im_b': nrm((DEPTH, S5_GROUPS, S5_GROUP_CH, S5_STATE), (2.0 * S5_STATE) ** -0.5),
        's5_d': nrm((DEPTH, D_S5), 1.0),
        's5_glu_w': nrm((DEPTH, D_S5, D_S5), D_S5 ** -0.5),
        's5_glu_b': nrm((DEPTH, D_S5), 0.02),
        'w_out': nrm((DEPTH, D_MODEL, D_MODEL), D_MODEL ** -0.5),
        'router_w': nrm((DEPTH, D_MODEL, N_EXPERTS), D_MODEL ** -0.5),
        'router_b': nrm((DEPTH, N_EXPERTS), 0.01),
        'exp_w_gate': nrm((DEPTH, N_EXPERTS, D_MODEL, D_EXPERT), D_MODEL ** -0.5),
        'exp_w_up': nrm((DEPTH, N_EXPERTS, D_MODEL, D_EXPERT), D_MODEL ** -0.5),
        'exp_w_down': nrm((DEPTH, N_EXPERTS, D_EXPERT, D_MODEL), D_EXPERT ** -0.5),
        'sh_w_gate': nrm((DEPTH, D_MODEL, D_SHARED), D_MODEL ** -0.5),
        'sh_w_up': nrm((DEPTH, D_MODEL, D_SHARED), D_MODEL ** -0.5),
        'sh_w_down': nrm((DEPTH, D_SHARED, D_MODEL), D_SHARED ** -0.5),
        'final_norm_g': gain((D_MODEL,)),
    }


def reference(x, c, ctx, c_ctx, ada_w, ada_b, norm1_g, norm2_g, w_in,
              gla_wa_f, gla_ba_f, gla_wa_b, gla_ba_b, gla_norm_g,
              s5_lam_re_f, s5_lam_im_f, s5_log_step_f, s5_lam_re_b, s5_lam_im_b, s5_log_step_b,
              s5_b_re, s5_b_im, s5_c_re_f, s5_c_im_f, s5_c_re_b, s5_c_im_b, s5_d, s5_glu_w, s5_glu_b,
              w_out, router_w, router_b, exp_w_gate, exp_w_up, exp_w_down,
              sh_w_gate, sh_w_up, sh_w_down, final_norm_g):
    h_ctx = ctx
    for i in range(DEPTH):
        lp = {
            'gla_wa_f': gla_wa_f[i], 'gla_ba_f': gla_ba_f[i],
            'gla_wa_b': gla_wa_b[i], 'gla_ba_b': gla_ba_b[i], 'gla_norm_g': gla_norm_g[i],
            's5_lam_re_f': s5_lam_re_f[i], 's5_lam_im_f': s5_lam_im_f[i], 's5_log_step_f': s5_log_step_f[i],
            's5_lam_re_b': s5_lam_re_b[i], 's5_lam_im_b': s5_lam_im_b[i], 's5_log_step_b': s5_log_step_b[i],
            's5_b_re': s5_b_re[i], 's5_b_im': s5_b_im[i],
            's5_c_re_f': s5_c_re_f[i], 's5_c_im_f': s5_c_im_f[i],
            's5_c_re_b': s5_c_re_b[i], 's5_c_im_b': s5_c_im_b[i],
            's5_d': s5_d[i], 's5_glu_w': s5_glu_w[i], 's5_glu_b': s5_glu_b[i],
        }
        last = i + 1 == DEPTH
        sh1, sc1, g1, sh2, sc2, g2 = adaln(c, ada_w[i], ada_b[i])
        csh1, csc1, cg1, csh2, csc2, cg2 = adaln(c_ctx, ada_w[i], ada_b[i])
        hc = modulate(rmsnorm(h_ctx, norm1_g[i]), csh1, csc1)
        mix_c, ctx_states = stream_mix(hc @ w_in[i], lp, None, not last)
        hx = modulate(rmsnorm(x, norm1_g[i]), sh1, sc1)
        mix_x, _ = stream_mix(hx @ w_in[i], lp, ctx_states, True)
        x = x + g1 * (mix_x @ w_out[i])
        hx2 = modulate(rmsnorm(x, norm2_g[i]), sh2, sc2)
        x = x + g2 * moe_ffn(hx2, router_w[i], router_b[i], exp_w_gate[i], exp_w_up[i], exp_w_down[i],
                             sh_w_gate[i], sh_w_up[i], sh_w_down[i])
        if not last:
            h_ctx = h_ctx + cg1 * (mix_c @ w_out[i])
            hc2 = modulate(rmsnorm(h_ctx, norm2_g[i]), csh2, csc2)
            h_ctx = h_ctx + cg2 * moe_ffn(hc2, router_w[i], router_b[i], exp_w_gate[i], exp_w_up[i], exp_w_down[i],
                                          sh_w_gate[i], sh_w_up[i], sh_w_down[i])
    return rmsnorm(x, final_norm_g)
```

```cpp
#include <hip/hip_runtime.h>
#include <stdint.h>
#include <stdio.h>

#define DM 1024
#define NB 16
#define SEQ 2048
#define CTX 256
#define NL (NB * SEQ)
#define NCX (NB * CTX)
#define NR (NL + NCX)
#define DIN 2080
#define O_Q 0
#define O_K 256
#define O_V 512
#define O_G 1024
#define O_LRF 1536
#define O_LRB 1552
#define O_U 1568
#define NE 256
#define TOPK 8
#define CAP 32768
#define EPS 1e-6f

#define NT 256
#define LDS_BYTES (72 * 1024)
#define N_PHASES 13
#ifndef FUSED
#define FUSED 0
#endif

#define XB_TMO      128
#define XB_XCNT(j)  (256  + 64 * (j))
#define XB_XSUB(j)  (1280 + 64 * (j))
#define XB_XGEN(j)  (2304 + 64 * (j))
#define XB_TOP      3328
#define XB_TOPGEN   3392
#define XCD_BAR_WORDS 3456
#define XB_SPIN_CAP (1u << 18)
#define LAS __attribute__((address_space(3)))

__device__ __forceinline__ unsigned xb_ld(unsigned* p)              { return __hip_atomic_load(p, __ATOMIC_RELAXED, __HIP_MEMORY_SCOPE_AGENT); }
__device__ __forceinline__ unsigned xb_add(unsigned* p, unsigned v) { return __hip_atomic_fetch_add(p, v, __ATOMIC_RELAXED, __HIP_MEMORY_SCOPE_AGENT); }
__device__ __forceinline__ unsigned xb_xcc_id() { return (unsigned)__builtin_amdgcn_s_getreg((3 << 11) | 20) & 0xFu; }
#define XB_SPIN(cond, bar) do { unsigned _sp = 0; while (cond) { __builtin_amdgcn_s_sleep(1); \
    if ((++_sp & 255u) == 0u) { if (xb_ld(&(bar)[XB_TMO])) break; if (_sp > XB_SPIN_CAP) { atomicAdd(&(bar)[XB_TMO], 1u); break; } } } } while (0)

struct XcdBarrier { unsigned* bar; unsigned x; volatile LAS unsigned* st; };

__device__ __forceinline__ XcdBarrier xcd_barrier_post(unsigned* bar, volatile LAS unsigned* st) {
    XcdBarrier b; b.bar = bar; b.x = xb_xcc_id(); b.st = st;
    if (threadIdx.x == 0) (void)xb_add(&bar[XB_XCNT(b.x)], 1u);
    return b;
}
__device__ __forceinline__ void xcd_barrier_complete(unsigned* bar, unsigned x, unsigned& nloc, unsigned& nx) {
    const unsigned G = gridDim.x * gridDim.y * gridDim.z;
    unsigned sum, cnt, mine, sp = 0u;
    for (;;) {
        sum = 0u; cnt = 0u; mine = 0u;
#pragma unroll
        for (unsigned j = 0; j < 16; ++j) { const unsigned c = xb_ld(&bar[XB_XCNT(j)]); sum += c; cnt += (c > 0u) ? 1u : 0u; mine = (j == x) ? c : mine; }
        if (sum == G) break;
        __builtin_amdgcn_s_sleep(1);
        if ((++sp & 255u) == 0u) { if (xb_ld(&bar[XB_TMO])) break; if (sp > XB_SPIN_CAP) { atomicAdd(&bar[XB_TMO], 1u); break; } }
    }
    nloc = mine > 0u ? mine : 1u; nx = cnt > 0u ? cnt : 1u;
}
__device__ __forceinline__ void xcd_barrier(const XcdBarrier& b) {
    asm volatile("s_waitcnt vmcnt(0)" ::: "memory");
    __syncthreads();
    if (threadIdx.x == 0) {
        unsigned* bar = b.bar;
        __builtin_amdgcn_s_waitcnt(0);
        unsigned nloc = b.st[0], nx = b.st[1];
        if (nloc == 0u) { xcd_barrier_complete(bar, b.x, nloc, nx); b.st[0] = nloc; b.st[1] = nx; }
        const unsigned old = xb_add(&bar[XB_XSUB(b.x)], 1u);
        const unsigned gen = old / nloc;
        if (old + 1u == (gen + 1u) * nloc) {
            __builtin_amdgcn_fence(__ATOMIC_RELEASE, "agent");
            asm volatile("s_waitcnt vmcnt(0)" ::: "memory");
            const unsigned og = xb_add(&bar[XB_TOP], 1u);
            const unsigned tg = og / nx;
            if (og + 1u == (tg + 1u) * nx) xb_add(&bar[XB_TOPGEN], 1u);
            else XB_SPIN(xb_ld(&bar[XB_TOPGEN]) == tg, bar);
            __builtin_amdgcn_fence(__ATOMIC_ACQUIRE, "agent");
            xb_add(&bar[XB_XGEN(b.x)], 1u);
            asm volatile("s_waitcnt vmcnt(0)" ::: "memory");
        } else {
            XB_SPIN(xb_ld(&bar[XB_XGEN(b.x)]) == gen, bar);
            __builtin_amdgcn_fence(__ATOMIC_ACQUIRE, "agent");
            asm volatile("s_waitcnt vmcnt(0)" ::: "memory");
        }
    }
    __syncthreads();
}

struct Params {
    const float *x, *c, *ctx, *c_ctx, *ada_w, *ada_b, *norm1_g, *norm2_g, *w_in,
        *wa_f, *ba_f, *wa_b, *ba_b, *gnorm_g,
        *lam_re_f, *lam_im_f, *lstep_f, *lam_re_b, *lam_im_b, *lstep_b,
        *b_re, *b_im, *c_re_f, *c_im_f, *c_re_b, *c_im_b, *s5_d, *glu_w, *glu_b,
        *w_out, *router_w, *router_b, *ew_gate, *ew_up, *ew_down, *sw_gate, *sw_up, *sw_down, *fnorm_g;
    float* out;
    unsigned* bar;
    int* cnt;
    float* modv;
    float* hx;
    float* proj;
    float* of;
    float* yf;
    float* mix;
    float* z;
    int* ltok;
    float* lw;
    int ph_lo, ph_hi;
};

__device__ __forceinline__ float sigmoidf_(float v) { return 1.0f / (1.0f + expf(-v)); }
__device__ __forceinline__ float siluf_(float v) { return v / (1.0f + expf(-v)); }
__device__ __forceinline__ float logsigmoidf_(float v) { return fminf(v, 0.0f) - log1pf(expf(-fabsf(v))); }
__device__ __forceinline__ float gelu_tanhf_(float v) { return 0.5f * v * (1.0f + tanhf(0.7978845608028654f * (v + 0.044715f * v * v * v))); }
__device__ __forceinline__ float wave_sum(float v) {
#pragma unroll
    for (int o = 32; o > 0; o >>= 1) v += __shfl_xor(v, o);
    return v;
}

template <bool DUAL, class AF, class EF>
__device__ __forceinline__ void gemm64(float* lds, int m0, int n0, int M, int N, int K, AF arow,
                                       const float* __restrict__ B0, const float* __restrict__ B1, int ldb, EF epi) {
    float* As = lds;
    float* Bs0 = lds + 16 * 68;
    float* Bs1 = Bs0 + 16 * 64;
    const int tid = threadIdx.x;
    const int ty = tid >> 4, tx = tid & 15;
    float acc0[4][4], acc1[4][4];
#pragma unroll
    for (int i = 0; i < 4; ++i)
#pragma unroll
        for (int j = 0; j < 4; ++j) { acc0[i][j] = 0.f; acc1[i][j] = 0.f; }
    const int am = tid >> 2, ak = (tid & 3) * 4;
    const int bk = tid >> 4, bn = (tid & 15) * 4;
    const float* ap = (m0 + am < M) ? arow(m0 + am) : nullptr;
    const bool bok = (n0 + bn) < N;
    for (int k0 = 0; k0 < K; k0 += 16) {
        float4 av = ap ? *(const float4*)(ap + k0 + ak) : make_float4(0.f, 0.f, 0.f, 0.f);
        float4 bv0 = bok ? *(const float4*)(B0 + (size_t)(k0 + bk) * ldb + n0 + bn) : make_float4(0.f, 0.f, 0.f, 0.f);
        float4 bv1 = make_float4(0.f, 0.f, 0.f, 0.f);
        if (DUAL) bv1 = bok ? *(const float4*)(B1 + (size_t)(k0 + bk) * ldb + n0 + bn) : make_float4(0.f, 0.f, 0.f, 0.f);
        __syncthreads();
        As[(ak + 0) * 68 + am] = av.x; As[(ak + 1) * 68 + am] = av.y; As[(ak + 2) * 68 + am] = av.z; As[(ak + 3) * 68 + am] = av.w;
        *(float4*)&Bs0[bk * 64 + bn] = bv0;
        if (DUAL) *(float4*)&Bs1[bk * 64 + bn] = bv1;
        __syncthreads();
#pragma unroll
        for (int kk = 0; kk < 16; ++kk) {
            const float4 a = *(const float4*)&As[kk * 68 + ty * 4];
            const float4 b = *(const float4*)&Bs0[kk * 64 + tx * 4];
            const float aa[4] = {a.x, a.y, a.z, a.w};
            const float bb[4] = {b.x, b.y, b.z, b.w};
#pragma unroll
            for (int i = 0; i < 4; ++i)
#pragma unroll
                for (int j = 0; j < 4; ++j) acc0[i][j] = fmaf(aa[i], bb[j], acc0[i][j]);
            if (DUAL) {
                const float4 b1 = *(const float4*)&Bs1[kk * 64 + tx * 4];
                const float bb1[4] = {b1.x, b1.y, b1.z, b1.w};
#pragma unroll
                for (int i = 0; i < 4; ++i)
#pragma unroll
                    for (int j = 0; j < 4; ++j) acc1[i][j] = fmaf(aa[i], bb1[j], acc1[i][j]);
            }
        }
    }
#pragma unroll
    for (int i = 0; i < 4; ++i)
#pragma unroll
        for (int j = 0; j < 4; ++j) {
            const int m = m0 + ty * 4 + i, n = n0 + tx * 4 + j;
            if (m < M && n < N) epi(m, n, acc0[i][j], acc1[i][j]);
        }
    __syncthreads();
}

template <bool DUAL, class AF, class EF>
__device__ __forceinline__ void gemm_dense(float* lds, int u0, int ustride, int M, int N, int K, AF arow,
                                           const float* B0, const float* B1, int ldb, EF epi) {
    const int tn = (N + 63) / 64, tm = (M + 63) / 64;
    for (int u = u0; u < tm * tn; u += ustride) {
        const int im = u / tn, in_ = u % tn;
        gemm64<DUAL>(lds, im * 64, in_ * 64, M, N, K, arow, B0, B1, ldb, epi);
    }
}

__device__ void phase_modv(const Params& p, float* lds) {
    const int tid = threadIdx.x;
    for (int i = tid; i < 17 * 1024; i += NT) {
        const int b = i >> 10, k = i & 1023;
        const float v = (b < 16) ? p.c[b * 1024 + k] : p.c_ctx[k];
        lds[i] = siluf_(v);
    }
    __syncthreads();
    float* red = lds + 17 * 1024;
    const int col_l = tid & 31, kg = tid >> 5;
    for (int u = blockIdx.x; u < 6144 / 32; u += gridDim.x) {
        const int col = u * 32 + col_l;
        float acc[17];
#pragma unroll
        for (int b = 0; b < 17; ++b) acc[b] = 0.f;
        for (int k = kg * 128; k < kg * 128 + 128; ++k) {
            const float w = p.ada_w[(size_t)k * 6144 + col];
#pragma unroll
            for (int b = 0; b < 17; ++b) acc[b] = fmaf(lds[b * 1024 + k], w, acc[b]);
        }
#pragma unroll
        for (int b = 0; b < 17; ++b) {
            __syncthreads();
            red[kg * 32 + col_l] = acc[b];
            __syncthreads();
            if (kg == 0) {
                float s = 0.f;
#pragma unroll
                for (int g = 0; g < 8; ++g) s += red[g * 32 + col_l];
                p.modv[b * 6144 + col] = s + p.ada_b[col];
            }
        }
    }
    __syncthreads();
}

__device__ void phase_norm_mod(const Params& p, int which) {
    const int lane = threadIdx.x & 63, wave = threadIdx.x >> 6;
    const int nrows = which == 0 ? NR : NL;
    const float* g = which == 0 ? p.norm1_g : p.norm2_g;
    const int osh = which == 0 ? 0 : 3072, osc = which == 0 ? 1024 : 4096;
    for (int r = blockIdx.x * 4 + wave; r < nrows; r += gridDim.x * 4) {
        const float* src; int b;
        if (which == 0) {
            if (r < NL) { src = p.x + (size_t)r * DM; b = r / SEQ; } else { src = p.ctx + (size_t)(r - NL) * DM; b = 16; }
        } else { src = p.of + (size_t)r * DM; b = r / SEQ; }
        float4 v[4]; float ss = 0.f;
#pragma unroll
        for (int i = 0; i < 4; ++i) { v[i] = *(const float4*)(src + i * 256 + lane * 4); ss += v[i].x * v[i].x + v[i].y * v[i].y + v[i].z * v[i].z + v[i].w * v[i].w; }
        ss = wave_sum(ss);
        const float rstd = rsqrtf(ss * (1.0f / DM) + EPS);
        float* dst = p.hx + (size_t)r * DM;
        const float* mv = p.modv + b * 6144;
#pragma unroll
        for (int i = 0; i < 4; ++i) {
            const int col = i * 256 + lane * 4;
            const float4 gg = *(const float4*)(g + col), sh = *(const float4*)(mv + osh + col), sc = *(const float4*)(mv + osc + col);
            float4 o;
            o.x = v[i].x * rstd * gg.x * (1.f + sc.x) + sh.x; o.y = v[i].y * rstd * gg.y * (1.f + sc.y) + sh.y;
            o.z = v[i].z * rstd * gg.z * (1.f + sc.z) + sh.z; o.w = v[i].w * rstd * gg.w * (1.f + sc.w) + sh.w;
            *(float4*)(dst + col) = o;
        }
    }
}

__device__ __forceinline__ int scan_row(int b, int dir, int s, bool& lat) {
    if (s < CTX) { lat = false; const int t = dir ? (CTX - 1 - s) : s; return NL + b * CTX + t; }
    lat = true; const int t = dir ? (SEQ - 1 - (s - CTX)) : (s - CTX); return b * SEQ + t;
}

__device__ void gla_naive(const Params& p, int unit, float* lds) {
    const int dir = unit & 1, h = (unit >> 1) & 3, b = unit >> 3;
    const int tid = threadIdx.x;
    const float* wa = dir ? p.wa_b : p.wa_f;
    const float* ba = dir ? p.ba_b : p.ba_f;
    float war[16]; float bar_ = 0.f;
    if (tid < 64) {
#pragma unroll
        for (int j = 0; j < 16; ++j) war[j] = wa[j * 256 + h * 64 + tid];
        bar_ = ba[h * 64 + tid];
    } else {
#pragma unroll
        for (int j = 0; j < 16; ++j) war[j] = 0.f;
    }
    float S[64];
#pragma unroll
    for (int d = 0; d < 64; ++d) S[d] = 0.f;
    __syncthreads();
    for (int s = 0; s < CTX + SEQ; ++s) {
        bool lat; const int row = scan_row(b, dir, s, lat);
        const float* pr = p.proj + (size_t)row * DIN;
        float* buf = lds + (s & 1) * 192;
        if (tid < 64) {
            const float q = pr[O_Q + h * 64 + tid] * 0.125f, k = pr[O_K + h * 64 + tid];
            float zz = bar_;
#pragma unroll
            for (int j = 0; j < 16; ++j) zz = fmaf(pr[O_LRF + dir * 16 + j], war[j], zz);
            const float a = expf(logsigmoidf_(zz) * (1.0f / 16.0f));
            buf[tid] = q; buf[64 + tid] = k; buf[128 + tid] = a;
        }
        float v = 0.f;
        if (tid < 128) v = pr[O_V + h * 128 + tid];
        __syncthreads();
        if (tid < 128) {
            float o = 0.f;
#pragma unroll
            for (int d = 0; d < 64; ++d) {
                S[d] = fmaf(buf[128 + d], S[d], buf[64 + d] * v);
                o = fmaf(buf[d], S[d], o);
            }
            if (lat) p.of[((size_t)dir * NL + row) * 512 + h * 128 + tid] = o;
        }
    }
    __syncthreads();
}

__device__ void s5_naive(const Params& p, int unit) {
    const int lane = threadIdx.x & 63;
    const int dir = unit & 1, g = (unit >> 1) & 31, b = unit >> 6;
    const float* lre = dir ? p.lam_re_b : p.lam_re_f;
    const float* lim = dir ? p.lam_im_b : p.lam_im_f;
    const float* lst = dir ? p.lstep_b : p.lstep_f;
    const float* cre = dir ? p.c_re_b : p.c_re_f;
    const float* cim = dir ? p.c_im_b : p.c_im_f;
    const float lam_re = lre[g * 64 + lane], lam_im = lim[g * 64 + lane];
    const float step = expf(lst[g]);
    const float mag = expf(lam_re * step);
    const float a_re = mag * cosf(lam_im * step), a_im = mag * sinf(lam_im * step);
    const float den = lam_re * lam_re + lam_im * lam_im;
    const float f_re = ((a_re - 1.0f) * lam_re + a_im * lam_im) / den;
    const float f_im = (a_im * lam_re - (a_re - 1.0f) * lam_im) / den;
    float bbr[16], bbi[16], cr[16], ci[16];
#pragma unroll
    for (int h = 0; h < 16; ++h) {
        const float br = p.b_re[(g * 64 + lane) * 16 + h], bi = p.b_im[(g * 64 + lane) * 16 + h];
        bbr[h] = f_re * br - f_im * bi; bbi[h] = f_re * bi + f_im * br;
        cr[h] = cre[(g * 16 + h) * 64 + lane]; ci[h] = cim[(g * 16 + h) * 64 + lane];
    }
    float xr = 0.f, xi = 0.f;
    for (int s = 0; s < CTX + SEQ; ++s) {
        bool lat; const int row = scan_row(b, dir, s, lat);
        const float* pu = p.proj + (size_t)row * DIN + O_U + g * 16;
        float u[16];
#pragma unroll
        for (int i = 0; i < 4; ++i) { const float4 t4 = *(const float4*)(pu + i * 4); u[i * 4] = t4.x; u[i * 4 + 1] = t4.y; u[i * 4 + 2] = t4.z; u[i * 4 + 3] = t4.w; }
        float bur = 0.f, bui = 0.f;
#pragma unroll
        for (int h = 0; h < 16; ++h) { bur = fmaf(bbr[h], u[h], bur); bui = fmaf(bbi[h], u[h], bui); }
        const float nxr = a_re * xr - a_im * xi + bur;
        const float nxi = a_re * xi + a_im * xr + bui;
        xr = nxr; xi = nxi;
        if (lat) {
            float v[16];
#pragma unroll
            for (int h = 0; h < 16; ++h) v[h] = cr[h] * xr - ci[h] * xi;
            float w8[8], w4[4], w2[2], w1;
            const bool h32 = lane & 32, h16 = lane & 16, h8 = lane & 8, h4 = lane & 4;
#pragma unroll
            for (int i = 0; i < 8; ++i) { const float mine = h32 ? v[i + 8] : v[i], send = h32 ? v[i] : v[i + 8]; w8[i] = mine + __shfl_xor(send, 32); }
#pragma unroll
            for (int i = 0; i < 4; ++i) { const float mine = h16 ? w8[i + 4] : w8[i], send = h16 ? w8[i] : w8[i + 4]; w4[i] = mine + __shfl_xor(send, 16); }
#pragma unroll
            for (int i = 0; i < 2; ++i) { const float mine = h8 ? w4[i + 2] : w4[i], send = h8 ? w4[i] : w4[i + 2]; w2[i] = mine + __shfl_xor(send, 8); }
            { const float mine = h4 ? w2[1] : w2[0], send = h4 ? w2[0] : w2[1]; w1 = mine + __shfl_xor(send, 4); }
            w1 += __shfl_xor(w1, 2); w1 += __shfl_xor(w1, 1);
            if ((lane & 3) == 0) p.yf[((size_t)dir * NL + row) * 512 + g * 16 + (lane >> 2)] = w1;
        }
    }
}

__device__ void phase_scans(const Params& p, float* lds) {
    for (int u = blockIdx.x; u < 128 + 256; u += gridDim.x) {
        if (u < 128) gla_naive(p, u, lds);
        else s5_naive(p, (u - 128) * 4 + (threadIdx.x >> 6));
    }
}

__device__ void phase_mix(const Params& p) {
    const int lane = threadIdx.x & 63, wave = threadIdx.x >> 6;
    for (int r = blockIdx.x * 4 + wave; r < NL; r += gridDim.x * 4) {
        const float* pr = p.proj + (size_t)r * DIN;
        const float* of0 = p.of + (size_t)r * 512;
        const float* of1 = p.of + ((size_t)NL + r) * 512;
#pragma unroll
        for (int h = 0; h < 4; ++h) {
            const int i0 = h * 128 + lane, i1 = i0 + 64;
            const float o0 = of0[i0] + of1[i0], o1 = of0[i1] + of1[i1];
            const float ss = wave_sum(o0 * o0 + o1 * o1);
            const float rstd = rsqrtf(ss * (1.0f / 128.0f) + EPS);
            p.mix[(size_t)r * DM + i0] = o0 * rstd * p.gnorm_g[lane] * siluf_(pr[O_G + i0]);
            p.mix[(size_t)r * DM + i1] = o1 * rstd * p.gnorm_g[lane + 64] * siluf_(pr[O_G + i1]);
        }
        const float* y0 = p.yf + (size_t)r * 512;
        const float* y1 = p.yf + ((size_t)NL + r) * 512;
#pragma unroll
        for (int i = 0; i < 8; ++i) {
            const int cc = i * 64 + lane;
            const float y = y0[cc] + y1[cc] + p.s5_d[cc] * pr[O_U + cc];
            p.z[(size_t)r * 512 + cc] = gelu_tanhf_(y);
        }
    }
}

__device__ void phase_route(const Params& p) {
    const int lane = threadIdx.x & 63, wave = threadIdx.x >> 6;
    const float* scores = p.yf;
    const float4 rb = *(const float4*)(p.router_b + lane * 4);
    for (int t = blockIdx.x * 4 + wave; t < NL; t += gridDim.x * 4) {
        const float4 sc4 = *(const float4*)(scores + (size_t)t * 256 + lane * 4);
        const float sc[4] = {sc4.x, sc4.y, sc4.z, sc4.w};
        float bv[4] = {sc4.x + rb.x, sc4.y + rb.y, sc4.z + rb.z, sc4.w + rb.w};
        float m1 = -INFINITY, m2 = -INFINITY;
#pragma unroll
        for (int j = 0; j < 4; ++j) { const float v = bv[j]; if (v > m1) { m2 = m1; m1 = v; } else if (v > m2) m2 = v; }
#pragma unroll
        for (int o = 1; o < 8; o <<= 1) {
            const float o1 = __shfl_xor(m1, o), o2 = __shfl_xor(m2, o);
            const float n1 = fmaxf(m1, o1), n2 = fmaxf(fminf(m1, o1), fmaxf(m2, o2));
            m1 = n1; m2 = n2;
        }
        const float gs = m1 + m2;
        const int myg = lane >> 3;
        int rank = 0;
#pragma unroll
        for (int j = 0; j < 8; ++j) { const float og = __shfl(gs, j * 8); rank += (og > gs || (og == gs && j < myg)) ? 1 : 0; }
        const bool sel = rank < 4;
#pragma unroll
        for (int j = 0; j < 4; ++j) if (!sel) bv[j] = -INFINITY;
        int my_e = -1; float my_s = 0.f; float ssum = 0.f;
#pragma unroll
        for (int k = 0; k < TOPK; ++k) {
            float bvv = bv[0]; int bi = 0;
#pragma unroll
            for (int j = 1; j < 4; ++j) if (bv[j] > bvv) { bvv = bv[j]; bi = j; }
            int be = lane * 4 + bi;
            float bs = (bi == 0) ? sc[0] : (bi == 1) ? sc[1] : (bi == 2) ? sc[2] : sc[3];
#pragma unroll
            for (int o = 1; o < 64; o <<= 1) {
                const float ov = __shfl_xor(bvv, o); const int oe = __shfl_xor(be, o); const float os = __shfl_xor(bs, o);
                if (ov > bvv || (ov == bvv && oe < be)) { bvv = ov; be = oe; bs = os; }
            }
            if ((be >> 2) == lane) {
#pragma unroll
                for (int j = 0; j < 4; ++j) if ((be & 3) == j) bv[j] = -INFINITY;
            }
            ssum += bs;
            if (lane == k) { my_e = be; my_s = bs; }
        }
        if (lane < TOPK) {
            const float w = my_s / ssum * 2.5f;
            const int pos = atomicAdd(&p.cnt[my_e], 1);
            p.ltok[(size_t)my_e * CAP + pos] = t;
            p.lw[(size_t)my_e * CAP + pos] = w;
        }
    }
}

__device__ __forceinline__ void expert_prefix(const Params& p, int* offs, int* toff, int ncolt) {
    const int tid = threadIdx.x;
    __syncthreads();
    {
        int s = 0, ts = 0;
        for (int e = 0; e < tid; ++e) { const int c = p.cnt[e]; s += c; ts += ((c + 63) / 64) * ncolt; }
        offs[tid] = s; toff[tid] = ts;
        if (tid == NT - 1) { const int c = p.cnt[tid]; offs[256] = s + c; toff[256] = ts + ((c + 63) / 64) * ncolt; }
    }
    __syncthreads();
}
__device__ __forceinline__ int find_expert(const int* toff, int u) {
    int lo = 0, hi = 256;
    while (hi - lo > 1) { const int mid = (lo + hi) >> 1; if (toff[mid] <= u) lo = mid; else hi = mid; }
    return lo;
}

__device__ void phase_final(const Params& p) {
    const int lane = threadIdx.x & 63, wave = threadIdx.x >> 6;
    for (int r = blockIdx.x * 4 + wave; r < NL; r += gridDim.x * 4) {
        const int b = r / SEQ;
        const float* x1 = p.of + (size_t)r * DM;
        const float* moe = p.mix + (size_t)r * DM;
        const float* g2 = p.modv + b * 6144 + 5120;
        float4 v[4]; float ss = 0.f;
#pragma unroll
        for (int i = 0; i < 4; ++i) {
            const int col = i * 256 + lane * 4;
            const float4 a = *(const float4*)(x1 + col), m = *(const float4*)(moe + col), gg = *(const float4*)(g2 + col);
            v[i].x = a.x + gg.x * m.x; v[i].y = a.y + gg.y * m.y; v[i].z = a.z + gg.z * m.z; v[i].w = a.w + gg.w * m.w;
            ss += v[i].x * v[i].x + v[i].y * v[i].y + v[i].z * v[i].z + v[i].w * v[i].w;
        }
        ss = wave_sum(ss);
        const float rstd = rsqrtf(ss * (1.0f / DM) + EPS);
#pragma unroll
        for (int i = 0; i < 4; ++i) {
            const int col = i * 256 + lane * 4;
            const float4 gg = *(const float4*)(p.fnorm_g + col);
            float4 o; o.x = v[i].x * rstd * gg.x; o.y = v[i].y * rstd * gg.y; o.z = v[i].z * rstd * gg.z; o.w = v[i].w * rstd * gg.w;
            *(float4*)(p.out + (size_t)r * DM + col) = o;
        }
    }
}

__global__ void __launch_bounds__(NT, 2) mega(Params p) {
    extern __shared__ __attribute__((aligned(16))) float lds[];
    __shared__ uint4 xb_words;
    if (threadIdx.x == 0) xb_words = make_uint4(0u, 0u, 0u, 0u);
    __syncthreads();
    XcdBarrier bar; bar.bar = p.bar; bar.x = 0; bar.st = (volatile LAS unsigned*)&xb_words;
    const bool fused = (p.ph_hi - p.ph_lo) > 1;
    if (fused) bar = xcd_barrier_post(p.bar, (volatile LAS unsigned*)&xb_words);
    const int bid = blockIdx.x, nb = gridDim.x;
#define PH(i) (p.ph_lo <= (i) && (i) < p.ph_hi)
#define SEAM(i) if (fused && p.ph_lo <= (i) && (i) + 1 < p.ph_hi) xcd_barrier(bar)

    if (PH(0)) {
        if (bid == 0 && threadIdx.x < 256) p.cnt[threadIdx.x] = 0;
        phase_modv(p, lds);
    }
    SEAM(0);
    if (PH(1)) phase_norm_mod(p, 0);
    SEAM(1);
    if (PH(2)) {
        const float* hx = p.hx; float* proj = p.proj;
        gemm_dense<false>(lds, bid, nb, NR, DIN, DM, [=](int m) { return hx + (size_t)m * DM; }, p.w_in, nullptr, DIN,
                          [=](int m, int n, float a0, float) { proj[(size_t)m * DIN + n] = a0; });
    }
    SEAM(2);
    if (PH(3)) phase_scans(p, lds);
    SEAM(3);
    if (PH(4)) phase_mix(p);
    SEAM(4);
    if (PH(5)) {
        const float* z = p.z; float* mix = p.mix; const float* gb = p.glu_b;
        gemm_dense<false>(lds, bid, nb, NL, 512, 512, [=](int m) { return z + (size_t)m * 512; }, p.glu_w, nullptr, 512,
                          [=](int m, int n, float a0, float) { mix[(size_t)m * DM + 512 + n] = z[(size_t)m * 512 + n] * sigmoidf_(a0 + gb[n]); });
    }
    SEAM(5);
    if (PH(6)) {
        const float* mix = p.mix; float* x1 = p.of; const float* x = p.x; const float* modv = p.modv;
        gemm_dense<false>(lds, bid, nb, NL, DM, DM, [=](int m) { return mix + (size_t)m * DM; }, p.w_out, nullptr, DM,
                          [=](int m, int n, float a0, float) { x1[(size_t)m * DM + n] = x[(size_t)m * DM + n] + modv[(m / SEQ) * 6144 + 2048 + n] * a0; });
    }
    SEAM(6);
    if (PH(7)) phase_norm_mod(p, 1);
    SEAM(7);
    if (PH(8)) {
        const float* hx2 = p.hx; float* scores = p.yf; float* shhid = p.yf + (size_t)NL * 256;
        gemm_dense<false>(lds, bid, nb, NL, 256, DM, [=](int m) { return hx2 + (size_t)m * DM; }, p.router_w, nullptr, 256,
                          [=](int m, int n, float a0, float) { scores[(size_t)m * 256 + n] = sigmoidf_(a0); });
        gemm_dense<true>(lds, bid, nb, NL, 256, DM, [=](int m) { return hx2 + (size_t)m * DM; }, p.sw_gate, p.sw_up, 256,
                         [=](int m, int n, float a0, float a1) { shhid[(size_t)m * 256 + n] = siluf_(a0) * a1; });
    }
    SEAM(8);
    if (PH(9)) phase_route(p);
    SEAM(9);
    if (PH(10)) {
        int* offs = (int*)(lds + 4096); int* toff = offs + 260;
        expert_prefix(p, offs, toff, 4);
        const float* hx2 = p.hx; float* hid = p.proj;
        const int total = toff[256];
        for (int u = bid; u < total; u += nb) {
            const int e = find_expert(toff, u);
            const int lt = u - toff[e], im = lt >> 2, in_ = lt & 3;
            const int* lt_e = p.ltok + (size_t)e * CAP; const int ro = offs[e];
            gemm64<true>(lds, im * 64, in_ * 64, p.cnt[e], 256, DM, [=](int m) { return hx2 + (size_t)lt_e[m] * DM; },
                         p.ew_gate + (size_t)e * DM * 256, p.ew_up + (size_t)e * DM * 256, 256,
                         [=](int m, int n, float a0, float a1) { hid[(size_t)(ro + m) * 256 + n] = siluf_(a0) * a1; });
        }
        const float* shhid = p.yf + (size_t)NL * 256; float* moe = p.mix;
        gemm_dense<false>(lds, bid, nb, NL, DM, 256, [=](int m) { return shhid + (size_t)m * 256; }, p.sw_down, nullptr, DM,
                          [=](int m, int n, float a0, float) { moe[(size_t)m * DM + n] = a0; });
    }
    SEAM(10);
    if (PH(11)) {
        int* offs = (int*)(lds + 4096); int* toff = offs + 260;
        expert_prefix(p, offs, toff, 16);
        const float* hid = p.proj; float* moe = p.mix;
        const int total = toff[256];
        for (int u = bid; u < total; u += nb) {
            const int e = find_expert(toff, u);
            const int lt = u - toff[e], im = lt >> 4, in_ = lt & 15;
            const int* lt_e = p.ltok + (size_t)e * CAP; const float* lw_e = p.lw + (size_t)e * CAP; const int ro = offs[e];
            gemm64<false>(lds, im * 64, in_ * 64, p.cnt[e], DM, 256, [=](int m) { return hid + (size_t)(ro + m) * 256; },
                          p.ew_down + (size_t)e * 256 * DM, nullptr, DM,
                          [=](int m, int n, float a0, float) { atomicAdd(&moe[(size_t)lt_e[m] * DM + n], lw_e[m] * a0); });
        }
    }
    SEAM(11);
    if (PH(12)) phase_final(p);
}

extern "C" void kernel_launch(void* const* d_in, const int* in_sizes, int n_in, void* d_out, int out_size, void* d_ws, size_t ws_size,
                              hipStream_t stream) {
    static int grid = 0;
    if (grid == 0) {
        int dev = 0, cus = 0, per_cu = 0;
        (void)hipGetDevice(&dev);
        (void)hipDeviceGetAttribute(&cus, hipDeviceAttributeMultiprocessorCount, dev);
        (void)hipFuncSetAttribute((const void*)mega, hipFuncAttributeMaxDynamicSharedMemorySize, LDS_BYTES);
        (void)hipOccupancyMaxActiveBlocksPerMultiprocessor(&per_cu, (const void*)mega, NT, LDS_BYTES);
        (void)hipGetLastError();
        if (per_cu < 1) per_cu = 1;
        if (per_cu > 2) per_cu = 2;
        grid = cus * per_cu;
    }
    size_t off = 0;
    auto carve = [&](size_t bytes) { size_t o = off; off += (bytes + 255) & ~(size_t)255; return (char*)d_ws + o; };
    Params p{};
    const float** ins = (const float**)&p;
    for (int i = 0; i < 39; ++i) ins[i] = (const float*)d_in[i];
    p.out = (float*)d_out;
    p.bar = (unsigned*)carve(XCD_BAR_WORDS * 4);
    p.cnt = (int*)carve(256 * 4);
    const size_t zero_bytes = off;
    p.modv = (float*)carve((size_t)17 * 6144 * 4);
    p.hx = (float*)carve((size_t)NR * DM * 4);
    p.proj = (float*)carve((size_t)NR * DIN * 4);
    p.of = (float*)carve((size_t)2 * NL * 512 * 4);
    p.yf = (float*)carve((size_t)2 * NL * 512 * 4);
    p.mix = (float*)carve((size_t)NL * DM * 4);
    p.z = (float*)carve((size_t)NL * 512 * 4);
    p.ltok = (int*)carve((size_t)NE * CAP * 4);
    p.lw = (float*)carve((size_t)NE * CAP * 4);
    if (off > ws_size) { fprintf(stderr, "kernel_launch: workspace too small: need %zu have %zu\n", off, ws_size); return; }
    (void)hipMemsetAsync(d_ws, 0, zero_bytes, stream);
#if FUSED
    p.ph_lo = 0; p.ph_hi = N_PHASES;
    hipLaunchKernelGGL(mega, dim3(grid), dim3(NT), LDS_BYTES, stream, p);
#else
    for (int i = 0; i < N_PHASES; ++i) {
        p.ph_lo = i; p.ph_hi = i + 1;
        hipLaunchKernelGGL(mega, dim3(grid), dim3(NT), LDS_BYTES, stream, p);
    }
#endif
}
```

```cpp
#include <hip/hip_runtime.h>
#include <stdint.h>
#include <stdio.h>

#define DM 1024
#define NB 16
#define SEQ 2048
#define CTX 256
#define NL (NB * SEQ)
#define NCX (NB * CTX)
#define NR (NL + NCX)
#define DIN 2080
#define S_LR 1536
#define S_U 1568
#define P_Q 0
#define P_K 256
#define P_V 512
#define P_G 1024
#define WC_U 1536
#define WC_LR 2048
#define P_LRF 1536
#define P_LRB 1552
#define DINP 1568
#define S5_ROWS 2304
#define NE 256
#define TOPK 8
#define CAP 32768
#define EPS 1e-6f

#define NT 512
#define NWAVES 8
#define STAGE_BYTES 131072
#define LDS_BYTES (STAGE_BYTES + 16384)
#define N_PHASES 13
#define S5_WLDS 14592
#ifndef FUSED
#define FUSED 1
#endif

typedef unsigned short bf16_t;
typedef short bf16x8 __attribute__((ext_vector_type(8)));
typedef float f32x4 __attribute__((ext_vector_type(4)));
typedef unsigned u32x4 __attribute__((ext_vector_type(4)));
typedef unsigned u32x2 __attribute__((ext_vector_type(2)));
#define LAS __attribute__((address_space(3)))

#define XB_TMO      128
#define XB_XCNT(j)  (256  + 64 * (j))
#define XB_XSUB(j)  (1280 + 64 * (j))
#define XB_XGEN(j)  (2304 + 64 * (j))
#define XB_TOP      3328
#define XB_TOPGEN   3392
#define XCD_BAR_WORDS 3456
#define XB_SPIN_CAP (1u << 18)

__device__ __forceinline__ unsigned xb_ld(unsigned* p)              { return __hip_atomic_load(p, __ATOMIC_RELAXED, __HIP_MEMORY_SCOPE_AGENT); }
__device__ __forceinline__ unsigned xb_add(unsigned* p, unsigned v) { return __hip_atomic_fetch_add(p, v, __ATOMIC_RELAXED, __HIP_MEMORY_SCOPE_AGENT); }
__device__ __forceinline__ unsigned xb_xcc_id() { return (unsigned)__builtin_amdgcn_s_getreg((3 << 11) | 20) & 0xFu; }
#define XB_SPIN(cond, bar) do { unsigned _sp = 0; while (cond) { __builtin_amdgcn_s_sleep(1); \
    if ((++_sp & 255u) == 0u) { if (xb_ld(&(bar)[XB_TMO])) break; if (_sp > XB_SPIN_CAP) { atomicAdd(&(bar)[XB_TMO], 1u); break; } } } } while (0)

struct XcdBarrier { unsigned* bar; unsigned x; volatile LAS unsigned* st; };

__device__ __forceinline__ XcdBarrier xcd_barrier_post(unsigned* bar, volatile LAS unsigned* st) {
    XcdBarrier b; b.bar = bar; b.x = xb_xcc_id(); b.st = st;
    if (threadIdx.x == 0) (void)xb_add(&bar[XB_XCNT(b.x)], 1u);
    return b;
}
__device__ __forceinline__ void xcd_barrier_complete(unsigned* bar, unsigned x, unsigned& nloc, unsigned& nx) {
    const unsigned G = gridDim.x * gridDim.y * gridDim.z;
    unsigned sum, cnt, mine, sp = 0u;
    for (;;) {
        sum = 0u; cnt = 0u; mine = 0u;
#pragma unroll
        for (unsigned j = 0; j < 16; ++j) { const unsigned c = xb_ld(&bar[XB_XCNT(j)]); sum += c; cnt += (c > 0u) ? 1u : 0u; mine = (j == x) ? c : mine; }
        if (sum == G) break;
        __builtin_amdgcn_s_sleep(1);
        if ((++sp & 255u) == 0u) { if (xb_ld(&bar[XB_TMO])) break; if (sp > XB_SPIN_CAP) { atomicAdd(&bar[XB_TMO], 1u); break; } }
    }
    nloc = mine > 0u ? mine : 1u; nx = cnt > 0u ? cnt : 1u;
}
__device__ __forceinline__ void xcd_barrier(const XcdBarrier& b) {
    asm volatile("s_waitcnt vmcnt(0)" ::: "memory");
    __syncthreads();
    if (threadIdx.x == 0) {
        unsigned* bar = b.bar;
        __builtin_amdgcn_s_waitcnt(0);
        unsigned nloc = b.st[0], nx = b.st[1];
        if (nloc == 0u) { xcd_barrier_complete(bar, b.x, nloc, nx); b.st[0] = nloc; b.st[1] = nx; }
        const unsigned old = xb_add(&bar[XB_XSUB(b.x)], 1u);
        const unsigned gen = old / nloc;
        if (old + 1u == (gen + 1u) * nloc) {
            __builtin_amdgcn_fence(__ATOMIC_RELEASE, "agent");
            asm volatile("s_waitcnt vmcnt(0)" ::: "memory");
            const unsigned og = xb_add(&bar[XB_TOP], 1u);
            const unsigned tg = og / nx;
            if (og + 1u == (tg + 1u) * nx) xb_add(&bar[XB_TOPGEN], 1u);
            else XB_SPIN(xb_ld(&bar[XB_TOPGEN]) == tg, bar);
            __builtin_amdgcn_fence(__ATOMIC_ACQUIRE, "agent");
            xb_add(&bar[XB_XGEN(b.x)], 1u);
            asm volatile("s_waitcnt vmcnt(0)" ::: "memory");
        } else {
            XB_SPIN(xb_ld(&bar[XB_XGEN(b.x)]) == gen, bar);
            __builtin_amdgcn_fence(__ATOMIC_ACQUIRE, "agent");
            asm volatile("s_waitcnt vmcnt(0)" ::: "memory");
        }
    }
    __syncthreads();
}

struct Params {
    const float *x, *c, *ctx, *c_ctx, *ada_w, *ada_b, *norm1_g, *norm2_g, *w_in,
        *wa_f, *ba_f, *wa_b, *ba_b, *gnorm_g,
        *lam_re_f, *lam_im_f, *lstep_f, *lam_re_b, *lam_im_b, *lstep_b,
        *b_re, *b_im, *c_re_f, *c_im_f, *c_re_b, *c_im_b, *s5_d, *glu_w, *glu_b,
        *w_out, *router_w, *router_b, *ew_gate, *ew_up, *ew_down, *sw_gate, *sw_up, *sw_down, *fnorm_g;
    float* out;
    unsigned* bar;
    int* cnt;
    float* modv;
    bf16_t* w_inT;
    bf16_t* w_outT;
    bf16_t* gluT;
    bf16_t* routerT3;
    bf16_t* shguT;
    bf16_t* shdT;
    bf16_t* hx;
    bf16_t* proj;
    bf16_t* of;
    bf16_t* yf;
    bf16_t* Ag;
    bf16_t* mix;
    bf16_t* z;
    float* scores;
    bf16_t* shhid;
    bf16_t* eguT;
    bf16_t* edT;
    bf16_t* hid;
    bf16_t* yb;
    unsigned short* ltok;
    unsigned* tinfo;
    float* tw;
    int ph_lo, ph_hi;
};

__device__ __forceinline__ float sigmoidf_(float v) { return 1.0f / (1.0f + expf(-v)); }
__device__ __forceinline__ float siluf_(float v) { return v / (1.0f + expf(-v)); }
__device__ __forceinline__ float logsigmoidf_(float v) { return fminf(v, 0.0f) - log1pf(expf(-fabsf(v))); }
__device__ __forceinline__ float gelu_tanhf_(float v) { return 0.5f * v * (1.0f + tanhf(0.7978845608028654f * (v + 0.044715f * v * v * v))); }
__device__ __forceinline__ float sigmoid_fast(float v) { return __builtin_amdgcn_rcpf(1.0f + __builtin_amdgcn_exp2f(-v * 1.4426950408889634f)); }
__device__ __forceinline__ float silu_fast(float v) { return v * sigmoid_fast(v); }
__device__ __forceinline__ float gelu_tanh_fast(float v) { return v * sigmoid_fast(1.5957691216057308f * (v + 0.044715f * v * v * v)); }
__device__ __forceinline__ float wave_sum(float v) {
#pragma unroll
    for (int o = 32; o > 0; o >>= 1) v += __shfl_xor(v, o);
    return v;
}
__device__ __forceinline__ float bf2f(bf16_t b) { return __uint_as_float(((unsigned)b) << 16); }
__device__ __forceinline__ float bflo(unsigned w) { return __uint_as_float(w << 16); }
__device__ __forceinline__ float bfhi(unsigned w) { return __uint_as_float(w & 0xFFFF0000u); }
__device__ __forceinline__ bf16_t f2bf(float f) { unsigned u = __float_as_uint(f); u += 0x7FFFu + ((u >> 16) & 1u); return (bf16_t)(u >> 16); }
typedef __bf16 bf16x2_t __attribute__((ext_vector_type(2)));
typedef float f32x2_t __attribute__((ext_vector_type(2)));
__device__ __forceinline__ unsigned cvt_pk_bf16(float lo, float hi) { const f32x2_t f = {lo, hi}; return __builtin_bit_cast(unsigned, __builtin_convertvector(f, bf16x2_t)); }

namespace g8 {
constexpr int BM = 256, BK = 64, HALF = 128, HTB = HALF * BK * 2, NXCD = 8, WGM = 8;
__device__ __forceinline__ int lds_byte(int r, int c) { const int st = (r >> 4) * 2 + (c >> 5), rr = r & 15, cc = c & 31, ob = rr * 64 + cc * 2; return st * 1024 + (ob ^ (((ob >> 9) & 1) << 5)); }
__device__ __forceinline__ void stage_rc(int b, int& R, int& C) { const int st = b / 1024, sb = b % 1024, swz = sb ^ (((sb >> 9) & 1) << 5); R = (st >> 1) * 16 + swz / 64; C = (st & 1) * 32 + (swz % 64) / 2; }
__device__ __forceinline__ int perm32(int rho) { const int n = rho >> 4, i = rho & 15; return 8 * (i >> 2) + 4 * n + (i & 3); }

struct Unit { const char* a; const char* b; int pm, pn, e, rows; };

struct DenseSched {
    const char* A; const char* Bt; unsigned lda, ldb; int nM, nN, nwg, G, c;
    __device__ __forceinline__ void init(const void* A_, const void* Bt_, unsigned lda_, unsigned ldb_, int M, int N, int G_, int c_) {
        A = (const char*)A_; Bt = (const char*)Bt_; lda = lda_; ldb = ldb_; nM = M / BM; nN = N / BM; nwg = nM * nN; G = G_; c = c_; }
    __device__ __forceinline__ bool next(int i, Unit& u) const {
        if (c < 0) return false;
        const long L = (long)i * G + c; if (L >= nwg) return false;
        int wgid = (int)L; { const int q = nwg / NXCD, r = nwg % NXCD, xcd = wgid % NXCD, off = wgid / NXCD; wgid = (xcd < r ? xcd * (q + 1) : r * (q + 1) + (xcd - r) * q) + off; }
        const int nig = WGM * nN, gid = wgid / nig, fm = gid * WGM, gsz = (nM - fm) < WGM ? (nM - fm) : WGM;
        u.pm = fm + ((wgid % nig) % gsz); u.pn = (wgid % nig) / gsz; u.e = 0; u.rows = BM;
        u.a = A + (size_t)u.pm * BM * lda; u.b = Bt + (size_t)u.pn * BM * ldb;
        return true;
    }
};

typedef int v8i_t __attribute__((ext_vector_type(8)));
typedef long v2l_t __attribute__((ext_vector_type(2)));
template <class Epi, class Sched, int KWRAP, bool GATHER = false, bool FP8 = false>
__device__ __forceinline__ void gemm_phase(LAS unsigned char* lds, const int K, const unsigned lda, const unsigned ldb, const Sched& S, const Epi& E) {
    const int tid = threadIdx.x, wid = __builtin_amdgcn_readfirstlane(tid >> 6), lane = tid & 63, wr = wid >> 2, wc = wid & 3, fr = lane & 15, fq = lane >> 4;
    const int nt = K / BK;
    unsigned voffA[2], voffB[2]; int rA[2]; unsigned cA2[2];
#pragma unroll
    for (int i = 0; i < 2; ++i) { int R, C; stage_rc(tid * 16 + i * 8192, R, C); const int Rb = Epi::PERM ? ((R & ~31) + perm32(R & 31)) : R;
        voffA[i] = (unsigned)R * lda + (unsigned)C * 2u; voffB[i] = (unsigned)Rb * ldb + (unsigned)C * 2u; rA[i] = R; cA2[i] = (unsigned)C * 2u; }
    unsigned gc[2][2], gn[2][2];
    const size_t kstep = (size_t)(BK * 2);
    const size_t hstepA = (size_t)HALF * lda, hstepB = (size_t)HALF * ldb;
    const unsigned ldsw = (unsigned)wid * 1024u;
    const int aoff = lds_byte(wr * 64 + fr, fq * 8), boff = lds_byte(wc * 32 + fr, fq * 8);
#define G8_SA(b, h) (((b) * 2 + (h)) * HTB)
#define G8_SB(b, h) ((4 + (b) * 2 + (h)) * HTB)
#define G8_STAGE(bufoff, gbase, voff) do { _Pragma("unroll") for (int _i = 0; _i < 2; ++_i) \
        __builtin_amdgcn_global_load_lds((const unsigned*)((const char*)(gbase) + (voff)[_i]), (LAS unsigned*)(lds + (bufoff) + ldsw + _i * 8192), 16, 0, 0); } while (0)
#define G8_KO(kt) ((size_t)(KWRAP ? ((kt) & (KWRAP - 1)) : (kt)) * kstep)
#define G8_LDA(dst, b, h) do { _Pragma("unroll") for (int m = 0; m < 4; ++m) _Pragma("unroll") for (int k = 0; k < 2; ++k) dst[m][k] = *(const LAS bf16x8*)(lds + G8_SA(b, h) + aoff + m * 2048 + k * 1024); } while (0)
#define G8_LDB(dst, b, h) do { _Pragma("unroll") for (int n = 0; n < 2; ++n) _Pragma("unroll") for (int k = 0; k < 2; ++k) dst[n][k] = *(const LAS bf16x8*)(lds + G8_SB(b, h) + boff + n * 2048 + k * 1024); } while (0)
#define G8_PK8(x) __builtin_bit_cast(v8i_t, x)
#define G8_MMA(ai, bj, At, Bt) do { __builtin_amdgcn_s_setprio(1); _Pragma("unroll") for (int m = 0; m < 4; ++m) _Pragma("unroll") for (int n = 0; n < 2; ++n) { \
        if constexpr (FP8) { _Pragma("unroll") for (int k = 0; k < 2; ++k) { const v2l_t b2_ = __builtin_bit_cast(v2l_t, Bt[n][k]), a2_ = __builtin_bit_cast(v2l_t, At[m][k]); \
            acc[ai][bj][m][n] = __builtin_amdgcn_mfma_f32_16x16x32_fp8_fp8(b2_[0], a2_[0], acc[ai][bj][m][n], 0, 0, 0); \
            acc[ai][bj][m][n] = __builtin_amdgcn_mfma_f32_16x16x32_fp8_fp8(b2_[1], a2_[1], acc[ai][bj][m][n], 0, 0, 0); } } \
        else { _Pragma("unroll") for (int k = 0; k < 2; ++k) acc[ai][bj][m][n] = __builtin_amdgcn_mfma_f32_16x16x32_bf16(Bt[n][k], At[m][k], acc[ai][bj][m][n], 0, 0, 0); } } \
        __builtin_amdgcn_s_setprio(0); } while (0)
#define G8_WAIT_V(n) asm volatile("s_waitcnt vmcnt(" #n ")" ::: "memory")
#define G8_WAIT_L(n) asm volatile("s_waitcnt lgkmcnt(" #n ")" ::: "memory")
#define G8_BAR __builtin_amdgcn_s_barrier()
#define G8_SCHED __builtin_amdgcn_sched_barrier(0)
    Unit cur, nxt; int ui = 0;
    if (!S.next(0, cur)) return;
    f32x4 acc[2][2][4][2];
#pragma unroll
    for (int a = 0; a < 2; ++a)
#pragma unroll
        for (int b = 0; b < 2; ++b)
#pragma unroll
            for (int m = 0; m < 4; ++m)
#pragma unroll
                for (int n = 0; n < 2; ++n) acc[a][b][m][n] = (f32x4){0.f, 0.f, 0.f, 0.f};
    bf16x8 At[4][2], B0[2][2], B1[2][2];
    const char* cA = cur.a; const char* cB = cur.b; const char* nA = cA;
#define G8_STA(bufoff, nx, h, kt) do { const size_t _ko = G8_KO(kt); _Pragma("unroll") for (int _i = 0; _i < 2; ++_i) { const char* _s; \
        if constexpr (GATHER) _s = S.gbase + (size_t)((nx) ? gn[h][_i] : gc[h][_i]) + _ko; else _s = ((nx) ? nA : cA) + ((h) ? hstepA : (size_t)0) + voffA[_i] + _ko; \
        __builtin_amdgcn_global_load_lds((const unsigned*)_s, (LAS unsigned*)(lds + (bufoff) + ldsw + _i * 8192), 16, 0, 0); } } while (0)
    if constexpr (GATHER) {
#pragma unroll
        for (int h = 0; h < 2; ++h)
#pragma unroll
            for (int i = 0; i < 2; ++i) { gc[h][i] = S.row_off(cur, h * HALF + rA[i]) + cA2[i]; gn[h][i] = gc[h][i]; }
    }
    G8_STAGE(G8_SB(0, 0), cB, voffB); G8_STA(G8_SA(0, 0), false, 0, 0); G8_STAGE(G8_SB(0, 1), cB + hstepB, voffB); G8_STA(G8_SA(0, 1), false, 1, 0);
    if (wr == 1) G8_BAR;
    G8_WAIT_V(4); G8_BAR;
    G8_STAGE(G8_SB(1, 0), cB + kstep, voffB); G8_STA(G8_SA(1, 0), false, 0, 1); G8_STAGE(G8_SB(1, 1), cB + hstepB + kstep, voffB);
    G8_WAIT_V(6); G8_BAR;
    for (;;) {
        const bool has_next = S.next(ui + 1, nxt);
        nA = has_next ? nxt.a : cA; const char* nB = has_next ? nxt.b : cB;
        if constexpr (GATHER) {
#pragma unroll
            for (int h = 0; h < 2; ++h)
#pragma unroll
                for (int i = 0; i < 2; ++i) gn[h][i] = has_next ? (S.row_off(nxt, h * HALF + rA[i]) + cA2[i]) : gc[h][i];
        }
        for (int t = 0; t < nt; t += 2) {
            const bool last = (t == nt - 2);
            const char* b2 = last ? nB : cB + (size_t)(t + 2) * kstep;
            const char* b3 = b2 + kstep;
            G8_LDB(B0, 0, 0); G8_SCHED; G8_LDA(At, 0, 0); G8_STA(G8_SA(1, 1), false, 1, t + 1);
            G8_WAIT_L(8); G8_BAR; G8_WAIT_L(0); G8_MMA(0, 0, At, B0); G8_BAR; G8_SCHED;
            G8_LDB(B1, 0, 1); G8_STAGE(G8_SB(0, 0), b2, voffB);
            G8_BAR; G8_WAIT_L(0); G8_MMA(0, 1, At, B1); G8_BAR;
            G8_LDA(At, 0, 1); G8_STA(G8_SA(0, 0), last, 0, last ? 0 : t + 2);
            G8_BAR; G8_WAIT_L(0); if (cur.rows > HALF) G8_MMA(1, 0, At, B0); G8_BAR; G8_SCHED;
            G8_STAGE(G8_SB(0, 1), b2 + hstepB, voffB);
            G8_WAIT_V(6); G8_BAR; if (cur.rows > HALF) G8_MMA(1, 1, At, B1); G8_BAR;
            G8_LDB(B0, 1, 0); G8_SCHED; G8_LDA(At, 1, 0); G8_STA(G8_SA(0, 1), last, 1, last ? 0 : t + 2);
            G8_WAIT_L(8); G8_BAR; G8_WAIT_L(0); G8_MMA(0, 0, At, B0); G8_BAR; G8_SCHED;
            G8_LDB(B1, 1, 1); G8_STAGE(G8_SB(1, 0), b3, voffB);
            G8_BAR; G8_WAIT_L(0); G8_MMA(0, 1, At, B1); G8_BAR;
            G8_LDA(At, 1, 1); G8_STA(G8_SA(1, 0), last, 0, last ? 1 : t + 3);
            G8_BAR; G8_WAIT_L(0); if (cur.rows > HALF) G8_MMA(1, 0, At, B0); G8_BAR; G8_SCHED;
            G8_STAGE(G8_SB(1, 1), b3 + hstepB, voffB);
            G8_WAIT_V(6); G8_BAR; if (cur.rows > HALF) G8_MMA(1, 1, At, B1); G8_BAR;
        }
        {
            asm volatile("s_nop 15\n\ts_nop 15" : "+v"(acc[1][1][0][0]), "+v"(acc[1][1][0][1]), "+v"(acc[1][1][1][0]), "+v"(acc[1][1][1][1]), "+v"(acc[1][1][2][0]), "+v"(acc[1][1][2][1]), "+v"(acc[1][1][3][0]), "+v"(acc[1][1][3][1]));
            int tz = threadIdx.x; asm volatile("" : "+v"(tz));
            const int wid2 = __builtin_amdgcn_readfirstlane(tz >> 6), lane2 = tz & 63;
            E(acc, cur, wid2 >> 2, wid2 & 3, lane2 & 15, lane2 >> 4);
        }
        if (!has_next) break;
#pragma unroll
        for (int a = 0; a < 2; ++a)
#pragma unroll
            for (int b = 0; b < 2; ++b)
#pragma unroll
                for (int m = 0; m < 4; ++m)
#pragma unroll
                    for (int n = 0; n < 2; ++n) acc[a][b][m][n] = (f32x4){0.f, 0.f, 0.f, 0.f};
        cur = nxt; cA = nA; cB = nB; ++ui;
        if constexpr (GATHER) {
#pragma unroll
            for (int h = 0; h < 2; ++h)
#pragma unroll
                for (int i = 0; i < 2; ++i) gc[h][i] = gn[h][i];
        }
    }
    G8_WAIT_V(0);
    if (wr == 0) G8_BAR;
    G8_BAR;
#undef G8_SA
#undef G8_SB
#undef G8_STAGE
#undef G8_STA
#undef G8_KO
#undef G8_LDA
#undef G8_LDB
#undef G8_MMA
#undef G8_PK8
#undef G8_WAIT_V
#undef G8_WAIT_L
#undef G8_BAR
#undef G8_SCHED
}

struct EpiProj {
    static constexpr bool PERM = true;
    bf16_t* O; bf16_t* AG;
    __device__ __forceinline__ void operator()(const f32x4 (&acc)[2][2][4][2], const Unit& u, int wr, int wc, int fr, int fq) const {
        const int row0 = u.pm * BM + wr * 64 + fr, col0 = u.pn * BM + wc * 32 + 8 * fq;
#pragma unroll
        for (int ai = 0; ai < 2; ++ai)
#pragma unroll
            for (int m = 0; m < 4; ++m) {
                const int r = row0 + ai * HALF + m * 16;
#pragma unroll
                for (int bj = 0; bj < 2; ++bj) { const f32x4 v0 = acc[ai][bj][m][0], v1 = acc[ai][bj][m][1];
                    const int c = col0 + bj * HALF;
                    const u32x4 pk = (u32x4){cvt_pk_bf16(v0[0], v0[1]), cvt_pk_bf16(v0[2], v0[3]), cvt_pk_bf16(v1[0], v1[1]), cvt_pk_bf16(v1[2], v1[3])};
                    if (u.pn < 6) *(u32x4*)(O + (size_t)r * DINP + c) = pk;
                    else if (u.pn < 8) { const int cu = c - WC_U; *(u32x4*)(AG + ((size_t)(cu >> 4) * S5_ROWS + (r >> 4)) * 512 + (r & 15) * 16 + (cu & 15)) = pk; }
                    else if (c < WC_LR + 32) *(u32x4*)(O + (size_t)r * DINP + P_LRF + (c - WC_LR)) = pk; } }
    }
};
struct EpiBf16 {
    static constexpr bool PERM = true;
    bf16_t* O;
    __device__ __forceinline__ void operator()(const f32x4 (&acc)[2][2][4][2], const Unit& u, int wr, int wc, int fr, int fq) const {
        const int row0 = u.pm * BM + wr * 64 + fr, col0 = u.pn * BM + wc * 32 + 8 * fq;
#pragma unroll
        for (int ai = 0; ai < 2; ++ai)
#pragma unroll
            for (int m = 0; m < 4; ++m) {
                const int r = row0 + ai * HALF + m * 16;
#pragma unroll
                for (int bj = 0; bj < 2; ++bj) { const f32x4 v0 = acc[ai][bj][m][0] * (8.0f / 128.0f), v1 = acc[ai][bj][m][1] * (8.0f / 128.0f);
                    int d0 = __builtin_amdgcn_cvt_pk_fp8_f32(v0[0], v0[1], 0, false); d0 = __builtin_amdgcn_cvt_pk_fp8_f32(v0[2], v0[3], d0, true);
                    int d1 = __builtin_amdgcn_cvt_pk_fp8_f32(v1[0], v1[1], 0, false); d1 = __builtin_amdgcn_cvt_pk_fp8_f32(v1[2], v1[3], d1, true);
                    *(u32x2*)((char*)O + (size_t)r * DM + col0 + bj * HALF) = (u32x2){(unsigned)d0, (unsigned)d1}; }
            }
    }
};
struct EpiGlu {
    static constexpr bool PERM = true;
    const bf16_t* Z; bf16_t* MIX; const float* bias;
    __device__ __forceinline__ void operator()(const f32x4 (&acc)[2][2][4][2], const Unit& u, int wr, int wc, int fr, int fq) const {
        const int row0 = u.pm * BM + wr * 64 + fr, col0 = u.pn * BM + wc * 32 + 8 * fq;
#pragma unroll
        for (int bj = 0; bj < 2; ++bj) {
            const int c = col0 + bj * HALF;
            const f32x4 b0 = *(const f32x4*)(bias + c), b1 = *(const f32x4*)(bias + c + 4);
            u32x4 zq[8];
#pragma unroll
            for (int ai = 0; ai < 2; ++ai)
#pragma unroll
                for (int m = 0; m < 4; ++m) zq[ai * 4 + m] = *(const u32x4*)(Z + (size_t)(row0 + ai * HALF + m * 16) * 512 + c);
#pragma unroll
            for (int ai = 0; ai < 2; ++ai)
#pragma unroll
                for (int m = 0; m < 4; ++m) {
                    const size_t r = (size_t)(row0 + ai * HALF + m * 16);
                    const u32x4 zz = zq[ai * 4 + m];
                    const f32x4 v0 = acc[ai][bj][m][0] + b0, v1 = acc[ai][bj][m][1] + b1;
                    const float o0 = bflo(zz[0]) * sigmoid_fast(v0[0]), o1 = bfhi(zz[0]) * sigmoid_fast(v0[1]), o2 = bflo(zz[1]) * sigmoid_fast(v0[2]), o3 = bfhi(zz[1]) * sigmoid_fast(v0[3]);
                    const float o4 = bflo(zz[2]) * sigmoid_fast(v1[0]), o5 = bfhi(zz[2]) * sigmoid_fast(v1[1]), o6 = bflo(zz[3]) * sigmoid_fast(v1[2]), o7 = bfhi(zz[3]) * sigmoid_fast(v1[3]);
                    *(u32x4*)(MIX + r * DM + 512 + c) = (u32x4){cvt_pk_bf16(o0, o1), cvt_pk_bf16(o2, o3), cvt_pk_bf16(o4, o5), cvt_pk_bf16(o6, o7)};
                }
        }
    }
};
struct EpiOut {
    static constexpr bool PERM = true;
    const float* X; bf16_t* X1; const float* modv;
    __device__ __forceinline__ void operator()(const f32x4 (&acc)[2][2][4][2], const Unit& u, int wr, int wc, int fr, int fq) const {
        const int row0 = u.pm * BM + wr * 64 + fr, col0 = u.pn * BM + wc * 32 + 8 * fq;
        const float* g1 = modv + ((u.pm * BM) / SEQ) * 6144 + 2048;
#pragma unroll
        for (int bj = 0; bj < 2; ++bj) {
            const int c = col0 + bj * HALF;
            const f32x4 ga = *(const f32x4*)(g1 + c), gb = *(const f32x4*)(g1 + c + 4);
#pragma unroll
            for (int ai = 0; ai < 2; ++ai) {
                f32x4 xa[4], xb[4];
#pragma unroll
                for (int m = 0; m < 4; ++m) { const float* xs = X + (size_t)(row0 + ai * HALF + m * 16) * DM + c; xa[m] = *(const f32x4*)xs; xb[m] = *(const f32x4*)(xs + 4); }
#pragma unroll
                for (int m = 0; m < 4; ++m) { const f32x4 y0 = xa[m] + ga * acc[ai][bj][m][0], y1 = xb[m] + gb * acc[ai][bj][m][1];
                    *(u32x4*)(X1 + (size_t)(row0 + ai * HALF + m * 16) * DM + c) = (u32x4){cvt_pk_bf16(y0[0], y0[1]), cvt_pk_bf16(y0[2], y0[3]), cvt_pk_bf16(y1[0], y1[1]), cvt_pk_bf16(y1[2], y1[3])}; }
            }
        }
    }
};
struct EpiScores {
    static constexpr bool PERM = false;
    float* O;
    __device__ __forceinline__ void operator()(const f32x4 (&acc)[2][2][4][2], const Unit& u, int wr, int wc, int fr, int fq) const {
        const int row0 = u.pm * BM + wr * 64 + fr, col0 = u.pn * BM + wc * 32 + 4 * fq;
#pragma unroll
        for (int ai = 0; ai < 2; ++ai)
#pragma unroll
            for (int m = 0; m < 4; ++m) { float* rowp = O + (size_t)(row0 + ai * HALF + m * 16) * 256 + col0;
#pragma unroll
                for (int bj = 0; bj < 2; ++bj)
#pragma unroll
                    for (int n = 0; n < 2; ++n) { const f32x4 v = acc[ai][bj][m][n];
                        *(f32x4*)(rowp + bj * HALF + n * 16) = (f32x4){sigmoid_fast(v[0]), sigmoid_fast(v[1]), sigmoid_fast(v[2]), sigmoid_fast(v[3])}; } }
    }
};
struct EpiGateUp {
    static constexpr bool PERM = true;
    bf16_t* O;
    __device__ __forceinline__ void operator()(const f32x4 (&acc)[2][2][4][2], const Unit& u, int wr, int wc, int fr, int fq) const {
        const int row0 = u.pm * BM + wr * 64 + fr, col0 = u.pn * HALF + wc * 32 + 8 * fq;
#pragma unroll
        for (int ai = 0; ai < 2; ++ai)
#pragma unroll
            for (int m = 0; m < 4; ++m) {
                const f32x4 g0 = acc[ai][0][m][0], g1 = acc[ai][0][m][1], u0 = acc[ai][1][m][0], u1 = acc[ai][1][m][1];
                int d0 = __builtin_amdgcn_cvt_pk_fp8_f32(silu_fast(g0[0]) * u0[0] * 8.0f, silu_fast(g0[1]) * u0[1] * 8.0f, 0, false); d0 = __builtin_amdgcn_cvt_pk_fp8_f32(silu_fast(g0[2]) * u0[2] * 8.0f, silu_fast(g0[3]) * u0[3] * 8.0f, d0, true);
                int d1 = __builtin_amdgcn_cvt_pk_fp8_f32(silu_fast(g1[0]) * u1[0] * 8.0f, silu_fast(g1[1]) * u1[1] * 8.0f, 0, false); d1 = __builtin_amdgcn_cvt_pk_fp8_f32(silu_fast(g1[2]) * u1[2] * 8.0f, silu_fast(g1[3]) * u1[3] * 8.0f, d1, true);
                *(u32x2*)((char*)O + (size_t)(row0 + ai * HALF + m * 16) * 256 + col0) = (u32x2){(unsigned)d0, (unsigned)d1};
            }
    }
};
struct EpiF32 {
    static constexpr bool PERM = false;
    float* O;
    __device__ __forceinline__ void operator()(const f32x4 (&acc)[2][2][4][2], const Unit& u, int wr, int wc, int fr, int fq) const {
        const int row0 = u.pm * BM + wr * 64 + fr, col0 = u.pn * BM + wc * 32 + 4 * fq;
#pragma unroll
        for (int ai = 0; ai < 2; ++ai)
#pragma unroll
            for (int m = 0; m < 4; ++m) { float* rowp = O + (size_t)(row0 + ai * HALF + m * 16) * DM + col0;
#pragma unroll
                for (int bj = 0; bj < 2; ++bj)
#pragma unroll
                    for (int n = 0; n < 2; ++n) *(f32x4*)(rowp + bj * HALF + n * 16) = acc[ai][bj][m][n]; }
    }
};
struct ExpertSched {
    const LAS int* toff;
    const LAS int* offs;
    const LAS int* cntl;
    const char* gbase; unsigned lda;
    const unsigned short* ltok;
    const char* Ad;
    const char* Bt; size_t bexp; unsigned ldb;
    int ncolt, G, c, total;
    __device__ __forceinline__ bool next(int i, Unit& u) const {
        const int L = i * G + c; if (L >= total) return false;
        int lo = 0, hi = 256;
        while (hi - lo > 1) { const int mid = (lo + hi) >> 1; if (__builtin_amdgcn_readfirstlane(toff[mid]) <= L) lo = mid; else hi = mid; }
        const int lt = L - __builtin_amdgcn_readfirstlane(toff[lo]);
        u.e = lo; u.pm = lt / ncolt; u.pn = lt % ncolt; u.rows = __builtin_amdgcn_readfirstlane(cntl[lo]) - u.pm * BM;
        u.b = Bt + (size_t)lo * bexp + (size_t)u.pn * BM * ldb;
        u.a = Ad ? Ad + (size_t)(__builtin_amdgcn_readfirstlane(offs[lo]) + u.pm * BM) * lda : nullptr;
        return true;
    }
    __device__ __forceinline__ unsigned row_off(const Unit& u, int rl) const {
        const int r = u.pm * BM + rl, cn = __builtin_amdgcn_readfirstlane(cntl[u.e]);
        const int tok = ltok[(size_t)u.e * CAP + (r < cn ? r : 0)];
        return (unsigned)tok * lda;
    }
};
struct EpiExpGU {
    static constexpr bool PERM = true;
    bf16_t* O; const LAS int* offs; const LAS int* cntl;
    __device__ __forceinline__ void operator()(const f32x4 (&acc)[2][2][4][2], const Unit& u, int wr, int wc, int fr, int fq) const {
        const int cn = __builtin_amdgcn_readfirstlane(cntl[u.e]), ro = __builtin_amdgcn_readfirstlane(offs[u.e]);
        const int rl0 = u.pm * BM + wr * 64 + fr, col0 = u.pn * HALF + wc * 32 + 8 * fq;
#pragma unroll
        for (int ai = 0; ai < 2; ++ai)
#pragma unroll
            for (int m = 0; m < 4; ++m) {
                const int rl = rl0 + ai * HALF + m * 16;
                const unsigned ob = (unsigned)(rl < cn ? ro + rl : NL * 8) * 256u + (unsigned)col0;
                const f32x4 g0 = acc[ai][0][m][0] * (1.0f / 32.0f), g1 = acc[ai][0][m][1] * (1.0f / 32.0f), u0 = acc[ai][1][m][0] * (8.0f / 32.0f), u1 = acc[ai][1][m][1] * (8.0f / 32.0f);
                int d0 = __builtin_amdgcn_cvt_pk_fp8_f32(silu_fast(g0[0]) * u0[0], silu_fast(g0[1]) * u0[1], 0, false); d0 = __builtin_amdgcn_cvt_pk_fp8_f32(silu_fast(g0[2]) * u0[2], silu_fast(g0[3]) * u0[3], d0, true);
                int d1 = __builtin_amdgcn_cvt_pk_fp8_f32(silu_fast(g1[0]) * u1[0], silu_fast(g1[1]) * u1[1], 0, false); d1 = __builtin_amdgcn_cvt_pk_fp8_f32(silu_fast(g1[2]) * u1[2], silu_fast(g1[3]) * u1[3], d1, true);
                *(u32x2*)((char*)O + ob) = (u32x2){(unsigned)d0, (unsigned)d1};
            }
    }
};
#define YB_SCALE 8.0f
struct EpiExpDown {
    static constexpr bool PERM = true;
    bf16_t* O; const LAS int* offs; const LAS int* cntl;
    __device__ __forceinline__ void operator()(const f32x4 (&acc)[2][2][4][2], const Unit& u, int wr, int wc, int fr, int fq) const {
        const int cn = __builtin_amdgcn_readfirstlane(cntl[u.e]), ro = __builtin_amdgcn_readfirstlane(offs[u.e]);
        const int rl0 = u.pm * BM + wr * 64 + fr, col0 = u.pn * BM + wc * 32 + 8 * fq;
#pragma unroll
        for (int ai = 0; ai < 2; ++ai)
#pragma unroll
            for (int m = 0; m < 4; ++m) {
                const int rl = rl0 + ai * HALF + m * 16;
                const unsigned ob = (unsigned)(rl < cn ? ro + rl : NL * 8) * DM + (unsigned)col0;
#pragma unroll
                for (int bj = 0; bj < 2; ++bj) { const f32x4 v0 = acc[ai][bj][m][0] * (YB_SCALE / 128.0f), v1 = acc[ai][bj][m][1] * (YB_SCALE / 128.0f);
                    int d0 = __builtin_amdgcn_cvt_pk_fp8_f32(v0[0], v0[1], 0, false); d0 = __builtin_amdgcn_cvt_pk_fp8_f32(v0[2], v0[3], d0, true);
                    int d1 = __builtin_amdgcn_cvt_pk_fp8_f32(v1[0], v1[1], 0, false); d1 = __builtin_amdgcn_cvt_pk_fp8_f32(v1[2], v1[3], d1, true);
                    *(u32x2*)((char*)O + ob + bj * HALF) = (u32x2){(unsigned)d0, (unsigned)d1}; }
            }
    }
};
struct EpiAddG2 {
    static constexpr bool PERM = false;
    float* O; const float* modv;
    __device__ __forceinline__ void operator()(const f32x4 (&acc)[2][2][4][2], const Unit& u, int wr, int wc, int fr, int fq) const {
        const int row0 = u.pm * BM + wr * 64 + fr, col0 = u.pn * BM + wc * 32 + 4 * fq;
        const float* g2 = modv + ((u.pm * BM) / SEQ) * 6144 + 5120;
#pragma unroll
        for (int bj = 0; bj < 2; ++bj)
#pragma unroll
            for (int n = 0; n < 2; ++n) {
                const int c = col0 + bj * HALF + n * 16;
                const f32x4 g = *(const f32x4*)(g2 + c);
                f32x4 xv[8];
#pragma unroll
                for (int ai = 0; ai < 2; ++ai)
#pragma unroll
                    for (int m = 0; m < 4; ++m) xv[ai * 4 + m] = *(const f32x4*)(O + (size_t)(row0 + ai * HALF + m * 16) * DM + c);
#pragma unroll
                for (int ai = 0; ai < 2; ++ai)
#pragma unroll
                    for (int m = 0; m < 4; ++m) *(f32x4*)(O + (size_t)(row0 + ai * HALF + m * 16) * DM + c) = xv[ai * 4 + m] + g * acc[ai][bj][m][n];
            }
    }
};
}

__device__ __forceinline__ float4 ld4(const float* p) { return *(const float4*)p; }
__device__ __forceinline__ float4 ld4(const bf16_t* p) { const u32x2 w = *(const u32x2*)p; return make_float4(bflo(w[0]), bfhi(w[0]), bflo(w[1]), bfhi(w[1])); }
template <bool DUAL, class AF, class EF>
__device__ __forceinline__ void gemm_naive(float* lds, int m0, int n0, int M, int N, int K, AF arow,
                                           const float* __restrict__ B0, const float* __restrict__ B1, int ldb, EF epi) {
    float* As = lds;
    float* Bs0 = lds + 16 * 132;
    float* Bs1 = Bs0 + 16 * 64;
    const int tid = threadIdx.x;
    const int ty = tid >> 4, tx = tid & 15;
    float acc0[4][4], acc1[4][4];
#pragma unroll
    for (int i = 0; i < 4; ++i)
#pragma unroll
        for (int j = 0; j < 4; ++j) { acc0[i][j] = 0.f; acc1[i][j] = 0.f; }
    const int am = tid >> 2, ak = (tid & 3) * 4;
    const int bk = (tid >> 4) & 15, bn = (tid & 15) * 4;
    const bool bthr = tid < 256;
    auto ap = arow((m0 + am < M) ? (m0 + am) : m0);
    const bool aok = (m0 + am) < M;
    const bool bok = bthr && (n0 + bn) < N;
    for (int k0 = 0; k0 < K; k0 += 16) {
        float4 av = aok ? ld4(ap + k0 + ak) : make_float4(0.f, 0.f, 0.f, 0.f);
        float4 bv0 = bok ? *(const float4*)(B0 + (size_t)(k0 + bk) * ldb + n0 + bn) : make_float4(0.f, 0.f, 0.f, 0.f);
        float4 bv1 = make_float4(0.f, 0.f, 0.f, 0.f);
        if (DUAL) bv1 = bok ? *(const float4*)(B1 + (size_t)(k0 + bk) * ldb + n0 + bn) : make_float4(0.f, 0.f, 0.f, 0.f);
        __syncthreads();
        As[(ak + 0) * 132 + am] = av.x; As[(ak + 1) * 132 + am] = av.y; As[(ak + 2) * 132 + am] = av.z; As[(ak + 3) * 132 + am] = av.w;
        if (bthr) { *(float4*)&Bs0[bk * 64 + bn] = bv0; if (DUAL) *(float4*)&Bs1[bk * 64 + bn] = bv1; }
        __syncthreads();
#pragma unroll
        for (int kk = 0; kk < 16; ++kk) {
            const float4 a = *(const float4*)&As[kk * 132 + ty * 4];
            const float4 b = *(const float4*)&Bs0[kk * 64 + tx * 4];
            const float aa[4] = {a.x, a.y, a.z, a.w};
            const float bb[4] = {b.x, b.y, b.z, b.w};
#pragma unroll
            for (int i = 0; i < 4; ++i)
#pragma unroll
                for (int j = 0; j < 4; ++j) acc0[i][j] = fmaf(aa[i], bb[j], acc0[i][j]);
            if (DUAL) {
                const float4 b1 = *(const float4*)&Bs1[kk * 64 + tx * 4];
                const float bb1[4] = {b1.x, b1.y, b1.z, b1.w};
#pragma unroll
                for (int i = 0; i < 4; ++i)
#pragma unroll
                    for (int j = 0; j < 4; ++j) acc1[i][j] = fmaf(aa[i], bb1[j], acc1[i][j]);
            }
        }
    }
#pragma unroll
    for (int i = 0; i < 4; ++i)
#pragma unroll
        for (int j = 0; j < 4; ++j) {
            const int m = m0 + ty * 4 + i, n = n0 + tx * 4 + j;
            if (m < M && n < N) epi(m, n, acc0[i][j], acc1[i][j]);
        }
    __syncthreads();
}

__device__ __forceinline__ void modv_unit(const Params& p, float* lds, int u) {
    float* red = lds + 17 * 1024;
    const int tid = threadIdx.x, col_l = tid & 31, kg = tid >> 5;
    const int col = u * 32 + col_l;
    float acc[17];
#pragma unroll
    for (int b = 0; b < 17; ++b) acc[b] = 0.f;
    for (int k = kg * 64; k < kg * 64 + 64; ++k) {
        const float w = p.ada_w[(size_t)k * 6144 + col];
#pragma unroll
        for (int b = 0; b < 17; ++b) acc[b] = fmaf(lds[b * 1024 + k], w, acc[b]);
    }
#pragma unroll
    for (int b = 0; b < 17; ++b) {
        __syncthreads();
        red[kg * 32 + col_l] = acc[b];
        __syncthreads();
        if (kg == 0) {
            float s = 0.f;
#pragma unroll
            for (int g = 0; g < 16; ++g) s += red[g * 32 + col_l];
            p.modv[b * 6144 + col] = s + p.ada_b[col];
        }
    }
}

struct CvtJob { const float* W; bf16_t* dst; int ldw, N, k0, n0, ldd, map; float f8;
};
#define NJ_DENSE 552
#define NJ_TOTAL (NJ_DENSE + 256 * 96)
__device__ __forceinline__ CvtJob cvt_decode(const Params& p, int u) {
    CvtJob j;
    const int J0 = 264, J1 = J0 + 128, J2 = J1 + 32, J3 = J2 + 32, J4 = J3 + 32, J5 = J4 + 32;
    if (u >= NJ_DENSE) {
        const int v = u - NJ_DENSE, e = v / 96, r = v % 96, which = r >> 5, l = r & 31;
        if (which < 2) { j.W = (which ? p.ew_up : p.ew_gate) + (size_t)e * DM * 256; j.dst = (bf16_t*)((char*)p.eguT + (size_t)e * 512 * DM); j.ldw = 256; j.N = 256; j.k0 = (l >> 2) * 128; j.n0 = (l & 3) * 64; j.ldd = DM; j.map = 2 + which; j.f8 = 32.0f; }
        else { j.W = p.ew_down + (size_t)e * 256 * DM; j.dst = (bf16_t*)((char*)p.edT + (size_t)e * DM * 256); j.ldw = DM; j.N = DM; j.k0 = (l >> 4) * 128; j.n0 = (l & 15) * 64; j.ldd = 256; j.map = 0; j.f8 = 16.0f; }
        return j;
    }
    j.f8 = 0.0f;
    if (u < J0) { j.W = p.w_in; j.dst = p.w_inT; j.ldw = DIN; j.N = DIN; j.k0 = (u / 33) * 128; j.n0 = (u % 33) * 64; j.ldd = DM; j.map = 1; }
    else if (u < J1) { const int l = u - J0; j.W = p.w_out; j.dst = p.w_outT; j.ldw = DM; j.N = DM; j.k0 = (l / 16) * 128; j.n0 = (l % 16) * 64; j.ldd = DM; j.map = 0; }
    else if (u < J2) { const int l = u - J1; j.W = p.glu_w; j.dst = p.gluT; j.ldw = 512; j.N = 512; j.k0 = (l / 8) * 128; j.n0 = (l % 8) * 64; j.ldd = 512; j.map = 0; }
    else if (u < J3) { const int l = u - J2; j.W = p.router_w; j.dst = p.routerT3; j.ldw = 256; j.N = 256; j.k0 = (l / 4) * 128; j.n0 = (l % 4) * 64; j.ldd = 3072; j.map = 4; }
    else if (u < J4) { const int l = u - J3; j.W = p.sw_gate; j.dst = p.shguT; j.ldw = 256; j.N = 256; j.k0 = (l / 4) * 128; j.n0 = (l % 4) * 64; j.ldd = DM; j.map = 2; }
    else if (u < J5) { const int l = u - J4; j.W = p.sw_up; j.dst = p.shguT; j.ldw = 256; j.N = 256; j.k0 = (l / 4) * 128; j.n0 = (l % 4) * 64; j.ldd = DM; j.map = 3; }
    else { const int l = u - J5; j.W = p.sw_down; j.dst = p.shdT; j.ldw = DM; j.N = DM; j.k0 = (l / 16) * 128; j.n0 = (l % 16) * 64; j.ldd = 256; j.map = 0; j.f8 = 16.0f; }
    return j;
}
__device__ __forceinline__ int cvt_rowmap(int map, int c) {
    if (map == 1) return c < S_LR ? c : (c < S_U ? (WC_LR + (c - S_LR)) : (WC_U + (c - S_U)));
    if (map == 2) return (c >> 7) * 256 + (c & 127);
    if (map == 3) return (c >> 7) * 256 + 128 + (c & 127);
    return c;
}
__device__ __forceinline__ void cvt_load(const CvtJob& j, float4 (&r)[4]) {
    const int tid = threadIdx.x;
#pragma unroll
    for (int i = 0; i < 2; ++i) {
        const int kk = (j.f8 != 0.0f) ? (tid >> 4) * 4 + 2 * i : (tid >> 4) * 2 + 64 * i, n = j.n0 + (tid & 15) * 4;
        r[2 * i] = make_float4(0.f, 0.f, 0.f, 0.f); r[2 * i + 1] = r[2 * i];
        if (n < j.N) { r[2 * i] = *(const float4*)(j.W + (size_t)(j.k0 + kk) * j.ldw + n); r[2 * i + 1] = *(const float4*)(j.W + (size_t)(j.k0 + kk + 1) * j.ldw + n); }
    }
}
__device__ __forceinline__ void cvt_fill(const CvtJob& j, const float4 (&r)[4], unsigned* T, unsigned* T2) {
    const int tid = threadIdx.x;
    if (j.f8 != 0.0f) {
        const int nl = (tid & 15) * 4, kq = tid >> 4; const float s = j.f8;
        const float a0[4] = {r[0].x, r[0].y, r[0].z, r[0].w}, a1[4] = {r[1].x, r[1].y, r[1].z, r[1].w}, a2[4] = {r[2].x, r[2].y, r[2].z, r[2].w}, a3[4] = {r[3].x, r[3].y, r[3].z, r[3].w};
#pragma unroll
        for (int q = 0; q < 4; ++q) { int w = __builtin_amdgcn_cvt_pk_fp8_f32(a0[q] * s, a1[q] * s, 0, false); w = __builtin_amdgcn_cvt_pk_fp8_f32(a2[q] * s, a3[q] * s, w, true); T[(nl + q) * 33 + kq] = (unsigned)w; }
        return;
    }
#pragma unroll
    for (int i = 0; i < 2; ++i) {
        const int kk = (tid >> 4) * 2 + 64 * i, nl = (tid & 15) * 4;
        const float av[4] = {r[2 * i].x, r[2 * i].y, r[2 * i].z, r[2 * i].w}, bv[4] = {r[2 * i + 1].x, r[2 * i + 1].y, r[2 * i + 1].z, r[2 * i + 1].w};
#pragma unroll
        for (int q = 0; q < 4; ++q) {
            const unsigned w = cvt_pk_bf16(av[q], bv[q]);
            T[(nl + q) * 65 + (kk >> 1)] = w;
            if (j.map == 4) T2[(nl + q) * 65 + (kk >> 1)] = cvt_pk_bf16(av[q] - bflo(w), bv[q] - bfhi(w));
        }
    }
}
__device__ __forceinline__ void cvt_drain(const CvtJob& j, const unsigned* T, const unsigned* T2) {
    const int tid = threadIdx.x;
    const int n_l = tid >> 3, seg = tid & 7;
    if (j.f8 != 0.0f) {
        if (j.n0 + n_l < j.N) {
            const int rr = cvt_rowmap(j.map, j.n0 + n_l);
            u32x4 w0;
#pragma unroll
            for (int w = 0; w < 4; ++w) w0[w] = T[n_l * 33 + seg * 4 + w];
            *(u32x4*)((char*)j.dst + (size_t)rr * j.ldd + j.k0 + seg * 16) = w0;
        }
        return;
    }
    if (j.n0 + n_l < j.N) {
        const int rr = cvt_rowmap(j.map, j.n0 + n_l);
        u32x4 w0, w1;
#pragma unroll
        for (int w = 0; w < 4; ++w) { w0[w] = T[n_l * 65 + seg * 8 + w]; w1[w] = T[n_l * 65 + seg * 8 + 4 + w]; }
        bf16_t* d = j.dst + (size_t)rr * j.ldd + j.k0 + seg * 16;
        *(u32x4*)d = w0; *(u32x4*)(d + 8) = w1;
        if (j.map == 4) {
            *(u32x4*)(d + 1024) = w0; *(u32x4*)(d + 1032) = w1;
#pragma unroll
            for (int w = 0; w < 4; ++w) { w0[w] = T2[n_l * 65 + seg * 8 + w]; w1[w] = T2[n_l * 65 + seg * 8 + 4 + w]; }
            *(u32x4*)(d + 2048) = w0; *(u32x4*)(d + 2056) = w1;
        }
    }
}

__device__ __forceinline__ void phase_prologue(const Params& p, float* lds, const int part) {
    const int tid = threadIdx.x, bid = blockIdx.x, nb = gridDim.x;
    if (part == 0) {
    if (bid < 192) {
        for (int i = tid; i < 17 * 1024; i += NT) {
            const int b = i >> 10, k = i & 1023;
            lds[i] = siluf_((b < 16) ? p.c[b * 1024 + k] : p.c_ctx[k]);
        }
        __syncthreads();
        for (int u = bid; u < 192; u += nb) modv_unit(p, lds, u);
        __syncthreads();
    }
    { u32x4* zp = (u32x4*)(p.w_inT + (size_t)DIN * DM); const int nz = (2304 - DIN) * DM * 2 / 16;
      for (int i = bid * NT + tid; i < nz; i += nb * NT) zp[i] = (u32x4){0u, 0u, 0u, 0u}; }
    return;
    }
    unsigned* Tb = (unsigned*)lds;
    int u = nb - 1 - bid, par = 0;
    if (u < NJ_TOTAL) {
        CvtJob jA = cvt_decode(p, u), jB = jA; float4 rA[4], rB[4];
        bool hB = (u + nb) < NJ_TOTAL;
        cvt_load(jA, rA);
        if (hB) { jB = cvt_decode(p, u + nb); cvt_load(jB, rB); } else { for (int q = 0; q < 4; ++q) rB[q] = rA[q]; }
        for (;;) {
            const int un = u + 2 * nb; const bool hnA = un < NJ_TOTAL, hnB = (un + nb) < NJ_TOTAL;
            CvtJob jnA = jA, jnB = jB; float4 rnA[4], rnB[4];
            if (hnA) { jnA = cvt_decode(p, un); cvt_load(jnA, rnA); } else { for (int q = 0; q < 4; ++q) rnA[q] = rA[q]; }
            if (hnB) { jnB = cvt_decode(p, un + nb); cvt_load(jnB, rnB); } else { for (int q = 0; q < 4; ++q) rnB[q] = rB[q]; }
            unsigned* T0 = Tb + (par * 2 + 0) * (64 * 65); unsigned* T1 = Tb + (par * 2 + 1) * (64 * 65); unsigned* T2 = Tb + 4 * (64 * 65);
            cvt_fill(jA, rA, T0, T2);
            if (hB) cvt_fill(jB, rB, T1, T2);
            __syncthreads();
            cvt_drain(jA, T0, T2);
            if (hB) cvt_drain(jB, T1, T2);
            if (jA.map == 4 || jB.map == 4) __syncthreads();
            if (!hnA) break;
            par ^= 1; u = un; jA = jnA; jB = jnB; hB = hnB;
#pragma unroll
            for (int q = 0; q < 4; ++q) { rA[q] = rnA[q]; rB[q] = rnB[q]; }
        }
    }
    __syncthreads();
}

__device__ __forceinline__ void phase_norm_mod(const Params& p, int which) {
    const int lane = threadIdx.x & 63, wave = threadIdx.x >> 6;
    const int nrows = which == 0 ? NR : NL;
    const float* g = which == 0 ? p.norm1_g : p.norm2_g;
    const int osh = which == 0 ? 0 : 3072, osc = which == 0 ? 1024 : 4096;
    auto rowsrc = [&](int r) -> const float* {
        if (which == 0) return (r < NL) ? p.x + (size_t)r * DM : p.ctx + (size_t)(r - NL) * DM;
        return p.out + (size_t)r * DM;
    };
    const int stride = gridDim.x * NWAVES, rbase = blockIdx.x * NWAVES + wave;
    float4 ring[3][4];
#pragma unroll
    for (int k = 0; k < 3; ++k) if (rbase + k * stride < nrows) { const float* s0 = rowsrc(rbase + k * stride);
#pragma unroll
        for (int i = 0; i < 2; ++i) {
            if (which == 1) ring[k][i] = __builtin_bit_cast(float4, *(const u32x4*)(p.yf + (size_t)(rbase + k * stride) * DM + i * 512 + lane * 8));
            else { ring[k][2 * i] = *(const float4*)(s0 + i * 512 + lane * 8); ring[k][2 * i + 1] = *(const float4*)(s0 + i * 512 + lane * 8 + 4); } } }
    for (int r0 = rbase; r0 < nrows; r0 += 3 * stride) {
#pragma unroll
      for (int k = 0; k < 3; ++k) {
        const int r = r0 + k * stride;
        if (r >= nrows) break;
        const int b = (which == 0 && r >= NL) ? 16 : r / SEQ;
        float4 v[4]; float ss = 0.f;
#pragma unroll
        for (int i = 0; i < 4; ++i) v[i] = ring[k][i];
        if (which == 1) {
#pragma unroll
            for (int i = 0; i < 2; ++i) { const u32x4 w_ = __builtin_bit_cast(u32x4, ring[k][i]);
                v[2 * i] = make_float4(bflo(w_[0]), bfhi(w_[0]), bflo(w_[1]), bfhi(w_[1])); v[2 * i + 1] = make_float4(bflo(w_[2]), bfhi(w_[2]), bflo(w_[3]), bfhi(w_[3])); }
        }
        {
            const int rn = r + 3 * stride;
            if (rn < nrows) { const float* s1 = rowsrc(rn);
#pragma unroll
                for (int i = 0; i < 2; ++i) {
                    if (which == 1) ring[k][i] = __builtin_bit_cast(float4, *(const u32x4*)(p.yf + (size_t)rn * DM + i * 512 + lane * 8));
                    else { ring[k][2 * i] = *(const float4*)(s1 + i * 512 + lane * 8); ring[k][2 * i + 1] = *(const float4*)(s1 + i * 512 + lane * 8 + 4); } } }
        }
#pragma unroll
        for (int i = 0; i < 4; ++i) ss += v[i].x * v[i].x + v[i].y * v[i].y + v[i].z * v[i].z + v[i].w * v[i].w;
        ss = wave_sum(ss);
        const float rstd = rsqrtf(ss * (1.0f / DM) + EPS);
        const float* mv = p.modv + b * 6144;
#pragma unroll
        for (int i = 0; i < 2; ++i) {
            const int col = i * 512 + lane * 8;
            float o[8];
#pragma unroll
            for (int h = 0; h < 2; ++h) {
                const float4 gg = *(const float4*)(g + col + 4 * h), sh = *(const float4*)(mv + osh + col + 4 * h), sc = *(const float4*)(mv + osc + col + 4 * h);
                const float4 vv = v[2 * i + h];
                o[4 * h + 0] = vv.x * rstd * gg.x * (1.f + sc.x) + sh.x; o[4 * h + 1] = vv.y * rstd * gg.y * (1.f + sc.y) + sh.y;
                o[4 * h + 2] = vv.z * rstd * gg.z * (1.f + sc.z) + sh.z; o[4 * h + 3] = vv.w * rstd * gg.w * (1.f + sc.w) + sh.w;
            }
            u32x4 hi = (u32x4){cvt_pk_bf16(o[0], o[1]), cvt_pk_bf16(o[2], o[3]), cvt_pk_bf16(o[4], o[5]), cvt_pk_bf16(o[6], o[7])};
            if (which == 0) {
                *(u32x4*)(p.hx + (size_t)r * DM + col) = hi;
            } else {
                *(u32x4*)(p.hx + (size_t)r * DM + col) = hi;
                { int d0 = __builtin_amdgcn_cvt_pk_fp8_f32(o[0], o[1], 0, false); d0 = __builtin_amdgcn_cvt_pk_fp8_f32(o[2], o[3], d0, true);
                  int d1 = __builtin_amdgcn_cvt_pk_fp8_f32(o[4], o[5], 0, false); d1 = __builtin_amdgcn_cvt_pk_fp8_f32(o[6], o[7], d1, true);
                  *(u32x2*)((char*)p.of + (size_t)r * DM + col) = (u32x2){(unsigned)d0, (unsigned)d1}; }
            }
        }
    }
    }
}

__device__ __forceinline__ int scan_row(int b, int dir, int s, bool& lat) {
    if (s < CTX) { lat = false; const int t = dir ? (CTX - 1 - s) : s; return NL + b * CTX + t; }
    lat = true; const int t = dir ? (SEQ - 1 - (s - CTX)) : (s - CTX); return b * SEQ + t;
}

#define GL_LD 72
__device__ __forceinline__ void gla_chunk_unit(const Params& p, unsigned char* lds8, int unit) {
    const int dir = unit & 1, h = (unit >> 1) & 3, b = unit >> 3;
    const int tid = threadIdx.x, lane = tid & 63, w = __builtin_amdgcn_readfirstlane(tid >> 6), fr = lane & 15, fq = lane >> 4;
    const int tc = tid >> 3, g8 = tid & 7;
    bf16_t* Qc = (bf16_t*)lds8;            bf16_t* Ki = Qc + 64 * GL_LD;   bf16_t* Pm = Ki + 64 * GL_LD;
    bf16_t* KsT = Pm + 64 * GL_LD;         bf16_t* VT = KsT + 64 * GL_LD;  bf16_t* ST = VT + 128 * GL_LD;
    float* LA = (float*)(ST + 128 * GL_LD); float* SEG = LA + 64 * 64;      float* LR = SEG + 8 * 64;
    float* WA = LR + 64 * 16;              float* BA = WA + 16 * 64;       float* DEC = BA + 64;   float* CL = DEC + 64;
    const float* wa = dir ? p.wa_b : p.wa_f;
    const float* ba = dir ? p.ba_b : p.ba_f;
    __syncthreads();
    for (int i = tid; i < 100 * 1024 / 4; i += NT) ((unsigned*)lds8)[i] = 0u;
    __syncthreads();
    f32x4 accS[4];
#pragma unroll
    for (int j = 0; j < 4; ++j) accS[j] = (f32x4){0.f, 0.f, 0.f, 0.f};
    const int tm = w >> 1, pr = w & 1;
    bf16x8 wfrag[2]; f32x4 bav[2];
#pragma unroll
    for (int j = 0; j < 2; ++j) {
        const int dk0 = (pr * 2 + j) * 16;
        u32x4 wv = (u32x4){0u, 0u, 0u, 0u};
        if (fq < 2) {
            float t8[8];
#pragma unroll
            for (int i = 0; i < 8; ++i) t8[i] = wa[(fq * 8 + i) * 256 + h * 64 + dk0 + fr];
            wv = (u32x4){cvt_pk_bf16(t8[0], t8[1]), cvt_pk_bf16(t8[2], t8[3]), cvt_pk_bf16(t8[4], t8[5]), cvt_pk_bf16(t8[6], t8[7])};
        }
        wfrag[j] = __builtin_bit_cast(bf16x8, wv);
        bav[j] = (f32x4){ba[h * 64 + dk0 + fq * 4], ba[h * 64 + dk0 + fq * 4 + 1], ba[h * 64 + dk0 + fq * 4 + 2], ba[h * 64 + dk0 + fq * 4 + 3]};
    }
    auto row_of = [&](int sc, int c) -> int {
        if (sc < 4) { const int tok = dir ? ((3 - sc) * 64 + 63 - c) : (sc * 64 + c); return NL + b * CTX + tok; }
        const int n = sc - 4; const int tok = dir ? ((31 - n) * 64 + 63 - c) : (n * 64 + c); return b * SEQ + tok;
    };
    u32x4 rq, rk, rv, rv2; unsigned rl;
    {
        const bf16_t* pr0 = p.proj + (size_t)row_of(0, tc) * DINP;
        rq = *(const u32x4*)(pr0 + P_Q + h * 64 + g8 * 8); rk = *(const u32x4*)(pr0 + P_K + h * 64 + g8 * 8);
        rv = *(const u32x4*)(pr0 + P_V + h * 128 + g8 * 16); rv2 = *(const u32x4*)(pr0 + P_V + h * 128 + g8 * 16 + 8); rl = *(const unsigned*)(pr0 + P_LRF + dir * 16 + g8 * 2);
    }
    for (int sc = 0; sc < 36; ++sc) {
        const bool lat = sc >= 4;
        const u32x4 cq = rq, ck = rk, cv = rv, cv2 = rv2; const unsigned cl_ = rl;
        if (sc + 1 < 36) {
            const bf16_t* pr1 = p.proj + (size_t)row_of(sc + 1, tc) * DINP;
            rq = *(const u32x4*)(pr1 + P_Q + h * 64 + g8 * 8); rk = *(const u32x4*)(pr1 + P_K + h * 64 + g8 * 8);
            rv = *(const u32x4*)(pr1 + P_V + h * 128 + g8 * 16); rv2 = *(const u32x4*)(pr1 + P_V + h * 128 + g8 * 16 + 8); rl = *(const unsigned*)(pr1 + P_LRF + dir * 16 + g8 * 2);
        }
        ((unsigned*)LR)[tc * 8 + g8] = cl_;
        __syncthreads();
        {
            u32x4 lv = (u32x4){0u, 0u, 0u, 0u};
            if (fq < 2) lv = *(const u32x4*)((const unsigned char*)LR + (tm * 16 + fr) * 32 + fq * 16);
            const bf16x8 lrf = __builtin_bit_cast(bf16x8, lv);
#pragma unroll
            for (int j = 0; j < 2; ++j) {
                f32x4 z = __builtin_amdgcn_mfma_f32_16x16x32_bf16(wfrag[j], lrf, (f32x4){0.f, 0.f, 0.f, 0.f}, 0, 0, 0);
                asm volatile("s_nop 15\n\ts_nop 15" : "+v"(z));
                z = z + bav[j];
                f32x4 o;
#pragma unroll
                for (int r = 0; r < 4; ++r) {
                    const float e = __builtin_amdgcn_exp2f(-fabsf(z[r]) * 1.4426950408889634f);
                    o[r] = (fminf(z[r], 0.0f) - __builtin_amdgcn_logf(1.0f + e) * 0.6931471805599453f) * (1.0f / 16.0f);
                }
                *(f32x4*)(LA + (tm * 16 + fr) * 64 + (pr * 2 + j) * 16 + fq * 4) = o;
            }
        }
        __syncthreads();
        {
            const int dk = tid & 63, sg = tid >> 6; float run = 0.f;
#pragma unroll
            for (int i = 0; i < 8; ++i) { run += LA[(sg * 8 + i) * 64 + dk]; LA[(sg * 8 + i) * 64 + dk] = run; }
            SEG[sg * 64 + dk] = run;
        }
        __syncthreads();
        if (tid < 64) {
            float run = 0.f;
#pragma unroll
            for (int s = 0; s < 8; ++s) { const float t = SEG[s * 64 + tid]; SEG[s * 64 + tid] = run; run += t; }
            CL[tid] = run; DEC[tid] = __builtin_amdgcn_exp2f(run * 1.4426950408889634f);
        }
        __syncthreads();
        {
            const float qv[8] = {bflo(cq[0]), bfhi(cq[0]), bflo(cq[1]), bfhi(cq[1]), bflo(cq[2]), bfhi(cq[2]), bflo(cq[3]), bfhi(cq[3])};
            const float kv[8] = {bflo(ck[0]), bfhi(ck[0]), bflo(ck[1]), bfhi(ck[1]), bflo(ck[2]), bfhi(ck[2]), bflo(ck[3]), bfhi(ck[3])};
            float qo[8], ko[8], ks[8];
#pragma unroll
            for (int i = 0; i < 8; ++i) {
                const int dk = g8 * 8 + i;
                const float cum = LA[tc * 64 + dk] + SEG[(tc >> 3) * 64 + dk];
                const float ec = __builtin_amdgcn_exp2f(cum * 1.4426950408889634f), en = __builtin_amdgcn_rcpf(ec), es = DEC[dk] * en;
                qo[i] = qv[i] * 0.125f * ec; ko[i] = kv[i] * en; ks[i] = kv[i] * es;
            }
#pragma unroll
            for (int i = 0; i < 8; i += 2) { const unsigned pk = cvt_pk_bf16(ks[i], ks[i + 1]);
                KsT[(g8 * 8 + i) * GL_LD + tc] = (bf16_t)(pk & 0xFFFFu); KsT[(g8 * 8 + i + 1) * GL_LD + tc] = (bf16_t)(pk >> 16); }
            *(u32x4*)(Qc + tc * GL_LD + g8 * 8) = (u32x4){cvt_pk_bf16(qo[0], qo[1]), cvt_pk_bf16(qo[2], qo[3]), cvt_pk_bf16(qo[4], qo[5]), cvt_pk_bf16(qo[6], qo[7])};
            *(u32x4*)(Ki + tc * GL_LD + g8 * 8) = (u32x4){cvt_pk_bf16(ko[0], ko[1]), cvt_pk_bf16(ko[2], ko[3]), cvt_pk_bf16(ko[4], ko[5]), cvt_pk_bf16(ko[6], ko[7])};
#pragma unroll
            for (int i = 0; i < 4; ++i) { VT[(g8 * 16 + 2 * i) * GL_LD + tc] = (bf16_t)(cv[i] & 0xFFFFu); VT[(g8 * 16 + 2 * i + 1) * GL_LD + tc] = (bf16_t)(cv[i] >> 16);
                                          VT[(g8 * 16 + 8 + 2 * i) * GL_LD + tc] = (bf16_t)(cv2[i] & 0xFFFFu); VT[(g8 * 16 + 9 + 2 * i) * GL_LD + tc] = (bf16_t)(cv2[i] >> 16); }
        }
        __syncthreads();
        f32x4 accO[4];
#pragma unroll
        for (int j = 0; j < 4; ++j) accO[j] = (f32x4){0.f, 0.f, 0.f, 0.f};
        bf16x8 yq[2];
        if (lat) {
#pragma unroll
            for (int kk = 0; kk < 2; ++kk) yq[kk] = *(const bf16x8*)(Qc + (tm * 16 + fr) * GL_LD + kk * 32 + fq * 8);
#pragma unroll
            for (int j = 0; j < 2; ++j) {
                const int ts = pr * 2 + j;
                f32x4 d = (f32x4){0.f, 0.f, 0.f, 0.f};
                if (ts <= tm) {
#pragma unroll
                    for (int kk = 0; kk < 2; ++kk) { const bf16x8 xk = *(const bf16x8*)(Ki + (ts * 16 + fr) * GL_LD + kk * 32 + fq * 8);
                        d = __builtin_amdgcn_mfma_f32_16x16x32_bf16(xk, yq[kk], d, 0, 0, 0); }
                    asm volatile("s_nop 15\n\ts_nop 15" : "+v"(d));
                    if (ts == tm) {
#pragma unroll
                        for (int r = 0; r < 4; ++r) d[r] = (fq * 4 + r <= fr) ? d[r] : 0.f;
                    }
                }
                *(u32x2*)(Pm + (tm * 16 + fr) * GL_LD + ts * 16 + fq * 4) = (u32x2){cvt_pk_bf16(d[0], d[1]), cvt_pk_bf16(d[2], d[3])};
            }
#pragma unroll
            for (int j = 0; j < 4; ++j) {
                const int tv = pr * 4 + j;
#pragma unroll
                for (int kk = 0; kk < 2; ++kk) { const bf16x8 xs = *(const bf16x8*)(ST + (tv * 16 + fr) * GL_LD + kk * 32 + fq * 8);
                    accO[j] = __builtin_amdgcn_mfma_f32_16x16x32_bf16(xs, yq[kk], accO[j], 0, 0, 0); }
            }
        }
        __syncthreads();
        {
            bf16x8 yp[2];
            if (lat) {
#pragma unroll
                for (int kk = 0; kk < 2; ++kk) yp[kk] = *(const bf16x8*)(Pm + (tm * 16 + fr) * GL_LD + kk * 32 + fq * 8);
            }
            const int orow = row_of(sc, tm * 16 + fr);
#pragma unroll
            for (int j = 0; j < 4; ++j) {
                const int tv = pr * 4 + j;
                bf16x8 xv[2];
#pragma unroll
                for (int kk = 0; kk < 2; ++kk) xv[kk] = *(const bf16x8*)(VT + (tv * 16 + fr) * GL_LD + kk * 32 + fq * 8);
                if (lat) {
#pragma unroll
                    for (int kk = 0; kk < 2; ++kk) accO[j] = __builtin_amdgcn_mfma_f32_16x16x32_bf16(xv[kk], yp[kk], accO[j], 0, 0, 0);
                    asm volatile("s_nop 15\n\ts_nop 15" : "+v"(accO[j]));
                    *(u32x2*)(p.of + ((size_t)dir * NL + orow) * 512 + h * 128 + tv * 16 + fq * 4) = (u32x2){cvt_pk_bf16(accO[j][0], accO[j][1]), cvt_pk_bf16(accO[j][2], accO[j][3])};
                }
                const f32x4 dc = *(const f32x4*)(DEC + tm * 16 + fq * 4);
                accS[j] = accS[j] * dc;
                asm volatile("s_nop 15\n\ts_nop 15" : "+v"(accS[j]));
#pragma unroll
                for (int kk = 0; kk < 2; ++kk) { const bf16x8 xks = *(const bf16x8*)(KsT + (tm * 16 + fr) * GL_LD + kk * 32 + fq * 8);
                    accS[j] = __builtin_amdgcn_mfma_f32_16x16x32_bf16(xks, xv[kk], accS[j], 0, 0, 0); }
                asm volatile("s_nop 15\n\ts_nop 15" : "+v"(accS[j]));
                *(u32x2*)(ST + (tv * 16 + fr) * GL_LD + tm * 16 + fq * 4) = (u32x2){cvt_pk_bf16(accS[j][0], accS[j][1]), cvt_pk_bf16(accS[j][2], accS[j][3])};
            }
        }
        __syncthreads();
    }
}

template <int dir> __device__ __forceinline__ void s5_wave_chain(const Params& p, int unit, unsigned char* wlds) {
    const int lane = threadIdx.x & 63, fr = lane & 15, fq = lane >> 4;
    const int g = (unit >> 1) & 31, b = unit >> 6;
    float* BU = (float*)wlds;
    bf16_t* XB = (bf16_t*)(wlds + 128 * 20 * 4);
    const float* lre = dir ? p.lam_re_b : p.lam_re_f;
    const float* lim = dir ? p.lam_im_b : p.lam_im_f;
    const float* lst = dir ? p.lstep_b : p.lstep_f;
    const float* cre = dir ? p.c_re_b : p.c_re_f;
    const float* cim = dir ? p.c_im_b : p.c_im_f;
    float a_re, a_im;
    {
        const float lam_re = lre[g * 64 + lane], lam_im = lim[g * 64 + lane];
        const float step = expf(lst[g]);
        const float mag = expf(lam_re * step);
        a_re = mag * cosf(lam_im * step); a_im = mag * sinf(lam_im * step);
    }
    bf16x8 yb[2][4];
#pragma unroll
    for (int st = 0; st < 4; ++st) {
        const int pp = st * 16 + fr;
        const float lam_re = lre[g * 64 + pp], lam_im = lim[g * 64 + pp];
        const float step = expf(lst[g]);
        const float mag = expf(lam_re * step);
        const float ar = mag * cosf(lam_im * step), ai = mag * sinf(lam_im * step);
        const float den = lam_re * lam_re + lam_im * lam_im;
        const float f_re = ((ar - 1.0f) * lam_re + ai * lam_im) / den;
        const float f_im = (ai * lam_re - (ar - 1.0f) * lam_im) / den;
        u32x4 wr_ = (u32x4){0u, 0u, 0u, 0u}, wi_ = wr_;
        if (fq < 2) {
            float vr[8], vi[8];
#pragma unroll
            for (int j = 0; j < 8; ++j) { const float br = p.b_re[(g * 64 + pp) * 16 + fq * 8 + j], bi = p.b_im[(g * 64 + pp) * 16 + fq * 8 + j];
                vr[j] = f_re * br - f_im * bi; vi[j] = f_re * bi + f_im * br; }
            wr_ = (u32x4){cvt_pk_bf16(vr[0], vr[1]), cvt_pk_bf16(vr[2], vr[3]), cvt_pk_bf16(vr[4], vr[5]), cvt_pk_bf16(vr[6], vr[7])};
            wi_ = (u32x4){cvt_pk_bf16(vi[0], vi[1]), cvt_pk_bf16(vi[2], vi[3]), cvt_pk_bf16(vi[4], vi[5]), cvt_pk_bf16(vi[6], vi[7])};
        }
        yb[0][st] = __builtin_bit_cast(bf16x8, wr_); yb[1][st] = __builtin_bit_cast(bf16x8, wi_);
    }
    bf16x8 cb[4];
#pragma unroll
    for (int kk = 0; kk < 4; ++kk) {
        float v[8];
#pragma unroll
        for (int j = 0; j < 8; ++j) { const int s = kk * 16 + fq * 4 + (j >> 1);
            v[j] = (j & 1) ? -cim[(g * 16 + fr) * 64 + s] : cre[(g * 16 + fr) * 64 + s]; }
        cb[kk] = __builtin_bit_cast(bf16x8, (u32x4){cvt_pk_bf16(v[0], v[1]), cvt_pk_bf16(v[2], v[3]), cvt_pk_bf16(v[4], v[5]), cvt_pk_bf16(v[6], v[7])});
    }
    auto crow = [&](int n) -> int { return (n < 16) ? (S5_ROWS - 256 + b * 16 + (dir ? 15 - n : n)) : (b * 128 + (dir ? 127 - (n - 16) : (n - 16))); };
    const bf16_t* Agg = p.Ag + (size_t)g * S5_ROWS * 512;
    const int tokidx = dir ? 15 - fr : fr;
    u32x4 rr[4];
#pragma unroll
    for (int k = 0; k < 4; ++k) { rr[k] = (u32x4){0u, 0u, 0u, 0u}; if (fq < 2) rr[k] = *(const u32x4*)(Agg + (size_t)crow(k) * 512 + tokidx * 16 + fq * 8); }
    f32x2_t X = {0.f, 0.f};
    const f32x2_t Are = {a_re, a_re}, Aimn = {-a_im, a_im};
    for (int i = lane; i < S5_WLDS / 4; i += 64) ((unsigned*)wlds)[i] = 0u;
    asm volatile("s_waitcnt lgkmcnt(0)" ::: "memory");
    for (int n4 = 0; n4 < 144; n4 += 4) {
#pragma unroll
      for (int k4 = 0; k4 < 4; ++k4) {
        const int n = n4 + k4;
        const bf16x8 xa = __builtin_bit_cast(bf16x8, rr[k4]);
        if (n + 4 < 144 && fq < 2) rr[k4] = *(const u32x4*)(Agg + (size_t)crow(n + 4) * 512 + tokidx * 16 + fq * 8);
        f32x4 d[2][4];
#pragma unroll
        for (int part = 0; part < 2; ++part)
#pragma unroll
            for (int st = 0; st < 4; ++st)
                d[part][st] = __builtin_amdgcn_mfma_f32_16x16x32_bf16(xa, yb[part][st], (f32x4){0.f, 0.f, 0.f, 0.f}, 0, 0, 0);
        asm volatile("s_nop 15\n\ts_nop 15" : "+v"(d[0][0]), "+v"(d[0][1]), "+v"(d[0][2]), "+v"(d[0][3]), "+v"(d[1][0]), "+v"(d[1][1]), "+v"(d[1][2]), "+v"(d[1][3]));
#pragma unroll
        for (int part = 0; part < 2; ++part)
#pragma unroll
            for (int st = 0; st < 4; ++st) if (part == 0) {
                float* bw = BU + (st * 16 + fr) * 36 + fq * 8;
                *(f32x4*)bw = (f32x4){d[0][st][0], d[1][st][0], d[0][st][1], d[1][st][1]};
                *(f32x4*)(bw + 4) = (f32x4){d[0][st][2], d[1][st][2], d[0][st][3], d[1][st][3]};
            }
        asm volatile("s_waitcnt lgkmcnt(0)" ::: "memory");
        {
            f32x4 b4[8];
#pragma unroll
            for (int q = 0; q < 8; ++q) b4[q] = *(const f32x4*)(BU + lane * 36 + q * 4);
#pragma unroll
            for (int t = 0; t < 16; ++t) {
                const f32x2_t Bt_ = {b4[t >> 1][(t & 1) * 2], b4[t >> 1][(t & 1) * 2 + 1]};
                const f32x2_t T_ = __builtin_elementwise_fma(Are, X, Bt_);
                f32x2_t Xs_ = {X[1], X[0]}; asm volatile("" : "+v"(Xs_));
                X = __builtin_elementwise_fma(Aimn, Xs_, T_);
                ((unsigned*)XB)[t * 68 + lane] = cvt_pk_bf16(X[0], X[1]);
            }
        }
        asm volatile("s_waitcnt lgkmcnt(0)" ::: "memory");
        if (n >= 16) {
            f32x4 y = (f32x4){0.f, 0.f, 0.f, 0.f};
#pragma unroll
            for (int kk = 0; kk < 4; ++kk) {
                const bf16x8 xf = *(const bf16x8*)(XB + fr * 136 + kk * 32 + fq * 8);
                y = __builtin_amdgcn_mfma_f32_16x16x32_bf16(xf, cb[kk], y, 0, 0, 0);
            }
            asm volatile("s_nop 15\n\ts_nop 15" : "+v"(y));
            const int row0 = crow(n) * 16;
#pragma unroll
            for (int r = 0; r < 4; ++r) { const int sp = fq * 4 + r, tk = dir ? 15 - sp : sp;
                p.yf[((size_t)dir * NL + row0 + tk) * 512 + g * 16 + fr] = f2bf(y[r]); }
        }
        asm volatile("s_waitcnt lgkmcnt(0)" ::: "memory");
      }
    }
}

__device__ __forceinline__ void phase_scans(const Params& p, float* lds) {
    const int bid = blockIdx.x, nb = gridDim.x;
    if (nb >= 256) {
        if (bid < 128) gla_chunk_unit(p, (unsigned char*)lds, bid);
        else {
            const int w = __builtin_amdgcn_readfirstlane(threadIdx.x >> 6), c = (bid - 128) * 8 + w;
            if (c & 1) s5_wave_chain<1>(p, c, (unsigned char*)lds + w * S5_WLDS); else s5_wave_chain<0>(p, c, (unsigned char*)lds + w * S5_WLDS);
        }
    } else {
        for (int u = bid; u < 128; u += nb) gla_chunk_unit(p, (unsigned char*)lds, u);
        __syncthreads();
        const int w = __builtin_amdgcn_readfirstlane(threadIdx.x >> 6);
        for (int c = bid * 8 + w; c < 1024; c += nb * 8) { if (c & 1) s5_wave_chain<1>(p, c, (unsigned char*)lds + w * S5_WLDS); else s5_wave_chain<0>(p, c, (unsigned char*)lds + w * S5_WLDS); }
    }
}

__device__ __forceinline__ void lr_columns(const Params& p, unsigned char* lds8) {
    const int tid = threadIdx.x, lane = tid & 63, w = tid >> 6, fr = lane & 15, fq = lane >> 4;
    bf16_t* W = (bf16_t*)lds8;
    const bool split = gridDim.x == 256;
    if (split && blockIdx.x < 128) return;
    const int wg = split ? blockIdx.x - 128 : blockIdx.x, nwg = split ? 128 : gridDim.x;
    __syncthreads();
    for (int i = tid; i < 32 * 128; i += NT) { const int n = i >> 7, c = i & 127; *(u32x4*)(W + n * 1032 + c * 8) = *(const u32x4*)(p.w_inT + (size_t)(WC_LR + n) * DM + c * 8); }
    __syncthreads();
    for (int t = wg * NWAVES + w; t < NR / 16; t += nwg * NWAVES) {
        const int tok0 = t * 16;
        f32x4 d0 = (f32x4){0.f, 0.f, 0.f, 0.f}, d1 = d0;
        const bf16_t* arow = p.hx + (size_t)(tok0 + fr) * DM + fq * 8;
#pragma unroll 8
        for (int ks = 0; ks < 32; ++ks) {
            const bf16x8 a = *(const bf16x8*)(arow + ks * 32);
            const bf16x8 b0 = *(const bf16x8*)(W + fr * 1032 + ks * 32 + fq * 8), b1 = *(const bf16x8*)(W + (16 + fr) * 1032 + ks * 32 + fq * 8);
            d0 = __builtin_amdgcn_mfma_f32_16x16x32_bf16(b0, a, d0, 0, 0, 0);
            d1 = __builtin_amdgcn_mfma_f32_16x16x32_bf16(b1, a, d1, 0, 0, 0);
        }
        asm volatile("s_nop 15\n\ts_nop 15" : "+v"(d0), "+v"(d1));
        bf16_t* o = p.proj + (size_t)(tok0 + fr) * DINP + P_LRF + fq * 4;
        *(u32x2*)o = (u32x2){cvt_pk_bf16(d0[0], d0[1]), cvt_pk_bf16(d0[2], d0[3])};
        *(u32x2*)(o + 16) = (u32x2){cvt_pk_bf16(d1[0], d1[1]), cvt_pk_bf16(d1[2], d1[3])};
    }
    __syncthreads();
}

__device__ __forceinline__ void phase_mix(const Params& p) {
    const int lane = threadIdx.x & 63, wave = threadIdx.x >> 6;
    const int stride = gridDim.x * NWAVES;
    int r = blockIdx.x * NWAVES + wave;
    if (r >= NL) return;
    const float4 gn0 = *(const float4*)(p.gnorm_g + (lane & 15) * 8), gn1 = *(const float4*)(p.gnorm_g + (lane & 15) * 8 + 4);
    const float4 sd0 = *(const float4*)(p.s5_d + lane * 8), sd1 = *(const float4*)(p.s5_d + lane * 8 + 4);
    const float gn[8] = {gn0.x, gn0.y, gn0.z, gn0.w, gn1.x, gn1.y, gn1.z, gn1.w}, sd[8] = {sd0.x, sd0.y, sd0.z, sd0.w, sd1.x, sd1.y, sd1.z, sd1.w};
    u32x4 c[6], n[6];
#define MIX_LOAD(dst, row) do { const size_t _r = (size_t)(row); \
        dst[0] = *(const u32x4*)(p.of + _r * 512 + lane * 8); dst[1] = *(const u32x4*)(p.of + ((size_t)NL + _r) * 512 + lane * 8); \
        dst[2] = *(const u32x4*)(p.proj + _r * DINP + P_G + lane * 8); \
        dst[3] = *(const u32x4*)(p.yf + _r * 512 + lane * 8); dst[4] = *(const u32x4*)(p.yf + ((size_t)NL + _r) * 512 + lane * 8); \
        dst[5] = *(const u32x4*)(p.Ag + ((size_t)(lane >> 1) * S5_ROWS + (_r >> 4)) * 512 + (_r & 15) * 16 + (lane & 1) * 8); } while (0)
    MIX_LOAD(c, r);
    for (;;) {
        const int rn = r + stride; const bool has = rn < NL;
        if (has) MIX_LOAD(n, rn);
        float o[8], g[8]; float ss = 0.f;
#pragma unroll
        for (int q = 0; q < 4; ++q) {
            o[2 * q] = bflo(c[0][q]) + bflo(c[1][q]); o[2 * q + 1] = bfhi(c[0][q]) + bfhi(c[1][q]);
            g[2 * q] = bflo(c[2][q]); g[2 * q + 1] = bfhi(c[2][q]);
            ss += o[2 * q] * o[2 * q] + o[2 * q + 1] * o[2 * q + 1];
        }
        ss += __shfl_xor(ss, 1); ss += __shfl_xor(ss, 2); ss += __shfl_xor(ss, 4); ss += __shfl_xor(ss, 8);
        const float rstd = rsqrtf(ss * (1.0f / 128.0f) + EPS);
        u32x4 mo, zo;
#pragma unroll
        for (int q = 0; q < 4; ++q) {
            const float m0 = o[2 * q] * rstd * gn[2 * q] * silu_fast(g[2 * q]), m1 = o[2 * q + 1] * rstd * gn[2 * q + 1] * silu_fast(g[2 * q + 1]);
            mo[q] = cvt_pk_bf16(m0, m1);
            const float y0 = bflo(c[3][q]) + bflo(c[4][q]) + sd[2 * q] * bflo(c[5][q]), y1 = bfhi(c[3][q]) + bfhi(c[4][q]) + sd[2 * q + 1] * bfhi(c[5][q]);
            zo[q] = cvt_pk_bf16(gelu_tanh_fast(y0), gelu_tanh_fast(y1));
        }
        *(u32x4*)(p.mix + (size_t)r * DM + lane * 8) = mo;
        *(u32x4*)(p.z + (size_t)r * 512 + lane * 8) = zo;
        if (!has) break;
        r = rn;
#pragma unroll
        for (int q = 0; q < 6; ++q) c[q] = n[q];
    }
#undef MIX_LOAD
}

__device__ __forceinline__ void phase_route(const Params& p, int* lm) {
    int* hist = lm; int* gbase = lm + 256; int* st_e = lm + 512; int* st_r = st_e + 1024; float* st_w = (float*)(st_r + 1024);
    const int tid = threadIdx.x;
    const int lane = threadIdx.x & 63, wave = threadIdx.x >> 6;
    const float* scores = p.scores;
    const float4 rb = *(const float4*)(p.router_b + lane * 4);
    for (int tb = blockIdx.x * 128; tb < NL; tb += gridDim.x * 128) {
    __syncthreads();
    if (tid < 256) hist[tid] = 0;
    __syncthreads();
    for (int tl = wave; tl < 128; tl += NWAVES) {
        const int t = tb + tl;
        const float4 sc4 = *(const float4*)(scores + (size_t)t * 256 + lane * 4);
        const float sc[4] = {sc4.x, sc4.y, sc4.z, sc4.w};
        float bv[4] = {sc4.x + rb.x, sc4.y + rb.y, sc4.z + rb.z, sc4.w + rb.w};
        float m1 = -INFINITY, m2 = -INFINITY;
#pragma unroll
        for (int j = 0; j < 4; ++j) { const float v = bv[j]; if (v > m1) { m2 = m1; m1 = v; } else if (v > m2) m2 = v; }
#pragma unroll
        for (int o = 1; o < 8; o <<= 1) {
            const float o1 = __shfl_xor(m1, o), o2 = __shfl_xor(m2, o);
            const float n1 = fmaxf(m1, o1), n2 = fmaxf(fminf(m1, o1), fmaxf(m2, o2));
            m1 = n1; m2 = n2;
        }
        const float gs = m1 + m2;
        const int myg = lane >> 3;
        int rank = 0;
#pragma unroll
        for (int j = 0; j < 8; ++j) { const float og = __shfl(gs, j * 8); rank += (og > gs || (og == gs && j < myg)) ? 1 : 0; }
        const bool sel = rank < 4;
#pragma unroll
        for (int j = 0; j < 4; ++j) if (!sel) bv[j] = -INFINITY;
        int my_e = -1; float my_s = 0.f; float ssum = 0.f;
#pragma unroll
        for (int k = 0; k < TOPK; ++k) {
            float bvv = bv[0]; int bi = 0;
#pragma unroll
            for (int j = 1; j < 4; ++j) if (bv[j] > bvv) { bvv = bv[j]; bi = j; }
            int be = lane * 4 + bi;
            float bs = (bi == 0) ? sc[0] : (bi == 1) ? sc[1] : (bi == 2) ? sc[2] : sc[3];
#pragma unroll
            for (int o = 1; o < 64; o <<= 1) {
                const float ov = __shfl_xor(bvv, o); const int oe = __shfl_xor(be, o); const float os = __shfl_xor(bs, o);
                if (ov > bvv || (ov == bvv && oe < be)) { bvv = ov; be = oe; bs = os; }
            }
            if ((be >> 2) == lane) {
#pragma unroll
                for (int j = 0; j < 4; ++j) if ((be & 3) == j) bv[j] = -INFINITY;
            }
            ssum += bs;
            if (lane == k) { my_e = be; my_s = bs; }
        }
        if (lane < TOPK) {
            st_e[tl * 8 + lane] = my_e; st_r[tl * 8 + lane] = atomicAdd(&hist[my_e], 1); st_w[tl * 8 + lane] = my_s / ssum * 2.5f;
        }
    }
    __syncthreads();
    if (tid < 256) { const int h = hist[tid]; gbase[tid] = h ? atomicAdd(&p.cnt[tid], h) : 0; }
    __syncthreads();
    for (int i = tid; i < 1024; i += NT) {
        const int e = st_e[i], pos = gbase[e] + st_r[i], t = tb + (i >> 3);
        p.ltok[(size_t)e * CAP + pos] = (unsigned short)t;
        p.tinfo[(size_t)tb * 8 + i] = ((unsigned)e << 16) | (unsigned)pos;
        p.tw[(size_t)tb * 8 + i] = st_w[i];
    }
    }
}

__device__ __forceinline__ void expert_tables(const Params& p, int* cntl, int* offs, int* toff, int ncolt) {
    const int tid = threadIdx.x;
    __syncthreads();
    if (tid < 256) cntl[tid] = p.cnt[tid];
    __syncthreads();
    if (tid < 256) {
        int s = 0, ts = 0;
        for (int e = 0; e < tid; ++e) { const int c = cntl[e]; s += c; ts += ((c + 255) >> 8) * ncolt; }
        offs[tid] = s; toff[tid] = ts;
        if (tid == 255) { const int c = cntl[255]; offs[256] = s + c; toff[256] = ts + ((c + 255) >> 8) * ncolt; }
    }
    __syncthreads();
}

__device__ __forceinline__ void phase_final(const Params& p, int* lmisc) {
    const int lane = threadIdx.x & 63, wave = threadIdx.x >> 6;
    int* cntl = lmisc; int* offs = lmisc + 256; int* toff = offs + 260;
    expert_tables(p, cntl, offs, toff, 1);
    for (int r = blockIdx.x * NWAVES + wave; r < NL; r += gridDim.x * NWAVES) {
        const int b = r / SEQ;
        const bf16_t* x1 = p.yf + (size_t)r * DM;
        const float* g2 = p.modv + b * 6144 + 5120;
        unsigned info = 0u; float wk = 0.f;
        if (lane < 8) { info = p.tinfo[(size_t)r * 8 + lane]; wk = p.tw[(size_t)r * 8 + lane]; }
        float a[16];
#pragma unroll
        for (int i = 0; i < 16; ++i) a[i] = 0.f;
#pragma unroll
        for (int k = 0; k < 8; ++k) {
            const unsigned inf = __shfl(info, k); const float w = __shfl(wk, k) * (1.0f / YB_SCALE);
            const unsigned char* row = (const unsigned char*)p.yb + (size_t)(offs[inf >> 16] + (int)(inf & 0xFFFFu)) * DM;
            const u32x4 v = *(const u32x4*)(row + lane * 16);
#pragma unroll
            for (int q = 0; q < 4; ++q) {
                const f32x2_t lo = __builtin_amdgcn_cvt_pk_f32_fp8((int)v[q], false), hi = __builtin_amdgcn_cvt_pk_f32_fp8((int)v[q], true);
                a[4 * q] = fmaf(w, lo[0], a[4 * q]); a[4 * q + 1] = fmaf(w, lo[1], a[4 * q + 1]); a[4 * q + 2] = fmaf(w, hi[0], a[4 * q + 2]); a[4 * q + 3] = fmaf(w, hi[1], a[4 * q + 3]);
            }
        }
        {
            const u32x4 v = *(const u32x4*)((const unsigned char*)p.hx + (size_t)r * DM + lane * 16);
#pragma unroll
            for (int q = 0; q < 4; ++q) {
                const f32x2_t lo = __builtin_amdgcn_cvt_pk_f32_fp8((int)v[q], false), hi = __builtin_amdgcn_cvt_pk_f32_fp8((int)v[q], true);
                a[4 * q] = fmaf(0.125f, lo[0], a[4 * q]); a[4 * q + 1] = fmaf(0.125f, lo[1], a[4 * q + 1]); a[4 * q + 2] = fmaf(0.125f, hi[0], a[4 * q + 2]); a[4 * q + 3] = fmaf(0.125f, hi[1], a[4 * q + 3]);
            }
        }
        float ss = 0.f;
#pragma unroll
        for (int h = 0; h < 4; ++h) {
            const int col = lane * 16 + 4 * h;
            const u32x2 xw = *(const u32x2*)(x1 + col); const float4 xv = make_float4(bflo(xw[0]), bfhi(xw[0]), bflo(xw[1]), bfhi(xw[1])), gg = *(const float4*)(g2 + col);
            float* aa = a + 4 * h;
            aa[0] = xv.x + gg.x * aa[0]; aa[1] = xv.y + gg.y * aa[1]; aa[2] = xv.z + gg.z * aa[2]; aa[3] = xv.w + gg.w * aa[3];
            ss += aa[0] * aa[0] + aa[1] * aa[1] + aa[2] * aa[2] + aa[3] * aa[3];
        }
        ss = wave_sum(ss);
        const float rstd = rsqrtf(ss * (1.0f / DM) + EPS);
#pragma unroll
        for (int h = 0; h < 4; ++h) {
            const int col = lane * 16 + 4 * h;
            const float4 gg = *(const float4*)(p.fnorm_g + col);
            const float* aa = a + 4 * h;
            float4 o; o.x = aa[0] * rstd * gg.x; o.y = aa[1] * rstd * gg.y; o.z = aa[2] * rstd * gg.z; o.w = aa[3] * rstd * gg.w;
            *(float4*)(p.out + (size_t)r * DM + col) = o;
        }
    }
}

__global__ void __launch_bounds__(NT, 2) mega(Params p) {
    extern __shared__ __attribute__((aligned(16))) unsigned char lds_raw[];
    float* lds = (float*)lds_raw;
    LAS unsigned char* ldsl = (LAS unsigned char*)lds_raw;
    float* lmisc = (float*)(lds_raw + STAGE_BYTES);
    volatile LAS unsigned* xbw = (volatile LAS unsigned*)(ldsl + LDS_BYTES - 16);
    if (threadIdx.x == 0) { xbw[0] = 0u; xbw[1] = 0u; xbw[2] = 0u; xbw[3] = 0u; }
    __syncthreads();
    XcdBarrier bar; bar.bar = p.bar; bar.x = 0; bar.st = xbw;
    const bool fused = (p.ph_hi - p.ph_lo) > 1;
    if (fused) bar = xcd_barrier_post(p.bar, xbw);
    const int bid = blockIdx.x, nb = gridDim.x;
#define PH(i) (p.ph_lo <= (i) && (i) < p.ph_hi)
#define SEAM(i) if (fused && p.ph_lo <= (i) && (i) + 1 < p.ph_hi) xcd_barrier(bar)

    if (PH(0)) phase_prologue(p, lds, 0);
    SEAM(0);
    if (PH(1)) { phase_norm_mod(p, 0); __syncthreads(); phase_prologue(p, lds, 1); }
    SEAM(1);
    if (PH(2)) {
        g8::DenseSched S; S.init(p.hx, p.w_inT, DM * 2, DM * 2, NR, 2048, nb, bid);
        g8::EpiProj E; E.O = p.proj; E.AG = p.Ag;
        g8::gemm_phase<g8::EpiProj, g8::DenseSched, 0>(ldsl, DM, DM * 2, DM * 2, S, E);
        lr_columns(p, (unsigned char*)lds);
    }
    SEAM(2);
    if (PH(3)) phase_scans(p, lds);
    SEAM(3);
    if (PH(4)) phase_mix(p);
    SEAM(4);
    if (PH(5)) {
        g8::DenseSched S; S.init(p.z, p.gluT, 512 * 2, 512 * 2, NL, 512, nb, bid);
        g8::EpiGlu E; E.Z = p.z; E.MIX = p.mix; E.bias = p.glu_b;
        g8::gemm_phase<g8::EpiGlu, g8::DenseSched, 0>(ldsl, 512, 512 * 2, 512 * 2, S, E);
    }
    SEAM(5);
    if (PH(6)) {
        g8::DenseSched S; S.init(p.mix, p.w_outT, DM * 2, DM * 2, NL, DM, nb, bid);
        g8::EpiOut E; E.X = p.x; E.X1 = p.yf; E.modv = p.modv;
        g8::gemm_phase<g8::EpiOut, g8::DenseSched, 0>(ldsl, DM, DM * 2, DM * 2, S, E);
    }
    SEAM(6);
    if (PH(7)) phase_norm_mod(p, 1);
    SEAM(7);
    if (PH(8)) {
        {
            g8::DenseSched S; S.init(p.hx, p.routerT3, DM * 2, 3072 * 2, NL, 256, nb, bid);
            g8::EpiScores E; E.O = p.scores;
            g8::gemm_phase<g8::EpiScores, g8::DenseSched, 0>(ldsl, DM, DM * 2, 3072 * 2, S, E);
        }
        __syncthreads();
        {
            g8::DenseSched S;
            S.init(p.hx, p.shguT, DM * 2, DM * 2, NL, 512, nb, bid);
            g8::EpiGateUp E; E.O = p.shhid;
            g8::gemm_phase<g8::EpiGateUp, g8::DenseSched, 0>(ldsl, DM, DM * 2, DM * 2, S, E);
        }
    }
    SEAM(8);
    if (PH(9)) phase_route(p, (int*)lmisc);
    SEAM(9);
    if (PH(10)) {
        int* cntl = (int*)lmisc; int* offs = cntl + 256; int* toff = offs + 260;
        expert_tables(p, cntl, offs, toff, 2);
        {
            g8::ExpertSched S;
            S.toff = (const LAS int*)toff; S.offs = (const LAS int*)offs; S.cntl = (const LAS int*)cntl;
            S.gbase = (const char*)p.of; S.lda = DM; S.ltok = p.ltok; S.Ad = nullptr;
            S.Bt = (const char*)p.eguT; S.bexp = (size_t)512 * DM; S.ldb = DM;
            S.ncolt = 2; S.G = nb; S.c = (bid & 7) * (nb >> 3) + (bid >> 3); S.total = __builtin_amdgcn_readfirstlane(toff[256]);
            g8::EpiExpGU E; E.O = p.hid; E.offs = S.offs; E.cntl = S.cntl;
            g8::gemm_phase<g8::EpiExpGU, g8::ExpertSched, 0, true, true>(ldsl, DM / 2, DM, DM, S, E);
        }
    }
    SEAM(10);
    if (PH(11)) {
        int* cntl = (int*)lmisc; int* offs = cntl + 256; int* toff = offs + 260;
        expert_tables(p, cntl, offs, toff, 4);
        g8::ExpertSched S;
        S.toff = (const LAS int*)toff; S.offs = (const LAS int*)offs; S.cntl = (const LAS int*)cntl;
        S.gbase = nullptr; S.lda = 256; S.ltok = p.ltok; S.Ad = (const char*)p.hid;
        S.Bt = (const char*)p.edT; S.bexp = (size_t)DM * 256; S.ldb = 256;
        S.ncolt = 4; S.G = nb; S.c = (bid & 7) * (nb >> 3) + (bid >> 3); S.total = __builtin_amdgcn_readfirstlane(toff[256]);
        g8::EpiExpDown E; E.O = p.yb; E.offs = S.offs; E.cntl = S.cntl;
        g8::gemm_phase<g8::EpiExpDown, g8::ExpertSched, 0, false, true>(ldsl, 128, 256, 256, S, E);
        __syncthreads();
        {
            g8::DenseSched S2; S2.init(p.shhid, p.shdT, 256, 256, NL, DM, nb, bid);
            g8::EpiBf16 E2; E2.O = p.hx;
            g8::gemm_phase<g8::EpiBf16, g8::DenseSched, 0, false, true>(ldsl, 128, 256, 256, S2, E2);
        }
    }
    SEAM(11);
    if (PH(12)) phase_final(p, (int*)lmisc);
}

extern "C" void kernel_launch(void* const* d_in, const int* in_sizes, int n_in, void* d_out, int out_size, void* d_ws, size_t ws_size,
                              hipStream_t stream) {
    static int grid = 0;
    if (grid == 0) {
        int dev = 0, cus = 0, per_cu = 0;
        (void)hipGetDevice(&dev);
        (void)hipDeviceGetAttribute(&cus, hipDeviceAttributeMultiprocessorCount, dev);
        (void)hipFuncSetAttribute((const void*)mega, hipFuncAttributeMaxDynamicSharedMemorySize, LDS_BYTES);
        (void)hipOccupancyMaxActiveBlocksPerMultiprocessor(&per_cu, (const void*)mega, NT, LDS_BYTES);
        (void)hipGetLastError();
        grid = cus;
    }
    size_t off = 0;
    auto carve = [&](size_t bytes) { size_t o = off; off += (bytes + 255) & ~(size_t)255; return (char*)d_ws + o; };
    Params p{};
    const float** ins = (const float**)&p;
    for (int i = 0; i < 39; ++i) ins[i] = (const float*)d_in[i];
    p.out = (float*)d_out;
    p.bar = (unsigned*)carve(XCD_BAR_WORDS * 4);
    p.cnt = (int*)carve(256 * 4);
    const size_t zero_bytes = off;
    p.modv = (float*)carve((size_t)17 * 6144 * 4);
    p.w_inT = (bf16_t*)carve((size_t)2304 * DM * 2);
    p.w_outT = (bf16_t*)carve((size_t)DM * DM * 2);
    p.gluT = (bf16_t*)carve((size_t)512 * 512 * 2);
    p.routerT3 = (bf16_t*)carve((size_t)256 * 3072 * 2);
    p.shguT = (bf16_t*)carve((size_t)512 * DM * 2);
    p.shdT = (bf16_t*)carve((size_t)DM * 256 * 2);
    p.hx = (bf16_t*)carve((size_t)NL * 2048 * 2);
    p.scores = (float*)carve((size_t)NL * 256 * 4);
    p.shhid = (bf16_t*)carve((size_t)NL * 256 * 2);
    p.ltok = (unsigned short*)carve((size_t)NE * CAP * 2);
    p.tinfo = (unsigned*)carve((size_t)NL * 8 * 4);
    p.tw = (float*)carve((size_t)NL * 8 * 4);
    p.edT = (bf16_t*)carve((size_t)NE * DM * 256 * 2);
    p.eguT = (bf16_t*)carve((size_t)NE * 512 * DM * 2);
    char* arena = carve(0);
    p.yb = (bf16_t*)p.eguT;
    {
        size_t a = 0;
        auto acarve = [&](size_t bytes) { size_t o = a; a += (bytes + 255) & ~(size_t)255; return arena + o; };
        p.proj = (bf16_t*)acarve((size_t)NR * DINP * 2);
        p.of = (bf16_t*)acarve((size_t)2 * NL * 512 * 2);
        p.yf = (bf16_t*)acarve((size_t)2 * NL * 512 * 2);
        p.Ag = (bf16_t*)acarve((size_t)32 * S5_ROWS * 512 * 2);
        p.mix = (bf16_t*)acarve((size_t)NL * DM * 2);
        p.z = (bf16_t*)acarve((size_t)NL * 512 * 2);
        const size_t early = a;
        const size_t yb_tail = (size_t)(NL * 8 + 1) * DM * 2 - (size_t)NE * 512 * DM * 2;
        p.hid = (bf16_t*)(arena + ((yb_tail + 255) & ~(size_t)255));
        const size_t late = ((yb_tail + 255) & ~(size_t)255) + (size_t)(NL * 8 + 256) * 256 * 2;
        (void)carve(early > late ? early : late);
    }
    if (off > ws_size) { fprintf(stderr, "kernel_launch: workspace too small: need %zu have %zu\n", off, ws_size); return; }
    (void)hipMemsetAsync(d_ws, 0, zero_bytes, stream);
#if FUSED
    p.ph_lo = 0; p.ph_hi = N_PHASES;
    hipLaunchKernelGGL(mega, dim3(grid), dim3(NT), LDS_BYTES, stream, p);
#else
    for (int i = 0; i < N_PHASES; ++i) {
        p.ph_lo = i; p.ph_hi = i + 1;
        hipLaunchKernelGGL(mega, dim3(grid), dim3(NT), LDS_BYTES, stream, p);
    }
#endif
}
```

```cpp
#include <hip/hip_runtime.h>
#include <stdint.h>
#include <stdio.h>

#define DM 1024
#define NB 16
#define SEQ 2048
#define CTX 256
#define NL (NB * SEQ)
#define NCX (NB * CTX)
#define NR (NL + NCX)
#define DIN 2080
#define S_LR 1536
#define S_U 1568
#define P_Q 0
#define P_K 256
#define P_V 512
#define P_G 1024
#define WC_U 1536
#define WC_LR 2048
#define P_LRF 1536
#define P_LRB 1552
#define DINP 1568
#define S5_ROWS 2304
#define NE 256
#define TOPK 8
#define CAP 32768
#define EPS 1e-6f

#define NT 512
#define NWAVES 8
#define STAGE_BYTES 131072
#define LDS_BYTES (STAGE_BYTES + 16384)
#define N_PHASES 13
#define S5_WLDS 14592
#ifndef FUSED
#define FUSED 1
#endif

typedef unsigned short bf16_t;
typedef short bf16x8 __attribute__((ext_vector_type(8)));
typedef float f32x4 __attribute__((ext_vector_type(4)));
typedef unsigned u32x4 __attribute__((ext_vector_type(4)));
typedef unsigned u32x2 __attribute__((ext_vector_type(2)));
#define LAS __attribute__((address_space(3)))

#define XB_TMO      128
#define XB_XCNT(j)  (256  + 64 * (j))
#define XB_XSUB(j)  (1280 + 64 * (j))
#define XB_XGEN(j)  (2304 + 64 * (j))
#define XB_TOP      3328
#define XB_TOPGEN   3392
#define XCD_BAR_WORDS 3456
#define XB_SPIN_CAP (1u << 18)

__device__ __forceinline__ unsigned xb_ld(unsigned* p)              { return __hip_atomic_load(p, __ATOMIC_RELAXED, __HIP_MEMORY_SCOPE_AGENT); }
__device__ __forceinline__ unsigned xb_add(unsigned* p, unsigned v) { return __hip_atomic_fetch_add(p, v, __ATOMIC_RELAXED, __HIP_MEMORY_SCOPE_AGENT); }
__device__ __forceinline__ unsigned xb_xcc_id() { return (unsigned)__builtin_amdgcn_s_getreg((3 << 11) | 20) & 0xFu; }
#define XB_SPIN(cond, bar) do { unsigned _sp = 0; while (cond) { __builtin_amdgcn_s_sleep(1); \
    if ((++_sp & 255u) == 0u) { if (xb_ld(&(bar)[XB_TMO])) break; if (_sp > XB_SPIN_CAP) { atomicAdd(&(bar)[XB_TMO], 1u); break; } } } } while (0)

struct XcdBarrier { unsigned* bar; unsigned x; volatile LAS unsigned* st; };

__device__ __forceinline__ XcdBarrier xcd_barrier_post(unsigned* bar, volatile LAS unsigned* st) {
    XcdBarrier b; b.bar = bar; b.x = xb_xcc_id(); b.st = st;
    if (threadIdx.x == 0) (void)xb_add(&bar[XB_XCNT(b.x)], 1u);
    return b;
}
__device__ __forceinline__ void xcd_barrier_complete(unsigned* bar, unsigned x, unsigned& nloc, unsigned& nx) {
    const unsigned G = gridDim.x * gridDim.y * gridDim.z;
    unsigned sum, cnt, mine, sp = 0u;
    for (;;) {
        sum = 0u; cnt = 0u; mine = 0u;
#pragma unroll
        for (unsigned j = 0; j < 16; ++j) { const unsigned c = xb_ld(&bar[XB_XCNT(j)]); sum += c; cnt += (c > 0u) ? 1u : 0u; mine = (j == x) ? c : mine; }
        if (sum == G) break;
        __builtin_amdgcn_s_sleep(1);
        if ((++sp & 255u) == 0u) { if (xb_ld(&bar[XB_TMO])) break; if (sp > XB_SPIN_CAP) { atomicAdd(&bar[XB_TMO], 1u); break; } }
    }
    nloc = mine > 0u ? mine : 1u; nx = cnt > 0u ? cnt : 1u;
}
__device__ __forceinline__ void xcd_barrier(const XcdBarrier& b) {
    asm volatile("s_waitcnt vmcnt(0)" ::: "memory");
    __syncthreads();
    if (threadIdx.x == 0) {
        unsigned* bar = b.bar;
        __builtin_amdgcn_s_waitcnt(0);
        unsigned nloc = b.st[0], nx = b.st[1];
        if (nloc == 0u) { xcd_barrier_complete(bar, b.x, nloc, nx); b.st[0] = nloc; b.st[1] = nx; }
        const unsigned old = xb_add(&bar[XB_XSUB(b.x)], 1u);
        const unsigned gen = old / nloc;
        if (old + 1u == (gen + 1u) * nloc) {
            __builtin_amdgcn_fence(__ATOMIC_RELEASE, "agent");
            asm volatile("s_waitcnt vmcnt(0)" ::: "memory");
            const unsigned og = xb_add(&bar[XB_TOP], 1u);
            const unsigned tg = og / nx;
            if (og + 1u == (tg + 1u) * nx) xb_add(&bar[XB_TOPGEN], 1u);
            else XB_SPIN(xb_ld(&bar[XB_TOPGEN]) == tg, bar);
            __builtin_amdgcn_fence(__ATOMIC_ACQUIRE, "agent");
            xb_add(&bar[XB_XGEN(b.x)], 1u);
            asm volatile("s_waitcnt vmcnt(0)" ::: "memory");
        } else {
            XB_SPIN(xb_ld(&bar[XB_XGEN(b.x)]) == gen, bar);
            __builtin_amdgcn_fence(__ATOMIC_ACQUIRE, "agent");
            asm volatile("s_waitcnt vmcnt(0)" ::: "memory");
        }
    }
    __syncthreads();
}

struct Params {
    const float *x, *c, *ctx, *c_ctx, *ada_w, *ada_b, *norm1_g, *norm2_g, *w_in,
        *wa_f, *ba_f, *wa_b, *ba_b, *gnorm_g,
        *lam_re_f, *lam_im_f, *lstep_f, *lam_re_b, *lam_im_b, *lstep_b,
        *b_re, *b_im, *c_re_f, *c_im_f, *c_re_b, *c_im_b, *s5_d, *glu_w, *glu_b,
        *w_out, *router_w, *router_b, *ew_gate, *ew_up, *ew_down, *sw_gate, *sw_up, *sw_down, *fnorm_g;
    float* out;
    unsigned* bar;
    int* cnt;
    float* modv;
    bf16_t* w_inT;
    bf16_t* w_outT;
    bf16_t* gluT;
    bf16_t* routerT3;
    bf16_t* shguT;
    bf16_t* shdT;
    bf16_t* hx;
    bf16_t* proj;
    bf16_t* of;
    bf16_t* yf;
    bf16_t* Ag;
    bf16_t* mix;
    bf16_t* z;
    float* scores;
    bf16_t* shhid;
    bf16_t* eguT;
    bf16_t* edT;
    bf16_t* hid;
    bf16_t* yb;
    unsigned short* ltok;
    unsigned* tinfo;
    float* tw;
    int ph_lo, ph_hi;
};

__device__ __forceinline__ float sigmoidf_(float v) { return 1.0f / (1.0f + expf(-v)); }
__device__ __forceinline__ float siluf_(float v) { return v / (1.0f + expf(-v)); }
__device__ __forceinline__ float logsigmoidf_(float v) { return fminf(v, 0.0f) - log1pf(expf(-fabsf(v))); }
__device__ __forceinline__ float gelu_tanhf_(float v) { return 0.5f * v * (1.0f + tanhf(0.7978845608028654f * (v + 0.044715f * v * v * v))); }
__device__ __forceinline__ float sigmoid_fast(float v) { return __builtin_amdgcn_rcpf(1.0f + __builtin_amdgcn_exp2f(-v * 1.4426950408889634f)); }
__device__ __forceinline__ float silu_fast(float v) { return v * sigmoid_fast(v); }
__device__ __forceinline__ float gelu_tanh_fast(float v) { return v * sigmoid_fast(1.5957691216057308f * (v + 0.044715f * v * v * v)); }
__device__ __forceinline__ float wave_sum(float v) {
#pragma unroll
    for (int o = 32; o > 0; o >>= 1) v += __shfl_xor(v, o);
    return v;
}
__device__ __forceinline__ float bf2f(bf16_t b) { return __uint_as_float(((unsigned)b) << 16); }
__device__ __forceinline__ float bflo(unsigned w) { return __uint_as_float(w << 16); }
__device__ __forceinline__ float bfhi(unsigned w) { return __uint_as_float(w & 0xFFFF0000u); }
__device__ __forceinline__ bf16_t f2bf(float f) { unsigned u = __float_as_uint(f); u += 0x7FFFu + ((u >> 16) & 1u); return (bf16_t)(u >> 16); }
typedef __bf16 bf16x2_t __attribute__((ext_vector_type(2)));
typedef float f32x2_t __attribute__((ext_vector_type(2)));
__device__ __forceinline__ unsigned cvt_pk_bf16(float lo, float hi) { const f32x2_t f = {lo, hi}; return __builtin_bit_cast(unsigned, __builtin_convertvector(f, bf16x2_t)); }

namespace g8 {
constexpr int BM = 256, BK = 64, HALF = 128, HTB = HALF * BK * 2, NXCD = 8, WGM = 8;
__device__ __forceinline__ int lds_byte(int r, int c) { const int st = (r >> 4) * 2 + (c >> 5), rr = r & 15, cc = c & 31, ob = rr * 64 + cc * 2; return st * 1024 + (ob ^ (((ob >> 9) & 1) << 5)); }
__device__ __forceinline__ void stage_rc(int b, int& R, int& C) { const int st = b / 1024, sb = b % 1024, swz = sb ^ (((sb >> 9) & 1) << 5); R = (st >> 1) * 16 + swz / 64; C = (st & 1) * 32 + (swz % 64) / 2; }
__device__ __forceinline__ int perm32(int rho) { const int n = rho >> 4, i = rho & 15; return 8 * (i >> 2) + 4 * n + (i & 3); }

struct Unit { const char* a; const char* b; int pm, pn, e, rows; };

struct DenseSched {
    const char* A; const char* Bt; unsigned lda, ldb; int nM, nN, nwg, G, c;
    __device__ __forceinline__ void init(const void* A_, const void* Bt_, unsigned lda_, unsigned ldb_, int M, int N, int G_, int c_) {
        A = (const char*)A_; Bt = (const char*)Bt_; lda = lda_; ldb = ldb_; nM = M / BM; nN = N / BM; nwg = nM * nN; G = G_; c = c_; }
    __device__ __forceinline__ bool next(int i, Unit& u) const {
        if (c < 0) return false;
        const long L = (long)i * G + c; if (L >= nwg) return false;
        int wgid = (int)L; { const int q = nwg / NXCD, r = nwg % NXCD, xcd = wgid % NXCD, off = wgid / NXCD; wgid = (xcd < r ? xcd * (q + 1) : r * (q + 1) + (xcd - r) * q) + off; }
        const int nig = WGM * nN, gid = wgid / nig, fm = gid * WGM, gsz = (nM - fm) < WGM ? (nM - fm) : WGM;
        u.pm = fm + ((wgid % nig) % gsz); u.pn = (wgid % nig) / gsz; u.e = 0; u.rows = BM;
        u.a = A + (size_t)u.pm * BM * lda; u.b = Bt + (size_t)u.pn * BM * ldb;
        return true;
    }
};

typedef int v8i_t __attribute__((ext_vector_type(8)));
typedef long v2l_t __attribute__((ext_vector_type(2)));
template <class Epi, class Sched, int KWRAP, bool GATHER = false, int FP8 = 0>
__device__ __forceinline__ void gemm_phase(LAS unsigned char* lds, const int K, const unsigned lda, const unsigned ldb, const Sched& S, const Epi& E) {
    const int tid = threadIdx.x, wid = __builtin_amdgcn_readfirstlane(tid >> 6), lane = tid & 63, wr = wid >> 2, wc = wid & 3, fr = lane & 15, fq = lane >> 4;
    const int nt = K / BK;
    unsigned voffA[2], voffB[2]; int rA[2]; unsigned cA2[2];
#pragma unroll
    for (int i = 0; i < 2; ++i) { int R, C; stage_rc(tid * 16 + i * 8192, R, C); const int Rb = Epi::PERM ? ((R & ~31) + perm32(R & 31)) : R;
        voffA[i] = (unsigned)R * lda + (unsigned)C * 2u; voffB[i] = (unsigned)Rb * ldb + (unsigned)C * 2u; rA[i] = R; cA2[i] = (unsigned)C * 2u; }
    unsigned gc[2][2], gn[2][2];
    const size_t kstep = (size_t)(BK * 2);
    const size_t hstepA = (size_t)HALF * lda, hstepB = (size_t)HALF * ldb;
    const unsigned ldsw = (unsigned)wid * 1024u;
    const int aoff = lds_byte(wr * 64 + fr, fq * 8), boff = lds_byte(wc * 32 + fr, fq * 8);
#define G8_SA(b, h) (((b) * 2 + (h)) * HTB)
#define G8_SB(b, h) ((4 + (b) * 2 + (h)) * HTB)
#define G8_STAGE(bufoff, gbase, voff) do { _Pragma("unroll") for (int _i = 0; _i < 2; ++_i) \
        __builtin_amdgcn_global_load_lds((const unsigned*)((const char*)(gbase) + (voff)[_i]), (LAS unsigned*)(lds + (bufoff) + ldsw + _i * 8192), 16, 0, 0); } while (0)
#define G8_KO(kt) ((size_t)(KWRAP ? ((kt) & (KWRAP - 1)) : (kt)) * kstep)
#define G8_LDA(dst, b, h) do { _Pragma("unroll") for (int m = 0; m < 4; ++m) _Pragma("unroll") for (int k = 0; k < 2; ++k) dst[m][k] = *(const LAS bf16x8*)(lds + G8_SA(b, h) + aoff + m * 2048 + k * 1024); } while (0)
#define G8_LDB(dst, b, h) do { _Pragma("unroll") for (int n = 0; n < 2; ++n) _Pragma("unroll") for (int k = 0; k < 2; ++k) dst[n][k] = *(const LAS bf16x8*)(lds + G8_SB(b, h) + boff + n * 2048 + k * 1024); } while (0)
#define G8_PK8(x) __builtin_bit_cast(v8i_t, x)
#define G8_MMA(ai, bj, At, Bt) do { __builtin_amdgcn_s_setprio(1); _Pragma("unroll") for (int m = 0; m < 4; ++m) _Pragma("unroll") for (int n = 0; n < 2; ++n) { \
        if constexpr (FP8 == 2) { typedef int v4i_ __attribute__((ext_vector_type(4))); \
            const v8i_t b8_ = __builtin_shufflevector(__builtin_bit_cast(v4i_, Bt[n][0]), __builtin_bit_cast(v4i_, Bt[n][1]), 0, 1, 2, 3, 4, 5, 6, 7); \
            const v8i_t a8_ = __builtin_shufflevector(__builtin_bit_cast(v4i_, At[m][0]), __builtin_bit_cast(v4i_, At[m][1]), 0, 1, 2, 3, 4, 5, 6, 7); \
            acc[ai][bj][m][n] = __builtin_amdgcn_mfma_scale_f32_16x16x128_f8f6f4(b8_, a8_, acc[ai][bj][m][n], 0, 0, 0, 0x7F7F7F7F, 0, 0x7F7F7F7F); } \
        else if constexpr (FP8 == 1) { _Pragma("unroll") for (int k = 0; k < 2; ++k) { const v2l_t b2_ = __builtin_bit_cast(v2l_t, Bt[n][k]), a2_ = __builtin_bit_cast(v2l_t, At[m][k]); \
            acc[ai][bj][m][n] = __builtin_amdgcn_mfma_f32_16x16x32_fp8_fp8(b2_[0], a2_[0], acc[ai][bj][m][n], 0, 0, 0); \
            acc[ai][bj][m][n] = __builtin_amdgcn_mfma_f32_16x16x32_fp8_fp8(b2_[1], a2_[1], acc[ai][bj][m][n], 0, 0, 0); } } \
        else { _Pragma("unroll") for (int k = 0; k < 2; ++k) acc[ai][bj][m][n] = __builtin_amdgcn_mfma_f32_16x16x32_bf16(Bt[n][k], At[m][k], acc[ai][bj][m][n], 0, 0, 0); } } \
        __builtin_amdgcn_s_setprio(0); } while (0)
#define G8_WAIT_V(n) asm volatile("s_waitcnt vmcnt(" #n ")" ::: "memory")
#define G8_WAIT_L(n) asm volatile("s_waitcnt lgkmcnt(" #n ")" ::: "memory")
#define G8_BAR __builtin_amdgcn_s_barrier()
#define G8_SCHED __builtin_amdgcn_sched_barrier(0)
    Unit cur, nxt; int ui = 0;
    if (!S.next(0, cur)) return;
    f32x4 acc[2][2][4][2];
#pragma unroll
    for (int a = 0; a < 2; ++a)
#pragma unroll
        for (int b = 0; b < 2; ++b)
#pragma unroll
            for (int m = 0; m < 4; ++m)
#pragma unroll
                for (int n = 0; n < 2; ++n) acc[a][b][m][n] = (f32x4){0.f, 0.f, 0.f, 0.f};
    bf16x8 At[4][2], B0[2][2], B1[2][2];
    const char* cA = cur.a; const char* cB = cur.b; const char* nA = cA;
#define G8_STA(bufoff, nx, h, kt) do { const size_t _ko = G8_KO(kt); _Pragma("unroll") for (int _i = 0; _i < 2; ++_i) { const char* _s; \
        if constexpr (GATHER) _s = S.gbase + (size_t)((nx) ? gn[h][_i] : gc[h][_i]) + _ko; else _s = ((nx) ? nA : cA) + ((h) ? hstepA : (size_t)0) + voffA[_i] + _ko; \
        __builtin_amdgcn_global_load_lds((const unsigned*)_s, (LAS unsigned*)(lds + (bufoff) + ldsw + _i * 8192), 16, 0, 0); } } while (0)
    if constexpr (GATHER) {
#pragma unroll
        for (int h = 0; h < 2; ++h)
#pragma unroll
            for (int i = 0; i < 2; ++i) { gc[h][i] = S.row_off(cur, h * HALF + rA[i]) + cA2[i]; gn[h][i] = gc[h][i]; }
    }
    G8_STAGE(G8_SB(0, 0), cB, voffB); G8_STA(G8_SA(0, 0), false, 0, 0); G8_STAGE(G8_SB(0, 1), cB + hstepB, voffB); G8_STA(G8_SA(0, 1), false, 1, 0);
    if (wr == 1) G8_BAR;
    G8_WAIT_V(4); G8_BAR;
    G8_STAGE(G8_SB(1, 0), cB + kstep, voffB); G8_STA(G8_SA(1, 0), false, 0, 1); G8_STAGE(G8_SB(1, 1), cB + hstepB + kstep, voffB);
    G8_WAIT_V(6); G8_BAR;
    for (;;) {
        const bool has_next = S.next(ui + 1, nxt);
        nA = has_next ? nxt.a : cA; const char* nB = has_next ? nxt.b : cB;
        if constexpr (GATHER) {
#pragma unroll
            for (int h = 0; h < 2; ++h)
#pragma unroll
                for (int i = 0; i < 2; ++i) gn[h][i] = has_next ? (S.row_off(nxt, h * HALF + rA[i]) + cA2[i]) : gc[h][i];
        }
        for (int t = 0; t < nt; t += 2) {
            const bool last = (t == nt - 2);
            const char* b2 = last ? nB : cB + (size_t)(t + 2) * kstep;
            const char* b3 = b2 + kstep;
            G8_LDB(B0, 0, 0); G8_SCHED; G8_LDA(At, 0, 0); G8_STA(G8_SA(1, 1), false, 1, t + 1);
            G8_WAIT_L(8); G8_BAR; G8_WAIT_L(0); G8_MMA(0, 0, At, B0); G8_BAR; G8_SCHED;
            G8_LDB(B1, 0, 1); G8_STAGE(G8_SB(0, 0), b2, voffB);
            G8_BAR; G8_WAIT_L(0); G8_MMA(0, 1, At, B1); G8_BAR;
            G8_LDA(At, 0, 1); G8_STA(G8_SA(0, 0), last, 0, last ? 0 : t + 2);
            G8_BAR; G8_WAIT_L(0); if (cur.rows > HALF) G8_MMA(1, 0, At, B0); G8_BAR; G8_SCHED;
            G8_STAGE(G8_SB(0, 1), b2 + hstepB, voffB);
            G8_WAIT_V(6); G8_BAR; if (cur.rows > HALF) G8_MMA(1, 1, At, B1); G8_BAR;
            G8_LDB(B0, 1, 0); G8_SCHED; G8_LDA(At, 1, 0); G8_STA(G8_SA(0, 1), last, 1, last ? 0 : t + 2);
            G8_WAIT_L(8); G8_BAR; G8_WAIT_L(0); G8_MMA(0, 0, At, B0); G8_BAR; G8_SCHED;
            G8_LDB(B1, 1, 1); G8_STAGE(G8_SB(1, 0), b3, voffB);
            G8_BAR; G8_WAIT_L(0); G8_MMA(0, 1, At, B1); G8_BAR;
            G8_LDA(At, 1, 1); G8_STA(G8_SA(1, 0), last, 0, last ? 1 : t + 3);
            G8_BAR; G8_WAIT_L(0); if (cur.rows > HALF) G8_MMA(1, 0, At, B0); G8_BAR; G8_SCHED;
            G8_STAGE(G8_SB(1, 1), b3 + hstepB, voffB);
            G8_WAIT_V(6); G8_BAR; if (cur.rows > HALF) G8_MMA(1, 1, At, B1); G8_BAR;
        }
        {
            asm volatile("s_nop 15\n\ts_nop 15" : "+v"(acc[1][1][0][0]), "+v"(acc[1][1][0][1]), "+v"(acc[1][1][1][0]), "+v"(acc[1][1][1][1]), "+v"(acc[1][1][2][0]), "+v"(acc[1][1][2][1]), "+v"(acc[1][1][3][0]), "+v"(acc[1][1][3][1]));
            int tz = threadIdx.x; asm volatile("" : "+v"(tz));
            const int wid2 = __builtin_amdgcn_readfirstlane(tz >> 6), lane2 = tz & 63;
            E(acc, cur, wid2 >> 2, wid2 & 3, lane2 & 15, lane2 >> 4);
        }
        if (!has_next) break;
#pragma unroll
        for (int a = 0; a < 2; ++a)
#pragma unroll
            for (int b = 0; b < 2; ++b)
#pragma unroll
                for (int m = 0; m < 4; ++m)
#pragma unroll
                    for (int n = 0; n < 2; ++n) acc[a][b][m][n] = (f32x4){0.f, 0.f, 0.f, 0.f};
        cur = nxt; cA = nA; cB = nB; ++ui;
        if constexpr (GATHER) {
#pragma unroll
            for (int h = 0; h < 2; ++h)
#pragma unroll
                for (int i = 0; i < 2; ++i) gc[h][i] = gn[h][i];
        }
    }
    G8_WAIT_V(0);
    if (wr == 0) G8_BAR;
    G8_BAR;
#undef G8_SA
#undef G8_SB
#undef G8_STAGE
#undef G8_STA
#undef G8_KO
#undef G8_LDA
#undef G8_LDB
#undef G8_MMA
#undef G8_PK8
#undef G8_WAIT_V
#undef G8_WAIT_L
#undef G8_BAR
#undef G8_SCHED
}

struct EpiProj {
    static constexpr bool PERM = true;
    bf16_t* O; bf16_t* AG;
    __device__ __forceinline__ void operator()(const f32x4 (&acc)[2][2][4][2], const Unit& u, int wr, int wc, int fr, int fq) const {
        const int row0 = u.pm * BM + wr * 64 + fr, col0 = u.pn * BM + wc * 32 + 8 * fq;
#pragma unroll
        for (int ai = 0; ai < 2; ++ai)
#pragma unroll
            for (int m = 0; m < 4; ++m) {
                const int r = row0 + ai * HALF + m * 16;
#pragma unroll
                for (int bj = 0; bj < 2; ++bj) { const f32x4 v0 = acc[ai][bj][m][0], v1 = acc[ai][bj][m][1];
                    const int c = col0 + bj * HALF;
                    const u32x4 pk = (u32x4){cvt_pk_bf16(v0[0], v0[1]), cvt_pk_bf16(v0[2], v0[3]), cvt_pk_bf16(v1[0], v1[1]), cvt_pk_bf16(v1[2], v1[3])};
                    if (u.pn < 6) *(u32x4*)(O + (size_t)r * DINP + c) = pk;
                    else if (u.pn < 8) { const int cu = c - WC_U; *(u32x4*)(AG + ((size_t)(cu >> 4) * S5_ROWS + (r >> 4)) * 512 + (r & 15) * 16 + (cu & 15)) = pk; }
                    else if (c < WC_LR + 32) *(u32x4*)(O + (size_t)r * DINP + P_LRF + (c - WC_LR)) = pk; } }
    }
};
struct EpiBf16 {
    static constexpr bool PERM = true;
    bf16_t* O;
    __device__ __forceinline__ void operator()(const f32x4 (&acc)[2][2][4][2], const Unit& u, int wr, int wc, int fr, int fq) const {
        const int row0 = u.pm * BM + wr * 64 + fr, col0 = u.pn * BM + wc * 32 + 8 * fq;
#pragma unroll
        for (int ai = 0; ai < 2; ++ai)
#pragma unroll
            for (int m = 0; m < 4; ++m) {
                const int r = row0 + ai * HALF + m * 16;
#pragma unroll
                for (int bj = 0; bj < 2; ++bj) { const f32x4 v0 = acc[ai][bj][m][0] * (8.0f / 128.0f), v1 = acc[ai][bj][m][1] * (8.0f / 128.0f);
                    int d0 = __builtin_amdgcn_cvt_pk_fp8_f32(v0[0], v0[1], 0, false); d0 = __builtin_amdgcn_cvt_pk_fp8_f32(v0[2], v0[3], d0, true);
                    int d1 = __builtin_amdgcn_cvt_pk_fp8_f32(v1[0], v1[1], 0, false); d1 = __builtin_amdgcn_cvt_pk_fp8_f32(v1[2], v1[3], d1, true);
                    *(u32x2*)((char*)O + (size_t)r * DM + col0 + bj * HALF) = (u32x2){(unsigned)d0, (unsigned)d1}; }
            }
    }
};
struct EpiGlu {
    static constexpr bool PERM = true;
    const bf16_t* Z; bf16_t* MIX; const float* bias;
    __device__ __forceinline__ void operator()(const f32x4 (&acc)[2][2][4][2], const Unit& u, int wr, int wc, int fr, int fq) const {
        const int row0 = u.pm * BM + wr * 64 + fr, col0 = u.pn * BM + wc * 32 + 8 * fq;
#pragma unroll
        for (int bj = 0; bj < 2; ++bj) {
            const int c = col0 + bj * HALF;
            const f32x4 b0 = *(const f32x4*)(bias + c), b1 = *(const f32x4*)(bias + c + 4);
            u32x4 zq[8];
#pragma unroll
            for (int ai = 0; ai < 2; ++ai)
#pragma unroll
                for (int m = 0; m < 4; ++m) zq[ai * 4 + m] = *(const u32x4*)(Z + (size_t)(row0 + ai * HALF + m * 16) * 512 + c);
#pragma unroll
            for (int ai = 0; ai < 2; ++ai)
#pragma unroll
                for (int m = 0; m < 4; ++m) {
                    const size_t r = (size_t)(row0 + ai * HALF + m * 16);
                    const u32x4 zz = zq[ai * 4 + m];
                    const f32x4 v0 = acc[ai][bj][m][0] + b0, v1 = acc[ai][bj][m][1] + b1;
                    const float o0 = bflo(zz[0]) * sigmoid_fast(v0[0]), o1 = bfhi(zz[0]) * sigmoid_fast(v0[1]), o2 = bflo(zz[1]) * sigmoid_fast(v0[2]), o3 = bfhi(zz[1]) * sigmoid_fast(v0[3]);
                    const float o4 = bflo(zz[2]) * sigmoid_fast(v1[0]), o5 = bfhi(zz[2]) * sigmoid_fast(v1[1]), o6 = bflo(zz[3]) * sigmoid_fast(v1[2]), o7 = bfhi(zz[3]) * sigmoid_fast(v1[3]);
                    *(u32x4*)(MIX + r * DM + 512 + c) = (u32x4){cvt_pk_bf16(o0, o1), cvt_pk_bf16(o2, o3), cvt_pk_bf16(o4, o5), cvt_pk_bf16(o6, o7)};
                }
        }
    }
};
struct EpiOut {
    static constexpr bool PERM = true;
    const float* X; bf16_t* X1; const float* modv;
    __device__ __forceinline__ void operator()(const f32x4 (&acc)[2][2][4][2], const Unit& u, int wr, int wc, int fr, int fq) const {
        const int row0 = u.pm * BM + wr * 64 + fr, col0 = u.pn * BM + wc * 32 + 8 * fq;
        const float* g1 = modv + ((u.pm * BM) / SEQ) * 6144 + 2048;
#pragma unroll
        for (int bj = 0; bj < 2; ++bj) {
            const int c = col0 + bj * HALF;
            const f32x4 ga = *(const f32x4*)(g1 + c), gb = *(const f32x4*)(g1 + c + 4);
#pragma unroll
            for (int ai = 0; ai < 2; ++ai) {
                f32x4 xa[4], xb[4];
#pragma unroll
                for (int m = 0; m < 4; ++m) { const float* xs = X + (size_t)(row0 + ai * HALF + m * 16) * DM + c; xa[m] = *(const f32x4*)xs; xb[m] = *(const f32x4*)(xs + 4); }
#pragma unroll
                for (int m = 0; m < 4; ++m) { const f32x4 y0 = xa[m] + ga * acc[ai][bj][m][0], y1 = xb[m] + gb * acc[ai][bj][m][1];
                    *(u32x4*)(X1 + (size_t)(row0 + ai * HALF + m * 16) * DM + c) = (u32x4){cvt_pk_bf16(y0[0], y0[1]), cvt_pk_bf16(y0[2], y0[3]), cvt_pk_bf16(y1[0], y1[1]), cvt_pk_bf16(y1[2], y1[3])}; }
            }
        }
    }
};
struct EpiScores {
    static constexpr bool PERM = false;
    float* O;
    __device__ __forceinline__ void operator()(const f32x4 (&acc)[2][2][4][2], const Unit& u, int wr, int wc, int fr, int fq) const {
        const int row0 = u.pm * BM + wr * 64 + fr, col0 = u.pn * BM + wc * 32 + 4 * fq;
#pragma unroll
        for (int ai = 0; ai < 2; ++ai)
#pragma unroll
            for (int m = 0; m < 4; ++m) { float* rowp = O + (size_t)(row0 + ai * HALF + m * 16) * 256 + col0;
#pragma unroll
                for (int bj = 0; bj < 2; ++bj)
#pragma unroll
                    for (int n = 0; n < 2; ++n) { const f32x4 v = acc[ai][bj][m][n];
                        *(f32x4*)(rowp + bj * HALF + n * 16) = (f32x4){sigmoid_fast(v[0]), sigmoid_fast(v[1]), sigmoid_fast(v[2]), sigmoid_fast(v[3])}; } }
    }
};
struct EpiGateUp {
    static constexpr bool PERM = true;
    bf16_t* O;
    __device__ __forceinline__ void operator()(const f32x4 (&acc)[2][2][4][2], const Unit& u, int wr, int wc, int fr, int fq) const {
        const int row0 = u.pm * BM + wr * 64 + fr, col0 = u.pn * HALF + wc * 32 + 8 * fq;
#pragma unroll
        for (int ai = 0; ai < 2; ++ai)
#pragma unroll
            for (int m = 0; m < 4; ++m) {
                const f32x4 g0 = acc[ai][0][m][0], g1 = acc[ai][0][m][1], u0 = acc[ai][1][m][0], u1 = acc[ai][1][m][1];
                int d0 = __builtin_amdgcn_cvt_pk_fp8_f32(silu_fast(g0[0]) * u0[0] * 8.0f, silu_fast(g0[1]) * u0[1] * 8.0f, 0, false); d0 = __builtin_amdgcn_cvt_pk_fp8_f32(silu_fast(g0[2]) * u0[2] * 8.0f, silu_fast(g0[3]) * u0[3] * 8.0f, d0, true);
                int d1 = __builtin_amdgcn_cvt_pk_fp8_f32(silu_fast(g1[0]) * u1[0] * 8.0f, silu_fast(g1[1]) * u1[1] * 8.0f, 0, false); d1 = __builtin_amdgcn_cvt_pk_fp8_f32(silu_fast(g1[2]) * u1[2] * 8.0f, silu_fast(g1[3]) * u1[3] * 8.0f, d1, true);
                *(u32x2*)((char*)O + (size_t)(row0 + ai * HALF + m * 16) * 256 + col0) = (u32x2){(unsigned)d0, (unsigned)d1};
            }
    }
};
struct EpiF32 {
    static constexpr bool PERM = false;
    float* O;
    __device__ __forceinline__ void operator()(const f32x4 (&acc)[2][2][4][2], const Unit& u, int wr, int wc, int fr, int fq) const {
        const int row0 = u.pm * BM + wr * 64 + fr, col0 = u.pn * BM + wc * 32 + 4 * fq;
#pragma unroll
        for (int ai = 0; ai < 2; ++ai)
#pragma unroll
            for (int m = 0; m < 4; ++m) { float* rowp = O + (size_t)(row0 + ai * HALF + m * 16) * DM + col0;
#pragma unroll
                for (int bj = 0; bj < 2; ++bj)
#pragma unroll
                    for (int n = 0; n < 2; ++n) *(f32x4*)(rowp + bj * HALF + n * 16) = acc[ai][bj][m][n]; }
    }
};
struct ExpertSched {
    const LAS int* toff;
    const LAS int* offs;
    const LAS int* cntl;
    const char* gbase; unsigned lda;
    const unsigned short* ltok;
    const char* Ad;
    const char* Bt; size_t bexp; unsigned ldb;
    int ncolt, G, c, total;
    __device__ __forceinline__ bool next(int i, Unit& u) const {
        const int L = i * G + c; if (L >= total) return false;
        int lo = 0, hi = 256;
        while (hi - lo > 1) { const int mid = (lo + hi) >> 1; if (__builtin_amdgcn_readfirstlane(toff[mid]) <= L) lo = mid; else hi = mid; }
        const int lt = L - __builtin_amdgcn_readfirstlane(toff[lo]);
        u.e = lo; u.pm = lt / ncolt; u.pn = lt % ncolt; u.rows = __builtin_amdgcn_readfirstlane(cntl[lo]) - u.pm * BM;
        u.b = Bt + (size_t)lo * bexp + (size_t)u.pn * BM * ldb;
        u.a = Ad ? Ad + (size_t)(__builtin_amdgcn_readfirstlane(offs[lo]) + u.pm * BM) * lda : nullptr;
        return true;
    }
    __device__ __forceinline__ unsigned row_off(const Unit& u, int rl) const {
        const int r = u.pm * BM + rl, cn = __builtin_amdgcn_readfirstlane(cntl[u.e]);
        const int tok = ltok[(size_t)u.e * CAP + (r < cn ? r : 0)];
        return (unsigned)tok * lda;
    }
};
struct EpiExpGU {
    static constexpr bool PERM = true;
    bf16_t* O; const LAS int* offs; const LAS int* cntl;
    __device__ __forceinline__ void operator()(const f32x4 (&acc)[2][2][4][2], const Unit& u, int wr, int wc, int fr, int fq) const {
        const int cn = __builtin_amdgcn_readfirstlane(cntl[u.e]), ro = __builtin_amdgcn_readfirstlane(offs[u.e]);
        const int rl0 = u.pm * BM + wr * 64 + fr, col0 = u.pn * HALF + wc * 32 + 8 * fq;
#pragma unroll
        for (int ai = 0; ai < 2; ++ai)
#pragma unroll
            for (int m = 0; m < 4; ++m) {
                const int rl = rl0 + ai * HALF + m * 16;
                const unsigned ob = (unsigned)(rl < cn ? ro + rl : NL * 8) * 256u + (unsigned)col0;
                const f32x4 g0 = acc[ai][0][m][0] * (1.0f / 32.0f), g1 = acc[ai][0][m][1] * (1.0f / 32.0f), u0 = acc[ai][1][m][0] * (8.0f / 32.0f), u1 = acc[ai][1][m][1] * (8.0f / 32.0f);
                int d0 = __builtin_amdgcn_cvt_pk_fp8_f32(silu_fast(g0[0]) * u0[0], silu_fast(g0[1]) * u0[1], 0, false); d0 = __builtin_amdgcn_cvt_pk_fp8_f32(silu_fast(g0[2]) * u0[2], silu_fast(g0[3]) * u0[3], d0, true);
                int d1 = __builtin_amdgcn_cvt_pk_fp8_f32(silu_fast(g1[0]) * u1[0], silu_fast(g1[1]) * u1[1], 0, false); d1 = __builtin_amdgcn_cvt_pk_fp8_f32(silu_fast(g1[2]) * u1[2], silu_fast(g1[3]) * u1[3], d1, true);
                *(u32x2*)((char*)O + ob) = (u32x2){(unsigned)d0, (unsigned)d1};
            }
    }
};
#define YB_SCALE 8.0f
struct EpiExpDown {
    static constexpr bool PERM = true;
    bf16_t* O; const LAS int* offs; const LAS int* cntl;
    __device__ __forceinline__ void operator()(const f32x4 (&acc)[2][2][4][2], const Unit& u, int wr, int wc, int fr, int fq) const {
        const int cn = __builtin_amdgcn_readfirstlane(cntl[u.e]), ro = __builtin_amdgcn_readfirstlane(offs[u.e]);
        const int rl0 = u.pm * BM + wr * 64 + fr, col0 = u.pn * BM + wc * 32 + 8 * fq;
#pragma unroll
        for (int ai = 0; ai < 2; ++ai)
#pragma unroll
            for (int m = 0; m < 4; ++m) {
                const int rl = rl0 + ai * HALF + m * 16;
                const unsigned ob = (unsigned)(rl < cn ? ro + rl : NL * 8) * DM + (unsigned)col0;
#pragma unroll
                for (int bj = 0; bj < 2; ++bj) { const f32x4 v0 = acc[ai][bj][m][0] * (YB_SCALE / 128.0f), v1 = acc[ai][bj][m][1] * (YB_SCALE / 128.0f);
                    int d0 = __builtin_amdgcn_cvt_pk_fp8_f32(v0[0], v0[1], 0, false); d0 = __builtin_amdgcn_cvt_pk_fp8_f32(v0[2], v0[3], d0, true);
                    int d1 = __builtin_amdgcn_cvt_pk_fp8_f32(v1[0], v1[1], 0, false); d1 = __builtin_amdgcn_cvt_pk_fp8_f32(v1[2], v1[3], d1, true);
                    *(u32x2*)((char*)O + ob + bj * HALF) = (u32x2){(unsigned)d0, (unsigned)d1}; }
            }
    }
};
struct EpiAddG2 {
    static constexpr bool PERM = false;
    float* O; const float* modv;
    __device__ __forceinline__ void operator()(const f32x4 (&acc)[2][2][4][2], const Unit& u, int wr, int wc, int fr, int fq) const {
        const int row0 = u.pm * BM + wr * 64 + fr, col0 = u.pn * BM + wc * 32 + 4 * fq;
        const float* g2 = modv + ((u.pm * BM) / SEQ) * 6144 + 5120;
#pragma unroll
        for (int bj = 0; bj < 2; ++bj)
#pragma unroll
            for (int n = 0; n < 2; ++n) {
                const int c = col0 + bj * HALF + n * 16;
                const f32x4 g = *(const f32x4*)(g2 + c);
                f32x4 xv[8];
#pragma unroll
                for (int ai = 0; ai < 2; ++ai)
#pragma unroll
                    for (int m = 0; m < 4; ++m) xv[ai * 4 + m] = *(const f32x4*)(O + (size_t)(row0 + ai * HALF + m * 16) * DM + c);
#pragma unroll
                for (int ai = 0; ai < 2; ++ai)
#pragma unroll
                    for (int m = 0; m < 4; ++m) *(f32x4*)(O + (size_t)(row0 + ai * HALF + m * 16) * DM + c) = xv[ai * 4 + m] + g * acc[ai][bj][m][n];
            }
    }
};
}

__device__ __forceinline__ float4 ld4(const float* p) { return *(const float4*)p; }
__device__ __forceinline__ float4 ld4(const bf16_t* p) { const u32x2 w = *(const u32x2*)p; return make_float4(bflo(w[0]), bfhi(w[0]), bflo(w[1]), bfhi(w[1])); }
template <bool DUAL, class AF, class EF>
__device__ __forceinline__ void gemm_naive(float* lds, int m0, int n0, int M, int N, int K, AF arow,
                                           const float* __restrict__ B0, const float* __restrict__ B1, int ldb, EF epi) {
    float* As = lds;
    float* Bs0 = lds + 16 * 132;
    float* Bs1 = Bs0 + 16 * 64;
    const int tid = threadIdx.x;
    const int ty = tid >> 4, tx = tid & 15;
    float acc0[4][4], acc1[4][4];
#pragma unroll
    for (int i = 0; i < 4; ++i)
#pragma unroll
        for (int j = 0; j < 4; ++j) { acc0[i][j] = 0.f; acc1[i][j] = 0.f; }
    const int am = tid >> 2, ak = (tid & 3) * 4;
    const int bk = (tid >> 4) & 15, bn = (tid & 15) * 4;
    const bool bthr = tid < 256;
    auto ap = arow((m0 + am < M) ? (m0 + am) : m0);
    const bool aok = (m0 + am) < M;
    const bool bok = bthr && (n0 + bn) < N;
    for (int k0 = 0; k0 < K; k0 += 16) {
        float4 av = aok ? ld4(ap + k0 + ak) : make_float4(0.f, 0.f, 0.f, 0.f);
        float4 bv0 = bok ? *(const float4*)(B0 + (size_t)(k0 + bk) * ldb + n0 + bn) : make_float4(0.f, 0.f, 0.f, 0.f);
        float4 bv1 = make_float4(0.f, 0.f, 0.f, 0.f);
        if (DUAL) bv1 = bok ? *(const float4*)(B1 + (size_t)(k0 + bk) * ldb + n0 + bn) : make_float4(0.f, 0.f, 0.f, 0.f);
        __syncthreads();
        As[(ak + 0) * 132 + am] = av.x; As[(ak + 1) * 132 + am] = av.y; As[(ak + 2) * 132 + am] = av.z; As[(ak + 3) * 132 + am] = av.w;
        if (bthr) { *(float4*)&Bs0[bk * 64 + bn] = bv0; if (DUAL) *(float4*)&Bs1[bk * 64 + bn] = bv1; }
        __syncthreads();
#pragma unroll
        for (int kk = 0; kk < 16; ++kk) {
            const float4 a = *(const float4*)&As[kk * 132 + ty * 4];
            const float4 b = *(const float4*)&Bs0[kk * 64 + tx * 4];
            const float aa[4] = {a.x, a.y, a.z, a.w};
            const float bb[4] = {b.x, b.y, b.z, b.w};
#pragma unroll
            for (int i = 0; i < 4; ++i)
#pragma unroll
                for (int j = 0; j < 4; ++j) acc0[i][j] = fmaf(aa[i], bb[j], acc0[i][j]);
            if (DUAL) {
                const float4 b1 = *(const float4*)&Bs1[kk * 64 + tx * 4];
                const float bb1[4] = {b1.x, b1.y, b1.z, b1.w};
#pragma unroll
                for (int i = 0; i < 4; ++i)
#pragma unroll
                    for (int j = 0; j < 4; ++j) acc1[i][j] = fmaf(aa[i], bb1[j], acc1[i][j]);
            }
        }
    }
#pragma unroll
    for (int i = 0; i < 4; ++i)
#pragma unroll
        for (int j = 0; j < 4; ++j) {
            const int m = m0 + ty * 4 + i, n = n0 + tx * 4 + j;
            if (m < M && n < N) epi(m, n, acc0[i][j], acc1[i][j]);
        }
    __syncthreads();
}

__device__ __forceinline__ void modv_unit(const Params& p, float* lds, int u) {
    float* red = lds + 17 * 1024;
    const int tid = threadIdx.x, col_l = tid & 31, kg = tid >> 5;
    const int col = u * 32 + col_l;
    float acc[17];
#pragma unroll
    for (int b = 0; b < 17; ++b) acc[b] = 0.f;
    for (int k = kg * 64; k < kg * 64 + 64; ++k) {
        const float w = p.ada_w[(size_t)k * 6144 + col];
#pragma unroll
        for (int b = 0; b < 17; ++b) acc[b] = fmaf(lds[b * 1024 + k], w, acc[b]);
    }
#pragma unroll
    for (int b = 0; b < 17; ++b) {
        __syncthreads();
        red[kg * 32 + col_l] = acc[b];
        __syncthreads();
        if (kg == 0) {
            float s = 0.f;
#pragma unroll
            for (int g = 0; g < 16; ++g) s += red[g * 32 + col_l];
            p.modv[b * 6144 + col] = s + p.ada_b[col];
        }
    }
}

struct CvtJob { const float* W; bf16_t* dst; int ldw, N, k0, n0, ldd, map; float f8;
};
#define NJ_DENSE 552
#define NJ_TOTAL (NJ_DENSE + 256 * 96)
__device__ __forceinline__ CvtJob cvt_decode(const Params& p, int u) {
    CvtJob j;
    const int J0 = 264, J1 = J0 + 128, J2 = J1 + 32, J3 = J2 + 32, J4 = J3 + 32, J5 = J4 + 32;
    if (u >= NJ_DENSE) {
        const int v = u - NJ_DENSE, e = v / 96, r = v % 96, which = r >> 5, l = r & 31;
        if (which < 2) { j.W = (which ? p.ew_up : p.ew_gate) + (size_t)e * DM * 256; j.dst = (bf16_t*)((char*)p.eguT + (size_t)e * 512 * DM); j.ldw = 256; j.N = 256; j.k0 = (l >> 2) * 128; j.n0 = (l & 3) * 64; j.ldd = DM; j.map = 2 + which; j.f8 = 32.0f; }
        else { j.W = p.ew_down + (size_t)e * 256 * DM; j.dst = (bf16_t*)((char*)p.edT + (size_t)e * DM * 256); j.ldw = DM; j.N = DM; j.k0 = (l >> 4) * 128; j.n0 = (l & 15) * 64; j.ldd = 256; j.map = 0; j.f8 = 16.0f; }
        return j;
    }
    j.f8 = 0.0f;
    if (u < J0) { j.W = p.w_in; j.dst = p.w_inT; j.ldw = DIN; j.N = DIN; j.k0 = (u / 33) * 128; j.n0 = (u % 33) * 64; j.ldd = DM; j.map = 1; }
    else if (u < J1) { const int l = u - J0; j.W = p.w_out; j.dst = p.w_outT; j.ldw = DM; j.N = DM; j.k0 = (l / 16) * 128; j.n0 = (l % 16) * 64; j.ldd = DM; j.map = 0; }
    else if (u < J2) { const int l = u - J1; j.W = p.glu_w; j.dst = p.gluT; j.ldw = 512; j.N = 512; j.k0 = (l / 8) * 128; j.n0 = (l % 8) * 64; j.ldd = 512; j.map = 0; }
    else if (u < J3) { const int l = u - J2; j.W = p.router_w; j.dst = p.routerT3; j.ldw = 256; j.N = 256; j.k0 = (l / 4) * 128; j.n0 = (l % 4) * 64; j.ldd = 3072; j.map = 4; }
    else if (u < J4) { const int l = u - J3; j.W = p.sw_gate; j.dst = p.shguT; j.ldw = 256; j.N = 256; j.k0 = (l / 4) * 128; j.n0 = (l % 4) * 64; j.ldd = DM; j.map = 2; }
    else if (u < J5) { const int l = u - J4; j.W = p.sw_up; j.dst = p.shguT; j.ldw = 256; j.N = 256; j.k0 = (l / 4) * 128; j.n0 = (l % 4) * 64; j.ldd = DM; j.map = 3; }
    else { const int l = u - J5; j.W = p.sw_down; j.dst = p.shdT; j.ldw = DM; j.N = DM; j.k0 = (l / 16) * 128; j.n0 = (l % 16) * 64; j.ldd = 256; j.map = 0; j.f8 = 16.0f; }
    return j;
}
__device__ __forceinline__ int cvt_rowmap(int map, int c) {
    if (map == 1) return c < S_LR ? c : (c < S_U ? (WC_LR + (c - S_LR)) : (WC_U + (c - S_U)));
    if (map == 2) return (c >> 7) * 256 + (c & 127);
    if (map == 3) return (c >> 7) * 256 + 128 + (c & 127);
    return c;
}
__device__ __forceinline__ void cvt_load(const CvtJob& j, float4 (&r)[4]) {
    const int tid = threadIdx.x;
#pragma unroll
    for (int i = 0; i < 2; ++i) {
        const int kk = (j.f8 != 0.0f) ? (tid >> 4) * 4 + 2 * i : (tid >> 4) * 2 + 64 * i, n = j.n0 + (tid & 15) * 4;
        r[2 * i] = make_float4(0.f, 0.f, 0.f, 0.f); r[2 * i + 1] = r[2 * i];
        if (n < j.N) { r[2 * i] = *(const float4*)(j.W + (size_t)(j.k0 + kk) * j.ldw + n); r[2 * i + 1] = *(const float4*)(j.W + (size_t)(j.k0 + kk + 1) * j.ldw + n); }
    }
}
__device__ __forceinline__ void cvt_fill(const CvtJob& j, const float4 (&r)[4], unsigned* T, unsigned* T2) {
    const int tid = threadIdx.x;
    if (j.f8 != 0.0f) {
        const int nl = (tid & 15) * 4, kq = tid >> 4; const float s = j.f8;
        const float a0[4] = {r[0].x, r[0].y, r[0].z, r[0].w}, a1[4] = {r[1].x, r[1].y, r[1].z, r[1].w}, a2[4] = {r[2].x, r[2].y, r[2].z, r[2].w}, a3[4] = {r[3].x, r[3].y, r[3].z, r[3].w};
#pragma unroll
        for (int q = 0; q < 4; ++q) { int w = __builtin_amdgcn_cvt_pk_fp8_f32(a0[q] * s, a1[q] * s, 0, false); w = __builtin_amdgcn_cvt_pk_fp8_f32(a2[q] * s, a3[q] * s, w, true); T[(nl + q) * 33 + kq] = (unsigned)w; }
        return;
    }
#pragma unroll
    for (int i = 0; i < 2; ++i) {
        const int kk = (tid >> 4) * 2 + 64 * i, nl = (tid & 15) * 4;
        const float av[4] = {r[2 * i].x, r[2 * i].y, r[2 * i].z, r[2 * i].w}, bv[4] = {r[2 * i + 1].x, r[2 * i + 1].y, r[2 * i + 1].z, r[2 * i + 1].w};
#pragma unroll
        for (int q = 0; q < 4; ++q) {
            const unsigned w = cvt_pk_bf16(av[q], bv[q]);
            T[(nl + q) * 65 + (kk >> 1)] = w;
            if (j.map == 4) T2[(nl + q) * 65 + (kk >> 1)] = cvt_pk_bf16(av[q] - bflo(w), bv[q] - bfhi(w));
        }
    }
}
__device__ __forceinline__ void cvt_drain(const CvtJob& j, const unsigned* T, const unsigned* T2) {
    const int tid = threadIdx.x;
    const int n_l = tid >> 3, seg = tid & 7;
    if (j.f8 != 0.0f) {
        if (j.n0 + n_l < j.N) {
            const int rr = cvt_rowmap(j.map, j.n0 + n_l);
            u32x4 w0;
#pragma unroll
            for (int w = 0; w < 4; ++w) w0[w] = T[n_l * 33 + seg * 4 + w];
            *(u32x4*)((char*)j.dst + (size_t)rr * j.ldd + j.k0 + seg * 16) = w0;
        }
        return;
    }
    if (j.n0 + n_l < j.N) {
        const int rr = cvt_rowmap(j.map, j.n0 + n_l);
        u32x4 w0, w1;
#pragma unroll
        for (int w = 0; w < 4; ++w) { w0[w] = T[n_l * 65 + seg * 8 + w]; w1[w] = T[n_l * 65 + seg * 8 + 4 + w]; }
        bf16_t* d = j.dst + (size_t)rr * j.ldd + j.k0 + seg * 16;
        *(u32x4*)d = w0; *(u32x4*)(d + 8) = w1;
        if (j.map == 4) {
            *(u32x4*)(d + 1024) = w0; *(u32x4*)(d + 1032) = w1;
#pragma unroll
            for (int w = 0; w < 4; ++w) { w0[w] = T2[n_l * 65 + seg * 8 + w]; w1[w] = T2[n_l * 65 + seg * 8 + 4 + w]; }
            *(u32x4*)(d + 2048) = w0; *(u32x4*)(d + 2056) = w1;
        }
    }
}

__device__ __forceinline__ void phase_prologue(const Params& p, float* lds, const int part) {
    const int tid = threadIdx.x, bid = blockIdx.x, nb = gridDim.x;
    if (part == 0) {
    if (bid < 192) {
        for (int i = tid; i < 17 * 1024; i += NT) {
            const int b = i >> 10, k = i & 1023;
            lds[i] = siluf_((b < 16) ? p.c[b * 1024 + k] : p.c_ctx[k]);
        }
        __syncthreads();
        for (int u = bid; u < 192; u += nb) modv_unit(p, lds, u);
        __syncthreads();
    }
    { u32x4* zp = (u32x4*)(p.w_inT + (size_t)DIN * DM); const int nz = (2304 - DIN) * DM * 2 / 16;
      for (int i = bid * NT + tid; i < nz; i += nb * NT) zp[i] = (u32x4){0u, 0u, 0u, 0u}; }
    return;
    }
    unsigned* Tb = (unsigned*)lds;
    int u = nb - 1 - bid, par = 0;
    if (u < NJ_TOTAL) {
        CvtJob jA = cvt_decode(p, u), jB = jA; float4 rA[4], rB[4];
        bool hB = (u + nb) < NJ_TOTAL;
        cvt_load(jA, rA);
        if (hB) { jB = cvt_decode(p, u + nb); cvt_load(jB, rB); } else { for (int q = 0; q < 4; ++q) rB[q] = rA[q]; }
        for (;;) {
            const int un = u + 2 * nb; const bool hnA = un < NJ_TOTAL, hnB = (un + nb) < NJ_TOTAL;
            CvtJob jnA = jA, jnB = jB; float4 rnA[4], rnB[4];
            if (hnA) { jnA = cvt_decode(p, un); cvt_load(jnA, rnA); } else { for (int q = 0; q < 4; ++q) rnA[q] = rA[q]; }
            if (hnB) { jnB = cvt_decode(p, un + nb); cvt_load(jnB, rnB); } else { for (int q = 0; q < 4; ++q) rnB[q] = rB[q]; }
            unsigned* T0 = Tb + (par * 2 + 0) * (64 * 65); unsigned* T1 = Tb + (par * 2 + 1) * (64 * 65); unsigned* T2 = Tb + 4 * (64 * 65);
            cvt_fill(jA, rA, T0, T2);
            if (hB) cvt_fill(jB, rB, T1, T2);
            __syncthreads();
            cvt_drain(jA, T0, T2);
            if (hB) cvt_drain(jB, T1, T2);
            if (jA.map == 4 || jB.map == 4) __syncthreads();
            if (!hnA) break;
            par ^= 1; u = un; jA = jnA; jB = jnB; hB = hnB;
#pragma unroll
            for (int q = 0; q < 4; ++q) { rA[q] = rnA[q]; rB[q] = rnB[q]; }
        }
    }
    __syncthreads();
}

__device__ __forceinline__ void phase_norm_mod(const Params& p, int which) {
    const int lane = threadIdx.x & 63, wave = threadIdx.x >> 6;
    const int nrows = which == 0 ? NR : NL;
    const float* g = which == 0 ? p.norm1_g : p.norm2_g;
    const int osh = which == 0 ? 0 : 3072, osc = which == 0 ? 1024 : 4096;
    auto rowsrc = [&](int r) -> const float* {
        if (which == 0) return (r < NL) ? p.x + (size_t)r * DM : p.ctx + (size_t)(r - NL) * DM;
        return p.out + (size_t)r * DM;
    };
    const int stride = gridDim.x * NWAVES, rbase = blockIdx.x * NWAVES + wave;
    float4 ring[3][4];
#pragma unroll
    for (int k = 0; k < 3; ++k) if (rbase + k * stride < nrows) { const float* s0 = rowsrc(rbase + k * stride);
#pragma unroll
        for (int i = 0; i < 2; ++i) {
            if (which == 1) ring[k][i] = __builtin_bit_cast(float4, *(const u32x4*)(p.yf + (size_t)(rbase + k * stride) * DM + i * 512 + lane * 8));
            else { ring[k][2 * i] = *(const float4*)(s0 + i * 512 + lane * 8); ring[k][2 * i + 1] = *(const float4*)(s0 + i * 512 + lane * 8 + 4); } } }
    for (int r0 = rbase; r0 < nrows; r0 += 3 * stride) {
#pragma unroll
      for (int k = 0; k < 3; ++k) {
        const int r = r0 + k * stride;
        if (r >= nrows) break;
        const int b = (which == 0 && r >= NL) ? 16 : r / SEQ;
        float4 v[4]; float ss = 0.f;
#pragma unroll
        for (int i = 0; i < 4; ++i) v[i] = ring[k][i];
        if (which == 1) {
#pragma unroll
            for (int i = 0; i < 2; ++i) { const u32x4 w_ = __builtin_bit_cast(u32x4, ring[k][i]);
                v[2 * i] = make_float4(bflo(w_[0]), bfhi(w_[0]), bflo(w_[1]), bfhi(w_[1])); v[2 * i + 1] = make_float4(bflo(w_[2]), bfhi(w_[2]), bflo(w_[3]), bfhi(w_[3])); }
        }
        {
            const int rn = r + 3 * stride;
            if (rn < nrows) { const float* s1 = rowsrc(rn);
#pragma unroll
                for (int i = 0; i < 2; ++i) {
                    if (which == 1) ring[k][i] = __builtin_bit_cast(float4, *(const u32x4*)(p.yf + (size_t)rn * DM + i * 512 + lane * 8));
                    else { ring[k][2 * i] = *(const float4*)(s1 + i * 512 + lane * 8); ring[k][2 * i + 1] = *(const float4*)(s1 + i * 512 + lane * 8 + 4); } } }
        }
#pragma unroll
        for (int i = 0; i < 4; ++i) ss += v[i].x * v[i].x + v[i].y * v[i].y + v[i].z * v[i].z + v[i].w * v[i].w;
        ss = wave_sum(ss);
        const float rstd = rsqrtf(ss * (1.0f / DM) + EPS);
        const float* mv = p.modv + b * 6144;
#pragma unroll
        for (int i = 0; i < 2; ++i) {
            const int col = i * 512 + lane * 8;
            float o[8];
#pragma unroll
            for (int h = 0; h < 2; ++h) {
                const float4 gg = *(const float4*)(g + col + 4 * h), sh = *(const float4*)(mv + osh + col + 4 * h), sc = *(const float4*)(mv + osc + col + 4 * h);
                const float4 vv = v[2 * i + h];
                o[4 * h + 0] = vv.x * rstd * gg.x * (1.f + sc.x) + sh.x; o[4 * h + 1] = vv.y * rstd * gg.y * (1.f + sc.y) + sh.y;
                o[4 * h + 2] = vv.z * rstd * gg.z * (1.f + sc.z) + sh.z; o[4 * h + 3] = vv.w * rstd * gg.w * (1.f + sc.w) + sh.w;
            }
            u32x4 hi = (u32x4){cvt_pk_bf16(o[0], o[1]), cvt_pk_bf16(o[2], o[3]), cvt_pk_bf16(o[4], o[5]), cvt_pk_bf16(o[6], o[7])};
            if (which == 0) {
                *(u32x4*)(p.hx + (size_t)r * DM + col) = hi;
            } else {
                *(u32x4*)(p.hx + (size_t)r * DM + col) = hi;
                { int d0 = __builtin_amdgcn_cvt_pk_fp8_f32(o[0], o[1], 0, false); d0 = __builtin_amdgcn_cvt_pk_fp8_f32(o[2], o[3], d0, true);
                  int d1 = __builtin_amdgcn_cvt_pk_fp8_f32(o[4], o[5], 0, false); d1 = __builtin_amdgcn_cvt_pk_fp8_f32(o[6], o[7], d1, true);
                  *(u32x2*)((char*)p.of + (size_t)r * DM + col) = (u32x2){(unsigned)d0, (unsigned)d1}; }
            }
        }
    }
    }
}

__device__ __forceinline__ int scan_row(int b, int dir, int s, bool& lat) {
    if (s < CTX) { lat = false; const int t = dir ? (CTX - 1 - s) : s; return NL + b * CTX + t; }
    lat = true; const int t = dir ? (SEQ - 1 - (s - CTX)) : (s - CTX); return b * SEQ + t;
}

#define GL_LD 72
__device__ __forceinline__ void gla_chunk_unit(const Params& p, unsigned char* lds8, int unit) {
    const int dir = unit & 1, h = (unit >> 1) & 3, b = unit >> 3;
    const int tid = threadIdx.x, lane = tid & 63, w = __builtin_amdgcn_readfirstlane(tid >> 6), fr = lane & 15, fq = lane >> 4;
    const int tc = tid >> 3, g8 = tid & 7;
    bf16_t* Qc = (bf16_t*)lds8;            bf16_t* Ki = Qc + 64 * GL_LD;   bf16_t* Pm = Ki + 64 * GL_LD;
    bf16_t* KsT = Pm + 64 * GL_LD;         bf16_t* VT = KsT + 64 * GL_LD;  bf16_t* ST = VT + 128 * GL_LD;
    float* LA = (float*)(ST + 128 * GL_LD); float* SEG = LA + 64 * 64;      float* LR = SEG + 8 * 64;
    float* WA = LR + 64 * 16;              float* BA = WA + 16 * 64;       float* DEC = BA + 64;   float* CL = DEC + 64;
    const float* wa = dir ? p.wa_b : p.wa_f;
    const float* ba = dir ? p.ba_b : p.ba_f;
    __syncthreads();
    for (int i = tid; i < 100 * 1024 / 4; i += NT) ((unsigned*)lds8)[i] = 0u;
    __syncthreads();
    f32x4 accS[4];
#pragma unroll
    for (int j = 0; j < 4; ++j) accS[j] = (f32x4){0.f, 0.f, 0.f, 0.f};
    const int tm = w >> 1, pr = w & 1;
    bf16x8 wfrag[2]; f32x4 bav[2];
#pragma unroll
    for (int j = 0; j < 2; ++j) {
        const int dk0 = (pr * 2 + j) * 16;
        u32x4 wv = (u32x4){0u, 0u, 0u, 0u};
        if (fq < 2) {
            float t8[8];
#pragma unroll
            for (int i = 0; i < 8; ++i) t8[i] = wa[(fq * 8 + i) * 256 + h * 64 + dk0 + fr];
            wv = (u32x4){cvt_pk_bf16(t8[0], t8[1]), cvt_pk_bf16(t8[2], t8[3]), cvt_pk_bf16(t8[4], t8[5]), cvt_pk_bf16(t8[6], t8[7])};
        }
        wfrag[j] = __builtin_bit_cast(bf16x8, wv);
        bav[j] = (f32x4){ba[h * 64 + dk0 + fq * 4], ba[h * 64 + dk0 + fq * 4 + 1], ba[h * 64 + dk0 + fq * 4 + 2], ba[h * 64 + dk0 + fq * 4 + 3]};
    }
    auto row_of = [&](int sc, int c) -> int {
        if (sc < 4) { const int tok = dir ? ((3 - sc) * 64 + 63 - c) : (sc * 64 + c); return NL + b * CTX + tok; }
        const int n = sc - 4; const int tok = dir ? ((31 - n) * 64 + 63 - c) : (n * 64 + c); return b * SEQ + tok;
    };
    u32x4 rq, rk, rv, rv2; unsigned rl;
    {
        const bf16_t* pr0 = p.proj + (size_t)row_of(0, tc) * DINP;
        rq = *(const u32x4*)(pr0 + P_Q + h * 64 + g8 * 8); rk = *(const u32x4*)(pr0 + P_K + h * 64 + g8 * 8);
        rv = *(const u32x4*)(pr0 + P_V + h * 128 + g8 * 16); rv2 = *(const u32x4*)(pr0 + P_V + h * 128 + g8 * 16 + 8); rl = *(const unsigned*)(pr0 + P_LRF + dir * 16 + g8 * 2);
    }
    for (int sc = 0; sc < 36; ++sc) {
        const bool lat = sc >= 4;
        const u32x4 cq = rq, ck = rk, cv = rv, cv2 = rv2; const unsigned cl_ = rl;
        if (sc + 1 < 36) {
            const bf16_t* pr1 = p.proj + (size_t)row_of(sc + 1, tc) * DINP;
            rq = *(const u32x4*)(pr1 + P_Q + h * 64 + g8 * 8); rk = *(const u32x4*)(pr1 + P_K + h * 64 + g8 * 8);
            rv = *(const u32x4*)(pr1 + P_V + h * 128 + g8 * 16); rv2 = *(const u32x4*)(pr1 + P_V + h * 128 + g8 * 16 + 8); rl = *(const unsigned*)(pr1 + P_LRF + dir * 16 + g8 * 2);
        }
        ((unsigned*)LR)[tc * 8 + g8] = cl_;
        __syncthreads();
        {
            u32x4 lv = (u32x4){0u, 0u, 0u, 0u};
            if (fq < 2) lv = *(const u32x4*)((const unsigned char*)LR + (tm * 16 + fr) * 32 + fq * 16);
            const bf16x8 lrf = __builtin_bit_cast(bf16x8, lv);
#pragma unroll
            for (int j = 0; j < 2; ++j) {
                f32x4 z = __builtin_amdgcn_mfma_f32_16x16x32_bf16(wfrag[j], lrf, (f32x4){0.f, 0.f, 0.f, 0.f}, 0, 0, 0);
                asm volatile("s_nop 15\n\ts_nop 15" : "+v"(z));
                z = z + bav[j];
                f32x4 o;
#pragma unroll
                for (int r = 0; r < 4; ++r) {
                    const float e = __builtin_amdgcn_exp2f(-fabsf(z[r]) * 1.4426950408889634f);
                    o[r] = (fminf(z[r], 0.0f) - __builtin_amdgcn_logf(1.0f + e) * 0.6931471805599453f) * (1.0f / 16.0f);
                }
                *(f32x4*)(LA + (tm * 16 + fr) * 64 + (pr * 2 + j) * 16 + fq * 4) = o;
            }
        }
        __syncthreads();
        {
            const int dk = tid & 63, sg = tid >> 6; float run = 0.f;
#pragma unroll
            for (int i = 0; i < 8; ++i) { run += LA[(sg * 8 + i) * 64 + dk]; LA[(sg * 8 + i) * 64 + dk] = run; }
            SEG[sg * 64 + dk] = run;
        }
        __syncthreads();
        if (tid < 64) {
            float run = 0.f;
#pragma unroll
            for (int s = 0; s < 8; ++s) { const float t = SEG[s * 64 + tid]; SEG[s * 64 + tid] = run; run += t; }
            CL[tid] = run; DEC[tid] = __builtin_amdgcn_exp2f(run * 1.4426950408889634f);
        }
        __syncthreads();
        {
            const float qv[8] = {bflo(cq[0]), bfhi(cq[0]), bflo(cq[1]), bfhi(cq[1]), bflo(cq[2]), bfhi(cq[2]), bflo(cq[3]), bfhi(cq[3])};
            const float kv[8] = {bflo(ck[0]), bfhi(ck[0]), bflo(ck[1]), bfhi(ck[1]), bflo(ck[2]), bfhi(ck[2]), bflo(ck[3]), bfhi(ck[3])};
            float qo[8], ko[8], ks[8];
#pragma unroll
            for (int i = 0; i < 8; ++i) {
                const int dk = g8 * 8 + i;
                const float cum = LA[tc * 64 + dk] + SEG[(tc >> 3) * 64 + dk];
                const float ec = __builtin_amdgcn_exp2f(cum * 1.4426950408889634f), en = __builtin_amdgcn_rcpf(ec), es = DEC[dk] * en;
                qo[i] = qv[i] * 0.125f * ec; ko[i] = kv[i] * en; ks[i] = kv[i] * es;
            }
#pragma unroll
            for (int i = 0; i < 8; i += 2) { const unsigned pk = cvt_pk_bf16(ks[i], ks[i + 1]);
                KsT[(g8 * 8 + i) * GL_LD + tc] = (bf16_t)(pk & 0xFFFFu); KsT[(g8 * 8 + i + 1) * GL_LD + tc] = (bf16_t)(pk >> 16); }
            *(u32x4*)(Qc + tc * GL_LD + g8 * 8) = (u32x4){cvt_pk_bf16(qo[0], qo[1]), cvt_pk_bf16(qo[2], qo[3]), cvt_pk_bf16(qo[4], qo[5]), cvt_pk_bf16(qo[6], qo[7])};
            *(u32x4*)(Ki + tc * GL_LD + g8 * 8) = (u32x4){cvt_pk_bf16(ko[0], ko[1]), cvt_pk_bf16(ko[2], ko[3]), cvt_pk_bf16(ko[4], ko[5]), cvt_pk_bf16(ko[6], ko[7])};
#pragma unroll
            for (int i = 0; i < 4; ++i) { VT[(g8 * 16 + 2 * i) * GL_LD + tc] = (bf16_t)(cv[i] & 0xFFFFu); VT[(g8 * 16 + 2 * i + 1) * GL_LD + tc] = (bf16_t)(cv[i] >> 16);
                                          VT[(g8 * 16 + 8 + 2 * i) * GL_LD + tc] = (bf16_t)(cv2[i] & 0xFFFFu); VT[(g8 * 16 + 9 + 2 * i) * GL_LD + tc] = (bf16_t)(cv2[i] >> 16); }
        }
        __syncthreads();
        f32x4 accO[4];
#pragma unroll
        for (int j = 0; j < 4; ++j) accO[j] = (f32x4){0.f, 0.f, 0.f, 0.f};
        bf16x8 yq[2];
        if (lat) {
#pragma unroll
            for (int kk = 0; kk < 2; ++kk) yq[kk] = *(const bf16x8*)(Qc + (tm * 16 + fr) * GL_LD + kk * 32 + fq * 8);
#pragma unroll
            for (int j = 0; j < 2; ++j) {
                const int ts = pr * 2 + j;
                f32x4 d = (f32x4){0.f, 0.f, 0.f, 0.f};
                if (ts <= tm) {
#pragma unroll
                    for (int kk = 0; kk < 2; ++kk) { const bf16x8 xk = *(const bf16x8*)(Ki + (ts * 16 + fr) * GL_LD + kk * 32 + fq * 8);
                        d = __builtin_amdgcn_mfma_f32_16x16x32_bf16(xk, yq[kk], d, 0, 0, 0); }
                    asm volatile("s_nop 15\n\ts_nop 15" : "+v"(d));
                    if (ts == tm) {
#pragma unroll
                        for (int r = 0; r < 4; ++r) d[r] = (fq * 4 + r <= fr) ? d[r] : 0.f;
                    }
                }
                *(u32x2*)(Pm + (tm * 16 + fr) * GL_LD + ts * 16 + fq * 4) = (u32x2){cvt_pk_bf16(d[0], d[1]), cvt_pk_bf16(d[2], d[3])};
            }
#pragma unroll
            for (int j = 0; j < 4; ++j) {
                const int tv = pr * 4 + j;
#pragma unroll
                for (int kk = 0; kk < 2; ++kk) { const bf16x8 xs = *(const bf16x8*)(ST + (tv * 16 + fr) * GL_LD + kk * 32 + fq * 8);
                    accO[j] = __builtin_amdgcn_mfma_f32_16x16x32_bf16(xs, yq[kk], accO[j], 0, 0, 0); }
            }
        }
        __syncthreads();
        {
            bf16x8 yp[2];
            if (lat) {
#pragma unroll
                for (int kk = 0; kk < 2; ++kk) yp[kk] = *(const bf16x8*)(Pm + (tm * 16 + fr) * GL_LD + kk * 32 + fq * 8);
            }
            const int orow = row_of(sc, tm * 16 + fr);
#pragma unroll
            for (int j = 0; j < 4; ++j) {
                const int tv = pr * 4 + j;
                bf16x8 xv[2];
#pragma unroll
                for (int kk = 0; kk < 2; ++kk) xv[kk] = *(const bf16x8*)(VT + (tv * 16 + fr) * GL_LD + kk * 32 + fq * 8);
                if (lat) {
#pragma unroll
                    for (int kk = 0; kk < 2; ++kk) accO[j] = __builtin_amdgcn_mfma_f32_16x16x32_bf16(xv[kk], yp[kk], accO[j], 0, 0, 0);
                    asm volatile("s_nop 15\n\ts_nop 15" : "+v"(accO[j]));
                    *(u32x2*)(p.of + ((size_t)dir * NL + orow) * 512 + h * 128 + tv * 16 + fq * 4) = (u32x2){cvt_pk_bf16(accO[j][0], accO[j][1]), cvt_pk_bf16(accO[j][2], accO[j][3])};
                }
                const f32x4 dc = *(const f32x4*)(DEC + tm * 16 + fq * 4);
                accS[j] = accS[j] * dc;
                asm volatile("s_nop 15\n\ts_nop 15" : "+v"(accS[j]));
#pragma unroll
                for (int kk = 0; kk < 2; ++kk) { const bf16x8 xks = *(const bf16x8*)(KsT + (tm * 16 + fr) * GL_LD + kk * 32 + fq * 8);
                    accS[j] = __builtin_amdgcn_mfma_f32_16x16x32_bf16(xks, xv[kk], accS[j], 0, 0, 0); }
                asm volatile("s_nop 15\n\ts_nop 15" : "+v"(accS[j]));
                *(u32x2*)(ST + (tv * 16 + fr) * GL_LD + tm * 16 + fq * 4) = (u32x2){cvt_pk_bf16(accS[j][0], accS[j][1]), cvt_pk_bf16(accS[j][2], accS[j][3])};
            }
        }
        __syncthreads();
    }
}

template <int dir> __device__ __forceinline__ void s5_wave_chain(const Params& p, int unit, unsigned char* wlds) {
    const int lane = threadIdx.x & 63, fr = lane & 15, fq = lane >> 4;
    const int g = (unit >> 1) & 31, b = unit >> 6;
    float* BU = (float*)wlds;
    bf16_t* XB = (bf16_t*)(wlds + 128 * 20 * 4);
    const float* lre = dir ? p.lam_re_b : p.lam_re_f;
    const float* lim = dir ? p.lam_im_b : p.lam_im_f;
    const float* lst = dir ? p.lstep_b : p.lstep_f;
    const float* cre = dir ? p.c_re_b : p.c_re_f;
    const float* cim = dir ? p.c_im_b : p.c_im_f;
    float a_re, a_im;
    {
        const float lam_re = lre[g * 64 + lane], lam_im = lim[g * 64 + lane];
        const float step = expf(lst[g]);
        const float mag = expf(lam_re * step);
        a_re = mag * cosf(lam_im * step); a_im = mag * sinf(lam_im * step);
    }
    bf16x8 yb[2][4];
#pragma unroll
    for (int st = 0; st < 4; ++st) {
        const int pp = st * 16 + fr;
        const float lam_re = lre[g * 64 + pp], lam_im = lim[g * 64 + pp];
        const float step = expf(lst[g]);
        const float mag = expf(lam_re * step);
        const float ar = mag * cosf(lam_im * step), ai = mag * sinf(lam_im * step);
        const float den = lam_re * lam_re + lam_im * lam_im;
        const float f_re = ((ar - 1.0f) * lam_re + ai * lam_im) / den;
        const float f_im = (ai * lam_re - (ar - 1.0f) * lam_im) / den;
        u32x4 wr_ = (u32x4){0u, 0u, 0u, 0u}, wi_ = wr_;
        if (fq < 2) {
            float vr[8], vi[8];
#pragma unroll
            for (int j = 0; j < 8; ++j) { const float br = p.b_re[(g * 64 + pp) * 16 + fq * 8 + j], bi = p.b_im[(g * 64 + pp) * 16 + fq * 8 + j];
                vr[j] = f_re * br - f_im * bi; vi[j] = f_re * bi + f_im * br; }
            wr_ = (u32x4){cvt_pk_bf16(vr[0], vr[1]), cvt_pk_bf16(vr[2], vr[3]), cvt_pk_bf16(vr[4], vr[5]), cvt_pk_bf16(vr[6], vr[7])};
            wi_ = (u32x4){cvt_pk_bf16(vi[0], vi[1]), cvt_pk_bf16(vi[2], vi[3]), cvt_pk_bf16(vi[4], vi[5]), cvt_pk_bf16(vi[6], vi[7])};
        }
        yb[0][st] = __builtin_bit_cast(bf16x8, wr_); yb[1][st] = __builtin_bit_cast(bf16x8, wi_);
    }
    bf16x8 cb[4];
#pragma unroll
    for (int kk = 0; kk < 4; ++kk) {
        float v[8];
#pragma unroll
        for (int j = 0; j < 8; ++j) { const int s = kk * 16 + fq * 4 + (j >> 1);
            v[j] = (j & 1) ? -cim[(g * 16 + fr) * 64 + s] : cre[(g * 16 + fr) * 64 + s]; }
        cb[kk] = __builtin_bit_cast(bf16x8, (u32x4){cvt_pk_bf16(v[0], v[1]), cvt_pk_bf16(v[2], v[3]), cvt_pk_bf16(v[4], v[5]), cvt_pk_bf16(v[6], v[7])});
    }
    auto crow = [&](int n) -> int { return (n < 16) ? (S5_ROWS - 256 + b * 16 + (dir ? 15 - n : n)) : (b * 128 + (dir ? 127 - (n - 16) : (n - 16))); };
    const bf16_t* Agg = p.Ag + (size_t)g * S5_ROWS * 512;
    const int tokidx = dir ? 15 - fr : fr;
    u32x4 rr[4];
#pragma unroll
    for (int k = 0; k < 4; ++k) { rr[k] = (u32x4){0u, 0u, 0u, 0u}; if (fq < 2) rr[k] = *(const u32x4*)(Agg + (size_t)crow(k) * 512 + tokidx * 16 + fq * 8); }
    f32x2_t X = {0.f, 0.f};
    const f32x2_t Are = {a_re, a_re}, Aimn = {-a_im, a_im};
    for (int i = lane; i < S5_WLDS / 4; i += 64) ((unsigned*)wlds)[i] = 0u;
    asm volatile("s_waitcnt lgkmcnt(0)" ::: "memory");
    for (int n4 = 0; n4 < 144; n4 += 4) {
#pragma unroll
      for (int k4 = 0; k4 < 4; ++k4) {
        const int n = n4 + k4;
        const bf16x8 xa = __builtin_bit_cast(bf16x8, rr[k4]);
        if (n + 4 < 144 && fq < 2) rr[k4] = *(const u32x4*)(Agg + (size_t)crow(n + 4) * 512 + tokidx * 16 + fq * 8);
        f32x4 d[2][4];
#pragma unroll
        for (int part = 0; part < 2; ++part)
#pragma unroll
            for (int st = 0; st < 4; ++st)
                d[part][st] = __builtin_amdgcn_mfma_f32_16x16x32_bf16(xa, yb[part][st], (f32x4){0.f, 0.f, 0.f, 0.f}, 0, 0, 0);
        asm volatile("s_nop 15\n\ts_nop 15" : "+v"(d[0][0]), "+v"(d[0][1]), "+v"(d[0][2]), "+v"(d[0][3]), "+v"(d[1][0]), "+v"(d[1][1]), "+v"(d[1][2]), "+v"(d[1][3]));
#pragma unroll
        for (int part = 0; part < 2; ++part)
#pragma unroll
            for (int st = 0; st < 4; ++st) if (part == 0) {
                float* bw = BU + (st * 16 + fr) * 36 + fq * 8;
                *(f32x4*)bw = (f32x4){d[0][st][0], d[1][st][0], d[0][st][1], d[1][st][1]};
                *(f32x4*)(bw + 4) = (f32x4){d[0][st][2], d[1][st][2], d[0][st][3], d[1][st][3]};
            }
        asm volatile("s_waitcnt lgkmcnt(0)" ::: "memory");
        {
            f32x4 b4[8];
#pragma unroll
            for (int q = 0; q < 8; ++q) b4[q] = *(const f32x4*)(BU + lane * 36 + q * 4);
#pragma unroll
            for (int t = 0; t < 16; ++t) {
                const f32x2_t Bt_ = {b4[t >> 1][(t & 1) * 2], b4[t >> 1][(t & 1) * 2 + 1]};
                const f32x2_t T_ = __builtin_elementwise_fma(Are, X, Bt_);
                f32x2_t Xs_ = {X[1], X[0]}; asm volatile("" : "+v"(Xs_));
                X = __builtin_elementwise_fma(Aimn, Xs_, T_);
                ((unsigned*)XB)[t * 68 + lane] = cvt_pk_bf16(X[0], X[1]);
            }
        }
        asm volatile("s_waitcnt lgkmcnt(0)" ::: "memory");
        if (n >= 16) {
            f32x4 y = (f32x4){0.f, 0.f, 0.f, 0.f};
#pragma unroll
            for (int kk = 0; kk < 4; ++kk) {
                const bf16x8 xf = *(const bf16x8*)(XB + fr * 136 + kk * 32 + fq * 8);
                y = __builtin_amdgcn_mfma_f32_16x16x32_bf16(xf, cb[kk], y, 0, 0, 0);
            }
            asm volatile("s_nop 15\n\ts_nop 15" : "+v"(y));
            const int row0 = crow(n) * 16;
#pragma unroll
            for (int r = 0; r < 4; ++r) { const int sp = fq * 4 + r, tk = dir ? 15 - sp : sp;
                p.yf[((size_t)dir * NL + row0 + tk) * 512 + g * 16 + fr] = f2bf(y[r]); }
        }
        asm volatile("s_waitcnt lgkmcnt(0)" ::: "memory");
      }
    }
}

__device__ __forceinline__ void phase_scans(const Params& p, float* lds) {
    const int bid = blockIdx.x, nb = gridDim.x;
    if (nb >= 256) {
        if (bid < 128) gla_chunk_unit(p, (unsigned char*)lds, bid);
        else {
            const int w = __builtin_amdgcn_readfirstlane(threadIdx.x >> 6), c = (bid - 128) * 8 + w;
            if (c & 1) s5_wave_chain<1>(p, c, (unsigned char*)lds + w * S5_WLDS); else s5_wave_chain<0>(p, c, (unsigned char*)lds + w * S5_WLDS);
        }
    } else {
        for (int u = bid; u < 128; u += nb) gla_chunk_unit(p, (unsigned char*)lds, u);
        __syncthreads();
        const int w = __builtin_amdgcn_readfirstlane(threadIdx.x >> 6);
        for (int c = bid * 8 + w; c < 1024; c += nb * 8) { if (c & 1) s5_wave_chain<1>(p, c, (unsigned char*)lds + w * S5_WLDS); else s5_wave_chain<0>(p, c, (unsigned char*)lds + w * S5_WLDS); }
    }
}

__device__ __forceinline__ void lr_columns(const Params& p, unsigned char* lds8) {
    const int tid = threadIdx.x, lane = tid & 63, w = tid >> 6, fr = lane & 15, fq = lane >> 4;
    bf16_t* W = (bf16_t*)lds8;
    const bool split = gridDim.x == 256;
    if (split && blockIdx.x < 128) return;
    const int wg = split ? blockIdx.x - 128 : blockIdx.x, nwg = split ? 128 : gridDim.x;
    __syncthreads();
    for (int i = tid; i < 32 * 128; i += NT) { const int n = i >> 7, c = i & 127; *(u32x4*)(W + n * 1032 + c * 8) = *(const u32x4*)(p.w_inT + (size_t)(WC_LR + n) * DM + c * 8); }
    __syncthreads();
    for (int t = wg * NWAVES + w; t < NR / 16; t += nwg * NWAVES) {
        const int tok0 = t * 16;
        f32x4 d0 = (f32x4){0.f, 0.f, 0.f, 0.f}, d1 = d0;
        const bf16_t* arow = p.hx + (size_t)(tok0 + fr) * DM + fq * 8;
#pragma unroll 8
        for (int ks = 0; ks < 32; ++ks) {
            const bf16x8 a = *(const bf16x8*)(arow + ks * 32);
            const bf16x8 b0 = *(const bf16x8*)(W + fr * 1032 + ks * 32 + fq * 8), b1 = *(const bf16x8*)(W + (16 + fr) * 1032 + ks * 32 + fq * 8);
            d0 = __builtin_amdgcn_mfma_f32_16x16x32_bf16(b0, a, d0, 0, 0, 0);
            d1 = __builtin_amdgcn_mfma_f32_16x16x32_bf16(b1, a, d1, 0, 0, 0);
        }
        asm volatile("s_nop 15\n\ts_nop 15" : "+v"(d0), "+v"(d1));
        bf16_t* o = p.proj + (size_t)(tok0 + fr) * DINP + P_LRF + fq * 4;
        *(u32x2*)o = (u32x2){cvt_pk_bf16(d0[0], d0[1]), cvt_pk_bf16(d0[2], d0[3])};
        *(u32x2*)(o + 16) = (u32x2){cvt_pk_bf16(d1[0], d1[1]), cvt_pk_bf16(d1[2], d1[3])};
    }
    __syncthreads();
}

__device__ __forceinline__ void phase_mix(const Params& p) {
    const int lane = threadIdx.x & 63, wave = threadIdx.x >> 6;
    const int stride = gridDim.x * NWAVES;
    int r = blockIdx.x * NWAVES + wave;
    if (r >= NL) return;
    const float4 gn0 = *(const float4*)(p.gnorm_g + (lane & 15) * 8), gn1 = *(const float4*)(p.gnorm_g + (lane & 15) * 8 + 4);
    const float4 sd0 = *(const float4*)(p.s5_d + lane * 8), sd1 = *(const float4*)(p.s5_d + lane * 8 + 4);
    const float gn[8] = {gn0.x, gn0.y, gn0.z, gn0.w, gn1.x, gn1.y, gn1.z, gn1.w}, sd[8] = {sd0.x, sd0.y, sd0.z, sd0.w, sd1.x, sd1.y, sd1.z, sd1.w};
    u32x4 c[6], n[6];
#define MIX_LOAD(dst, row) do { const size_t _r = (size_t)(row); \
        dst[0] = *(const u32x4*)(p.of + _r * 512 + lane * 8); dst[1] = *(const u32x4*)(p.of + ((size_t)NL + _r) * 512 + lane * 8); \
        dst[2] = *(const u32x4*)(p.proj + _r * DINP + P_G + lane * 8); \
        dst[3] = *(const u32x4*)(p.yf + _r * 512 + lane * 8); dst[4] = *(const u32x4*)(p.yf + ((size_t)NL + _r) * 512 + lane * 8); \
        dst[5] = *(const u32x4*)(p.Ag + ((size_t)(lane >> 1) * S5_ROWS + (_r >> 4)) * 512 + (_r & 15) * 16 + (lane & 1) * 8); } while (0)
    MIX_LOAD(c, r);
    for (;;) {
        const int rn = r + stride; const bool has = rn < NL;
        if (has) MIX_LOAD(n, rn);
        float o[8], g[8]; float ss = 0.f;
#pragma unroll
        for (int q = 0; q < 4; ++q) {
            o[2 * q] = bflo(c[0][q]) + bflo(c[1][q]); o[2 * q + 1] = bfhi(c[0][q]) + bfhi(c[1][q]);
            g[2 * q] = bflo(c[2][q]); g[2 * q + 1] = bfhi(c[2][q]);
            ss += o[2 * q] * o[2 * q] + o[2 * q + 1] * o[2 * q + 1];
        }
        ss += __shfl_xor(ss, 1); ss += __shfl_xor(ss, 2); ss += __shfl_xor(ss, 4); ss += __shfl_xor(ss, 8);
        const float rstd = rsqrtf(ss * (1.0f / 128.0f) + EPS);
        u32x4 mo, zo;
#pragma unroll
        for (int q = 0; q < 4; ++q) {
            const float m0 = o[2 * q] * rstd * gn[2 * q] * silu_fast(g[2 * q]), m1 = o[2 * q + 1] * rstd * gn[2 * q + 1] * silu_fast(g[2 * q + 1]);
            mo[q] = cvt_pk_bf16(m0, m1);
            const float y0 = bflo(c[3][q]) + bflo(c[4][q]) + sd[2 * q] * bflo(c[5][q]), y1 = bfhi(c[3][q]) + bfhi(c[4][q]) + sd[2 * q + 1] * bfhi(c[5][q]);
            zo[q] = cvt_pk_bf16(gelu_tanh_fast(y0), gelu_tanh_fast(y1));
        }
        *(u32x4*)(p.mix + (size_t)r * DM + lane * 8) = mo;
        *(u32x4*)(p.z + (size_t)r * 512 + lane * 8) = zo;
        if (!has) break;
        r = rn;
#pragma unroll
        for (int q = 0; q < 6; ++q) c[q] = n[q];
    }
#undef MIX_LOAD
}

__device__ __forceinline__ void phase_route(const Params& p, int* lm) {
    int* hist = lm; int* gbase = lm + 256; int* st_e = lm + 512; int* st_r = st_e + 1024; float* st_w = (float*)(st_r + 1024);
    const int tid = threadIdx.x;
    const int lane = threadIdx.x & 63, wave = threadIdx.x >> 6;
    const float* scores = p.scores;
    const float4 rb = *(const float4*)(p.router_b + lane * 4);
    for (int tb = blockIdx.x * 128; tb < NL; tb += gridDim.x * 128) {
    __syncthreads();
    if (tid < 256) hist[tid] = 0;
    __syncthreads();
    for (int tl = wave; tl < 128; tl += NWAVES) {
        const int t = tb + tl;
        const float4 sc4 = *(const float4*)(scores + (size_t)t * 256 + lane * 4);
        const float sc[4] = {sc4.x, sc4.y, sc4.z, sc4.w};
        float bv[4] = {sc4.x + rb.x, sc4.y + rb.y, sc4.z + rb.z, sc4.w + rb.w};
        float m1 = -INFINITY, m2 = -INFINITY;
#pragma unroll
        for (int j = 0; j < 4; ++j) { const float v = bv[j]; if (v > m1) { m2 = m1; m1 = v; } else if (v > m2) m2 = v; }
#pragma unroll
        for (int o = 1; o < 8; o <<= 1) {
            const float o1 = __shfl_xor(m1, o), o2 = __shfl_xor(m2, o);
            const float n1 = fmaxf(m1, o1), n2 = fmaxf(fminf(m1, o1), fmaxf(m2, o2));
            m1 = n1; m2 = n2;
        }
        const float gs = m1 + m2;
        const int myg = lane >> 3;
        int rank = 0;
#pragma unroll
        for (int j = 0; j < 8; ++j) { const float og = __shfl(gs, j * 8); rank += (og > gs || (og == gs && j < myg)) ? 1 : 0; }
        const bool sel = rank < 4;
#pragma unroll
        for (int j = 0; j < 4; ++j) if (!sel) bv[j] = -INFINITY;
        int my_e = -1; float my_s = 0.f; float ssum = 0.f;
#pragma unroll
        for (int k = 0; k < TOPK; ++k) {
            float bvv = bv[0]; int bi = 0;
#pragma unroll
            for (int j = 1; j < 4; ++j) if (bv[j] > bvv) { bvv = bv[j]; bi = j; }
            int be = lane * 4 + bi;
            float bs = (bi == 0) ? sc[0] : (bi == 1) ? sc[1] : (bi == 2) ? sc[2] : sc[3];
#pragma unroll
            for (int o = 1; o < 64; o <<= 1) {
                const float ov = __shfl_xor(bvv, o); const int oe = __shfl_xor(be, o); const float os = __shfl_xor(bs, o);
                if (ov > bvv || (ov == bvv && oe < be)) { bvv = ov; be = oe; bs = os; }
            }
            if ((be >> 2) == lane) {
#pragma unroll
                for (int j = 0; j < 4; ++j) if ((be & 3) == j) bv[j] = -INFINITY;
            }
            ssum += bs;
            if (lane == k) { my_e = be; my_s = bs; }
        }
        if (lane < TOPK) {
            st_e[tl * 8 + lane] = my_e; st_r[tl * 8 + lane] = atomicAdd(&hist[my_e], 1); st_w[tl * 8 + lane] = my_s / ssum * 2.5f;
        }
    }
    __syncthreads();
    if (tid < 256) { const int h = hist[tid]; gbase[tid] = h ? atomicAdd(&p.cnt[tid], h) : 0; }
    __syncthreads();
    for (int i = tid; i < 1024; i += NT) {
        const int e = st_e[i], pos = gbase[e] + st_r[i], t = tb + (i >> 3);
        p.ltok[(size_t)e * CAP + pos] = (unsigned short)t;
        p.tinfo[(size_t)tb * 8 + i] = ((unsigned)e << 16) | (unsigned)pos;
        p.tw[(size_t)tb * 8 + i] = st_w[i];
    }
    }
}

__device__ __forceinline__ void expert_tables(const Params& p, int* cntl, int* offs, int* toff, int ncolt) {
    const int tid = threadIdx.x;
    __syncthreads();
    if (tid < 256) cntl[tid] = p.cnt[tid];
    __syncthreads();
    if (tid < 256) {
        int s = 0, ts = 0;
        for (int e = 0; e < tid; ++e) { const int c = cntl[e]; s += c; ts += ((c + 255) >> 8) * ncolt; }
        offs[tid] = s; toff[tid] = ts;
        if (tid == 255) { const int c = cntl[255]; offs[256] = s + c; toff[256] = ts + ((c + 255) >> 8) * ncolt; }
    }
    __syncthreads();
}

__device__ __forceinline__ void phase_final(const Params& p, int* lmisc) {
    const int lane = threadIdx.x & 63, wave = threadIdx.x >> 6;
    int* cntl = lmisc; int* offs = lmisc + 256; int* toff = offs + 260;
    expert_tables(p, cntl, offs, toff, 1);
    for (int r = blockIdx.x * NWAVES + wave; r < NL; r += gridDim.x * NWAVES) {
        const int b = r / SEQ;
        const bf16_t* x1 = p.yf + (size_t)r * DM;
        const float* g2 = p.modv + b * 6144 + 5120;
        unsigned info = 0u; float wk = 0.f;
        if (lane < 8) { info = p.tinfo[(size_t)r * 8 + lane]; wk = p.tw[(size_t)r * 8 + lane]; }
        float a[16];
#pragma unroll
        for (int i = 0; i < 16; ++i) a[i] = 0.f;
#pragma unroll
        for (int k = 0; k < 8; ++k) {
            const unsigned inf = __shfl(info, k); const float w = __shfl(wk, k) * (1.0f / YB_SCALE);
            const unsigned char* row = (const unsigned char*)p.yb + (size_t)(offs[inf >> 16] + (int)(inf & 0xFFFFu)) * DM;
            const u32x4 v = *(const u32x4*)(row + lane * 16);
#pragma unroll
            for (int q = 0; q < 4; ++q) {
                const f32x2_t lo = __builtin_amdgcn_cvt_pk_f32_fp8((int)v[q], false), hi = __builtin_amdgcn_cvt_pk_f32_fp8((int)v[q], true);
                a[4 * q] = fmaf(w, lo[0], a[4 * q]); a[4 * q + 1] = fmaf(w, lo[1], a[4 * q + 1]); a[4 * q + 2] = fmaf(w, hi[0], a[4 * q + 2]); a[4 * q + 3] = fmaf(w, hi[1], a[4 * q + 3]);
            }
        }
        {
            const u32x4 v = *(const u32x4*)((const unsigned char*)p.hx + (size_t)r * DM + lane * 16);
#pragma unroll
            for (int q = 0; q < 4; ++q) {
                const f32x2_t lo = __builtin_amdgcn_cvt_pk_f32_fp8((int)v[q], false), hi = __builtin_amdgcn_cvt_pk_f32_fp8((int)v[q], true);
                a[4 * q] = fmaf(0.125f, lo[0], a[4 * q]); a[4 * q + 1] = fmaf(0.125f, lo[1], a[4 * q + 1]); a[4 * q + 2] = fmaf(0.125f, hi[0], a[4 * q + 2]); a[4 * q + 3] = fmaf(0.125f, hi[1], a[4 * q + 3]);
            }
        }
        float ss = 0.f;
#pragma unroll
        for (int h = 0; h < 4; ++h) {
            const int col = lane * 16 + 4 * h;
            const u32x2 xw = *(const u32x2*)(x1 + col); const float4 xv = make_float4(bflo(xw[0]), bfhi(xw[0]), bflo(xw[1]), bfhi(xw[1])), gg = *(const float4*)(g2 + col);
            float* aa = a + 4 * h;
            aa[0] = xv.x + gg.x * aa[0]; aa[1] = xv.y + gg.y * aa[1]; aa[2] = xv.z + gg.z * aa[2]; aa[3] = xv.w + gg.w * aa[3];
            ss += aa[0] * aa[0] + aa[1] * aa[1] + aa[2] * aa[2] + aa[3] * aa[3];
        }
        ss = wave_sum(ss);
        const float rstd = rsqrtf(ss * (1.0f / DM) + EPS);
#pragma unroll
        for (int h = 0; h < 4; ++h) {
            const int col = lane * 16 + 4 * h;
            const float4 gg = *(const float4*)(p.fnorm_g + col);
            const float* aa = a + 4 * h;
            float4 o; o.x = aa[0] * rstd * gg.x; o.y = aa[1] * rstd * gg.y; o.z = aa[2] * rstd * gg.z; o.w = aa[3] * rstd * gg.w;
            *(float4*)(p.out + (size_t)r * DM + col) = o;
        }
    }
}

__global__ void __launch_bounds__(NT, 2) mega(Params p) {
    extern __shared__ __attribute__((aligned(16))) unsigned char lds_raw[];
    float* lds = (float*)lds_raw;
    LAS unsigned char* ldsl = (LAS unsigned char*)lds_raw;
    float* lmisc = (float*)(lds_raw + STAGE_BYTES);
    volatile LAS unsigned* xbw = (volatile LAS unsigned*)(ldsl + LDS_BYTES - 16);
    if (threadIdx.x == 0) { xbw[0] = 0u; xbw[1] = 0u; xbw[2] = 0u; xbw[3] = 0u; }
    __syncthreads();
    XcdBarrier bar; bar.bar = p.bar; bar.x = 0; bar.st = xbw;
    const bool fused = (p.ph_hi - p.ph_lo) > 1;
    if (fused) bar = xcd_barrier_post(p.bar, xbw);
    const int bid = blockIdx.x, nb = gridDim.x;
#define PH(i) (p.ph_lo <= (i) && (i) < p.ph_hi)
#define SEAM(i) if (fused && p.ph_lo <= (i) && (i) + 1 < p.ph_hi) xcd_barrier(bar)

    if (PH(0)) phase_prologue(p, lds, 0);
    SEAM(0);
    if (PH(1)) { phase_norm_mod(p, 0); __syncthreads(); phase_prologue(p, lds, 1); }
    SEAM(1);
    if (PH(2)) {
        g8::DenseSched S; S.init(p.hx, p.w_inT, DM * 2, DM * 2, NR, 2048, nb, bid);
        g8::EpiProj E; E.O = p.proj; E.AG = p.Ag;
        g8::gemm_phase<g8::EpiProj, g8::DenseSched, 0>(ldsl, DM, DM * 2, DM * 2, S, E);
        lr_columns(p, (unsigned char*)lds);
    }
    SEAM(2);
    if (PH(3)) phase_scans(p, lds);
    SEAM(3);
    if (PH(4)) phase_mix(p);
    SEAM(4);
    if (PH(5)) {
        g8::DenseSched S; S.init(p.z, p.gluT, 512 * 2, 512 * 2, NL, 512, nb, bid);
        g8::EpiGlu E; E.Z = p.z; E.MIX = p.mix; E.bias = p.glu_b;
        g8::gemm_phase<g8::EpiGlu, g8::DenseSched, 0>(ldsl, 512, 512 * 2, 512 * 2, S, E);
    }
    SEAM(5);
    if (PH(6)) {
        g8::DenseSched S; S.init(p.mix, p.w_outT, DM * 2, DM * 2, NL, DM, nb, bid);
        g8::EpiOut E; E.X = p.x; E.X1 = p.yf; E.modv = p.modv;
        g8::gemm_phase<g8::EpiOut, g8::DenseSched, 0>(ldsl, DM, DM * 2, DM * 2, S, E);
    }
    SEAM(6);
    if (PH(7)) phase_norm_mod(p, 1);
    SEAM(7);
    if (PH(8)) {
        {
            g8::DenseSched S; S.init(p.hx, p.routerT3, DM * 2, 3072 * 2, NL, 256, nb, bid);
            g8::EpiScores E; E.O = p.scores;
            g8::gemm_phase<g8::EpiScores, g8::DenseSched, 0>(ldsl, DM, DM * 2, 3072 * 2, S, E);
        }
        __syncthreads();
        {
            g8::DenseSched S;
            S.init(p.hx, p.shguT, DM * 2, DM * 2, NL, 512, nb, bid);
            g8::EpiGateUp E; E.O = p.shhid;
            g8::gemm_phase<g8::EpiGateUp, g8::DenseSched, 0>(ldsl, DM, DM * 2, DM * 2, S, E);
        }
    }
    SEAM(8);
    if (PH(9)) phase_route(p, (int*)lmisc);
    SEAM(9);
    if (PH(10)) {
        int* cntl = (int*)lmisc; int* offs = cntl + 256; int* toff = offs + 260;
        expert_tables(p, cntl, offs, toff, 2);
        {
            g8::ExpertSched S;
            S.toff = (const LAS int*)toff; S.offs = (const LAS int*)offs; S.cntl = (const LAS int*)cntl;
            S.gbase = (const char*)p.of; S.lda = DM; S.ltok = p.ltok; S.Ad = nullptr;
            S.Bt = (const char*)p.eguT; S.bexp = (size_t)512 * DM; S.ldb = DM;
            S.ncolt = 2; S.G = nb; S.c = (bid & 7) * (nb >> 3) + (bid >> 3); S.total = __builtin_amdgcn_readfirstlane(toff[256]);
            g8::EpiExpGU E; E.O = p.hid; E.offs = S.offs; E.cntl = S.cntl;
            g8::gemm_phase<g8::EpiExpGU, g8::ExpertSched, 0, true, 1>(ldsl, DM / 2, DM, DM, S, E);
        }
    }
    SEAM(10);
    if (PH(11)) {
        int* cntl = (int*)lmisc; int* offs = cntl + 256; int* toff = offs + 260;
        expert_tables(p, cntl, offs, toff, 4);
        g8::ExpertSched S;
        S.toff = (const LAS int*)toff; S.offs = (const LAS int*)offs; S.cntl = (const LAS int*)cntl;
        S.gbase = nullptr; S.lda = 256; S.ltok = p.ltok; S.Ad = (const char*)p.hid;
        S.Bt = (const char*)p.edT; S.bexp = (size_t)DM * 256; S.ldb = 256;
        S.ncolt = 4; S.G = nb; S.c = (bid & 7) * (nb >> 3) + (bid >> 3); S.total = __builtin_amdgcn_readfirstlane(toff[256]);
        g8::EpiExpDown E; E.O = p.yb; E.offs = S.offs; E.cntl = S.cntl;
        g8::gemm_phase<g8::EpiExpDown, g8::ExpertSched, 0, false, 2>(ldsl, 128, 256, 256, S, E);
        __syncthreads();
        {
            g8::DenseSched S2; S2.init(p.shhid, p.shdT, 256, 256, NL, DM, nb, bid);
            g8::EpiBf16 E2; E2.O = p.hx;
            g8::gemm_phase<g8::EpiBf16, g8::DenseSched, 0, false, 1>(ldsl, 128, 256, 256, S2, E2);
        }
    }
    SEAM(11);
    if (PH(12)) phase_final(p, (int*)lmisc);
}

extern "C" void kernel_launch(void* const* d_in, const int* in_sizes, int n_in, void* d_out, int out_size, void* d_ws, size_t ws_size,
                              hipStream_t stream) {
    static int grid = 0;
    if (grid == 0) {
        int dev = 0, cus = 0, per_cu = 0;
        (void)hipGetDevice(&dev);
        (void)hipDeviceGetAttribute(&cus, hipDeviceAttributeMultiprocessorCount, dev);
        (void)hipFuncSetAttribute((const void*)mega, hipFuncAttributeMaxDynamicSharedMemorySize, LDS_BYTES);
        (void)hipOccupancyMaxActiveBlocksPerMultiprocessor(&per_cu, (const void*)mega, NT, LDS_BYTES);
        (void)hipGetLastError();
        grid = cus;
    }
    size_t off = 0;
    auto carve = [&](size_t bytes) { size_t o = off; off += (bytes + 255) & ~(size_t)255; return (char*)d_ws + o; };
    Params p{};
    const float** ins = (const float**)&p;
    for (int i = 0; i < 39; ++i) ins[i] = (const float*)d_in[i];
    p.out = (float*)d_out;
    p.bar = (unsigned*)carve(XCD_BAR_WORDS * 4);
    p.cnt = (int*)carve(256 * 4);
    const size_t zero_bytes = off;
    p.modv = (float*)carve((size_t)17 * 6144 * 4);
    p.w_inT = (bf16_t*)carve((size_t)2304 * DM * 2);
    p.w_outT = (bf16_t*)carve((size_t)DM * DM * 2);
    p.gluT = (bf16_t*)carve((size_t)512 * 512 * 2);
    p.routerT3 = (bf16_t*)carve((size_t)256 * 3072 * 2);
    p.shguT = (bf16_t*)carve((size_t)512 * DM * 2);
    p.shdT = (bf16_t*)carve((size_t)DM * 256 * 2);
    p.hx = (bf16_t*)carve((size_t)NL * 2048 * 2);
    p.scores = (float*)carve((size_t)NL * 256 * 4);
    p.shhid = (bf16_t*)carve((size_t)NL * 256 * 2);
    p.ltok = (unsigned short*)carve((size_t)NE * CAP * 2);
    p.tinfo = (unsigned*)carve((size_t)NL * 8 * 4);
    p.tw = (float*)carve((size_t)NL * 8 * 4);
    p.edT = (bf16_t*)carve((size_t)NE * DM * 256 * 2);
    p.eguT = (bf16_t*)carve((size_t)NE * 512 * DM * 2);
    char* arena = carve(0);
    p.yb = (bf16_t*)p.eguT;
    {
        size_t a = 0;
        auto acarve = [&](size_t bytes) { size_t o = a; a += (bytes + 255) & ~(size_t)255; return arena + o; };
        p.proj = (bf16_t*)acarve((size_t)NR * DINP * 2);
        p.of = (bf16_t*)acarve((size_t)2 * NL * 512 * 2);
        p.yf = (bf16_t*)acarve((size_t)2 * NL * 512 * 2);
        p.Ag = (bf16_t*)acarve((size_t)32 * S5_ROWS * 512 * 2);
        p.mix = (bf16_t*)acarve((size_t)NL * DM * 2);
        p.z = (bf16_t*)acarve((size_t)NL * 512 * 2);
        const size_t early = a;
        const size_t yb_tail = (size_t)(NL * 8 + 1) * DM * 2 - (size_t)NE * 512 * DM * 2;
        p.hid = (bf16_t*)(arena + ((yb_tail + 255) & ~(size_t)255));
        const size_t late = ((yb_tail + 255) & ~(size_t)255) + (size_t)(NL * 8 + 256) * 256 * 2;
        (void)carve(early > late ? early : late);
    }
    if (off > ws_size) { fprintf(stderr, "kernel_launch: workspace too small: need %zu have %zu\n", off, ws_size); return; }
    (void)hipMemsetAsync(d_ws, 0, zero_bytes, stream);
#if FUSED
    p.ph_lo = 0; p.ph_hi = N_PHASES;
    hipLaunchKernelGGL(mega, dim3(grid), dim3(NT), LDS_BYTES, stream, p);
#else
    for (int i = 0; i < N_PHASES; ++i) {
        p.ph_lo = i; p.ph_hi = i + 1;
        hipLaunchKernelGGL(mega, dim3(grid), dim3(NT), LDS_BYTES, stream, p);
    }
#endif
}
```

```cpp
#include <hip/hip_runtime.h>
#include <stdint.h>
#include <stdio.h>

#define DM 1024
#define NB 16
#define SEQ 2048
#define CTX 256
#define NL (NB * SEQ)
#define NCX (NB * CTX)
#define NR (NL + NCX)
#define DIN 2080
#define S_LR 1536
#define S_U 1568
#define P_Q 0
#define P_K 256
#define P_V 512
#define P_G 1024
#define WC_U 1536
#define WC_LR 2048
#define P_LRF 1536
#define P_LRB 1552
#define DINP 1568
#define S5_ROWS 2304
#define NE 256
#define TOPK 8
#define CAP 32768
#define EPS 1e-6f

#define NT 512
#define NWAVES 8
#define STAGE_BYTES 131072
#define LDS_BYTES (STAGE_BYTES + 16384)
#define N_PHASES 13
#define S5_WLDS 14592
#ifndef FUSED
#define FUSED 1
#endif

typedef unsigned short bf16_t;
typedef short bf16x8 __attribute__((ext_vector_type(8)));
typedef float f32x4 __attribute__((ext_vector_type(4)));
typedef unsigned u32x4 __attribute__((ext_vector_type(4)));
typedef unsigned u32x2 __attribute__((ext_vector_type(2)));
#define LAS __attribute__((address_space(3)))

#define XB_TMO      128
#define XB_XCNT(j)  (256  + 64 * (j))
#define XB_XSUB(j)  (1280 + 64 * (j))
#define XB_XGEN(j)  (2304 + 64 * (j))
#define XB_TOP      3328
#define XB_TOPGEN   3392
#define XCD_BAR_WORDS 3456
#define XB_SPIN_CAP (1u << 18)

__device__ __forceinline__ unsigned xb_ld(unsigned* p)              { return __hip_atomic_load(p, __ATOMIC_RELAXED, __HIP_MEMORY_SCOPE_AGENT); }
__device__ __forceinline__ unsigned xb_add(unsigned* p, unsigned v) { return __hip_atomic_fetch_add(p, v, __ATOMIC_RELAXED, __HIP_MEMORY_SCOPE_AGENT); }
__device__ __forceinline__ unsigned xb_xcc_id() { return (unsigned)__builtin_amdgcn_s_getreg((3 << 11) | 20) & 0xFu; }
#define XB_SPIN(cond, bar) do { unsigned _sp = 0; while (cond) { __builtin_amdgcn_s_sleep(1); \
    if ((++_sp & 255u) == 0u) { if (xb_ld(&(bar)[XB_TMO])) break; if (_sp > XB_SPIN_CAP) { atomicAdd(&(bar)[XB_TMO], 1u); break; } } } } while (0)

struct XcdBarrier { unsigned* bar; unsigned x; volatile LAS unsigned* st; };

__device__ __forceinline__ XcdBarrier xcd_barrier_post(unsigned* bar, volatile LAS unsigned* st) {
    XcdBarrier b; b.bar = bar; b.x = xb_xcc_id(); b.st = st;
    if (threadIdx.x == 0) (void)xb_add(&bar[XB_XCNT(b.x)], 1u);
    return b;
}
__device__ __forceinline__ void xcd_barrier_complete(unsigned* bar, unsigned x, unsigned& nloc, unsigned& nx) {
    const unsigned G = gridDim.x * gridDim.y * gridDim.z;
    unsigned sum, cnt, mine, sp = 0u;
    for (;;) {
        sum = 0u; cnt = 0u; mine = 0u;
#pragma unroll
        for (unsigned j = 0; j < 16; ++j) { const unsigned c = xb_ld(&bar[XB_XCNT(j)]); sum += c; cnt += (c > 0u) ? 1u : 0u; mine = (j == x) ? c : mine; }
        if (sum == G) break;
        __builtin_amdgcn_s_sleep(1);
        if ((++sp & 255u) == 0u) { if (xb_ld(&bar[XB_TMO])) break; if (sp > XB_SPIN_CAP) { atomicAdd(&bar[XB_TMO], 1u); break; } }
    }
    nloc = mine > 0u ? mine : 1u; nx = cnt > 0u ? cnt : 1u;
}
__device__ __forceinline__ void xcd_barrier(const XcdBarrier& b) {
    asm volatile("s_waitcnt vmcnt(0)" ::: "memory");
    __syncthreads();
    if (threadIdx.x == 0) {
        unsigned* bar = b.bar;
        __builtin_amdgcn_s_waitcnt(0);
        unsigned nloc = b.st[0], nx = b.st[1];
        if (nloc == 0u) { xcd_barrier_complete(bar, b.x, nloc, nx); b.st[0] = nloc; b.st[1] = nx; }
        const unsigned old = xb_add(&bar[XB_XSUB(b.x)], 1u);
        const unsigned gen = old / nloc;
        if (old + 1u == (gen + 1u) * nloc) {
            __builtin_amdgcn_fence(__ATOMIC_RELEASE, "agent");
            asm volatile("s_waitcnt vmcnt(0)" ::: "memory");
            const unsigned og = xb_add(&bar[XB_TOP], 1u);
            const unsigned tg = og / nx;
            if (og + 1u == (tg + 1u) * nx) xb_add(&bar[XB_TOPGEN], 1u);
            else XB_SPIN(xb_ld(&bar[XB_TOPGEN]) == tg, bar);
            __builtin_amdgcn_fence(__ATOMIC_ACQUIRE, "agent");
            xb_add(&bar[XB_XGEN(b.x)], 1u);
            asm volatile("s_waitcnt vmcnt(0)" ::: "memory");
        } else {
            XB_SPIN(xb_ld(&bar[XB_XGEN(b.x)]) == gen, bar);
            __builtin_amdgcn_fence(__ATOMIC_ACQUIRE, "agent");
            asm volatile("s_waitcnt vmcnt(0)" ::: "memory");
        }
    }
    __syncthreads();
}

struct Params {
    const float *x, *c, *ctx, *c_ctx, *ada_w, *ada_b, *norm1_g, *norm2_g, *w_in,
        *wa_f, *ba_f, *wa_b, *ba_b, *gnorm_g,
        *lam_re_f, *lam_im_f, *lstep_f, *lam_re_b, *lam_im_b, *lstep_b,
        *b_re, *b_im, *c_re_f, *c_im_f, *c_re_b, *c_im_b, *s5_d, *glu_w, *glu_b,
        *w_out, *router_w, *router_b, *ew_gate, *ew_up, *ew_down, *sw_gate, *sw_up, *sw_down, *fnorm_g;
    float* out;
    unsigned* bar;
    int* cnt;
    float* modv;
    bf16_t* w_inT;
    bf16_t* w_outT;
    bf16_t* gluT;
    bf16_t* routerT3;
    bf16_t* shguT;
    bf16_t* shdT;
    bf16_t* hx;
    bf16_t* proj;
    bf16_t* of;
    bf16_t* yf;
    bf16_t* Ag;
    bf16_t* mix;
    bf16_t* z;
    float* scores;
    bf16_t* shhid;
    bf16_t* eguT;
    bf16_t* edT;
    bf16_t* hid;
    bf16_t* yb;
    unsigned short* ltok;
    unsigned* tinfo;
    float* tw;
    int ph_lo, ph_hi;
};

__device__ __forceinline__ float sigmoidf_(float v) { return 1.0f / (1.0f + expf(-v)); }
__device__ __forceinline__ float siluf_(float v) { return v / (1.0f + expf(-v)); }
__device__ __forceinline__ float logsigmoidf_(float v) { return fminf(v, 0.0f) - log1pf(expf(-fabsf(v))); }
__device__ __forceinline__ float gelu_tanhf_(float v) { return 0.5f * v * (1.0f + tanhf(0.7978845608028654f * (v + 0.044715f * v * v * v))); }
__device__ __forceinline__ float sigmoid_fast(float v) { return __builtin_amdgcn_rcpf(1.0f + __builtin_amdgcn_exp2f(-v * 1.4426950408889634f)); }
__device__ __forceinline__ float silu_fast(float v) { return v * sigmoid_fast(v); }
__device__ __forceinline__ float gelu_tanh_fast(float v) { return v * sigmoid_fast(1.5957691216057308f * (v + 0.044715f * v * v * v)); }
__device__ __forceinline__ float wave_sum(float v) {
#pragma unroll
    for (int o = 32; o > 0; o >>= 1) v += __shfl_xor(v, o);
    return v;
}
__device__ __forceinline__ float bf2f(bf16_t b) { return __uint_as_float(((unsigned)b) << 16); }
__device__ __forceinline__ float bflo(unsigned w) { return __uint_as_float(w << 16); }
__device__ __forceinline__ float bfhi(unsigned w) { return __uint_as_float(w & 0xFFFF0000u); }
__device__ __forceinline__ bf16_t f2bf(float f) { unsigned u = __float_as_uint(f); u += 0x7FFFu + ((u >> 16) & 1u); return (bf16_t)(u >> 16); }
typedef __bf16 bf16x2_t __attribute__((ext_vector_type(2)));
typedef float f32x2_t __attribute__((ext_vector_type(2)));
__device__ __forceinline__ unsigned cvt_pk_bf16(float lo, float hi) { const f32x2_t f = {lo, hi}; return __builtin_bit_cast(unsigned, __builtin_convertvector(f, bf16x2_t)); }

namespace g8 {
constexpr int BM = 256, BK = 64, HALF = 128, HTB = HALF * BK * 2, NXCD = 8, WGM = 8;
__device__ __forceinline__ int lds_byte(int r, int c) { const int st = (r >> 4) * 2 + (c >> 5), rr = r & 15, cc = c & 31, ob = rr * 64 + cc * 2; return st * 1024 + (ob ^ (((ob >> 9) & 1) << 5)); }
__device__ __forceinline__ void stage_rc(int b, int& R, int& C) { const int st = b / 1024, sb = b % 1024, swz = sb ^ (((sb >> 9) & 1) << 5); R = (st >> 1) * 16 + swz / 64; C = (st & 1) * 32 + (swz % 64) / 2; }
__device__ __forceinline__ int perm32(int rho) { const int n = rho >> 4, i = rho & 15; return 8 * (i >> 2) + 4 * n + (i & 3); }

struct Unit { const char* a; const char* b; int pm, pn, e, rows; };

struct DenseSched {
    const char* A; const char* Bt; unsigned lda, ldb; int nM, nN, nwg, G, c;
    __device__ __forceinline__ void init(const void* A_, const void* Bt_, unsigned lda_, unsigned ldb_, int M, int N, int G_, int c_) {
        A = (const char*)A_; Bt = (const char*)Bt_; lda = lda_; ldb = ldb_; nM = M / BM; nN = N / BM; nwg = nM * nN; G = G_; c = c_; }
    __device__ __forceinline__ bool next(int i, Unit& u) const {
        if (c < 0) return false;
        const long L = (long)i * G + c; if (L >= nwg) return false;
        int wgid = (int)L; { const int q = nwg / NXCD, r = nwg % NXCD, xcd = wgid % NXCD, off = wgid / NXCD; wgid = (xcd < r ? xcd * (q + 1) : r * (q + 1) + (xcd - r) * q) + off; }
        const int nig = WGM * nN, gid = wgid / nig, fm = gid * WGM, gsz = (nM - fm) < WGM ? (nM - fm) : WGM;
        u.pm = fm + ((wgid % nig) % gsz); u.pn = (wgid % nig) / gsz; u.e = 0; u.rows = BM;
        u.a = A + (size_t)u.pm * BM * lda; u.b = Bt + (size_t)u.pn * BM * ldb;
        return true;
    }
};

typedef int v8i_t __attribute__((ext_vector_type(8)));
typedef long v2l_t __attribute__((ext_vector_type(2)));
template <class Epi, class Sched, int KWRAP, bool GATHER = false, int FP8 = 0>
__device__ __forceinline__ void gemm_phase(LAS unsigned char* lds, const int K, const unsigned lda, const unsigned ldb, const Sched& S, const Epi& E) {
    const int tid = threadIdx.x, wid = __builtin_amdgcn_readfirstlane(tid >> 6), lane = tid & 63, wr = wid >> 2, wc = wid & 3, fr = lane & 15, fq = lane >> 4;
    const int nt = K / BK;
    unsigned voffA[2], voffB[2]; int rA[2]; unsigned cA2[2];
#pragma unroll
    for (int i = 0; i < 2; ++i) { int R, C; stage_rc(tid * 16 + i * 8192, R, C); const int Rb = Epi::PERM ? ((R & ~31) + perm32(R & 31)) : R;
        voffA[i] = (unsigned)R * lda + (unsigned)C * 2u; voffB[i] = (unsigned)Rb * ldb + (unsigned)C * 2u; rA[i] = R; cA2[i] = (unsigned)C * 2u; }
    unsigned gc[2][2], gn[2][2];
    const size_t kstep = (size_t)(BK * 2);
    const size_t hstepA = (size_t)HALF * lda, hstepB = (size_t)HALF * ldb;
    const unsigned ldsw = (unsigned)wid * 1024u;
    const int aoff = lds_byte(wr * 64 + fr, fq * 8), boff = lds_byte(wc * 32 + fr, fq * 8);
#define G8_SA(b, h) (((b) * 2 + (h)) * HTB)
#define G8_SB(b, h) ((4 + (b) * 2 + (h)) * HTB)
#define G8_STAGE(bufoff, gbase, voff) do { _Pragma("unroll") for (int _i = 0; _i < 2; ++_i) \
        __builtin_amdgcn_global_load_lds((const unsigned*)((const char*)(gbase) + (voff)[_i]), (LAS unsigned*)(lds + (bufoff) + ldsw + _i * 8192), 16, 0, 0); } while (0)
#define G8_KO(kt) ((size_t)(KWRAP ? ((kt) & (KWRAP - 1)) : (kt)) * kstep)
#define G8_LDA(dst, b, h) do { _Pragma("unroll") for (int m = 0; m < 4; ++m) _Pragma("unroll") for (int k = 0; k < 2; ++k) dst[m][k] = *(const LAS bf16x8*)(lds + G8_SA(b, h) + aoff + m * 2048 + k * 1024); } while (0)
#define G8_LDB(dst, b, h) do { _Pragma("unroll") for (int n = 0; n < 2; ++n) _Pragma("unroll") for (int k = 0; k < 2; ++k) dst[n][k] = *(const LAS bf16x8*)(lds + G8_SB(b, h) + boff + n * 2048 + k * 1024); } while (0)
#define G8_PK8(x) __builtin_bit_cast(v8i_t, x)
#define G8_MMA(ai, bj, At, Bt) do { __builtin_amdgcn_s_setprio(1); _Pragma("unroll") for (int m = 0; m < 4; ++m) _Pragma("unroll") for (int n = 0; n < 2; ++n) { \
        if constexpr (FP8 == 2 || (FP8 == 4 && (ai) == 1)) { typedef int v4i_ __attribute__((ext_vector_type(4))); \
            const v8i_t b8_ = __builtin_shufflevector(__builtin_bit_cast(v4i_, Bt[n][0]), __builtin_bit_cast(v4i_, Bt[n][1]), 0, 1, 2, 3, 4, 5, 6, 7); \
            const v8i_t a8_ = __builtin_shufflevector(__builtin_bit_cast(v4i_, At[m][0]), __builtin_bit_cast(v4i_, At[m][1]), 0, 1, 2, 3, 4, 5, 6, 7); \
            acc[ai][bj][m][n] = __builtin_amdgcn_mfma_scale_f32_16x16x128_f8f6f4(b8_, a8_, acc[ai][bj][m][n], 0, 0, 0, 0x7F7F7F7F, 0, 0x7F7F7F7F); } \
        else if constexpr (FP8 == 1 || FP8 == 4) { _Pragma("unroll") for (int k = 0; k < 2; ++k) { const v2l_t b2_ = __builtin_bit_cast(v2l_t, Bt[n][k]), a2_ = __builtin_bit_cast(v2l_t, At[m][k]); \
            acc[ai][bj][m][n] = __builtin_amdgcn_mfma_f32_16x16x32_fp8_fp8(b2_[0], a2_[0], acc[ai][bj][m][n], 0, 0, 0); \
            acc[ai][bj][m][n] = __builtin_amdgcn_mfma_f32_16x16x32_fp8_fp8(b2_[1], a2_[1], acc[ai][bj][m][n], 0, 0, 0); } } \
        else { _Pragma("unroll") for (int k = 0; k < 2; ++k) acc[ai][bj][m][n] = __builtin_amdgcn_mfma_f32_16x16x32_bf16(Bt[n][k], At[m][k], acc[ai][bj][m][n], 0, 0, 0); } } \
        __builtin_amdgcn_s_setprio(0); } while (0)
#define G8_WAIT_V(n) asm volatile("s_waitcnt vmcnt(" #n ")" ::: "memory")
#define G8_WAIT_L(n) asm volatile("s_waitcnt lgkmcnt(" #n ")" ::: "memory")
#define G8_BAR __builtin_amdgcn_s_barrier()
#define G8_SCHED __builtin_amdgcn_sched_barrier(0)
    Unit cur, nxt; int ui = 0;
    if (!S.next(0, cur)) return;
    f32x4 acc[2][2][4][2];
#pragma unroll
    for (int a = 0; a < 2; ++a)
#pragma unroll
        for (int b = 0; b < 2; ++b)
#pragma unroll
            for (int m = 0; m < 4; ++m)
#pragma unroll
                for (int n = 0; n < 2; ++n) acc[a][b][m][n] = (f32x4){0.f, 0.f, 0.f, 0.f};
    bf16x8 At[4][2], B0[2][2], B1[2][2];
    const char* cA = cur.a; const char* cB = cur.b; const char* nA = cA;
#define G8_STA(bufoff, nx, h, kt) do { const size_t _ko = G8_KO(kt); _Pragma("unroll") for (int _i = 0; _i < 2; ++_i) { const char* _s; \
        if constexpr (GATHER) _s = S.gbase + (size_t)((nx) ? gn[h][_i] : gc[h][_i]) + _ko; else _s = ((nx) ? nA : cA) + ((h) ? hstepA : (size_t)0) + voffA[_i] + _ko; \
        __builtin_amdgcn_global_load_lds((const unsigned*)_s, (LAS unsigned*)(lds + (bufoff) + ldsw + _i * 8192), 16, 0, 0); } } while (0)
    if constexpr (GATHER) {
#pragma unroll
        for (int h = 0; h < 2; ++h)
#pragma unroll
            for (int i = 0; i < 2; ++i) { gc[h][i] = S.row_off(cur, h * HALF + rA[i]) + cA2[i]; gn[h][i] = gc[h][i]; }
    }
    G8_STAGE(G8_SB(0, 0), cB, voffB); G8_STA(G8_SA(0, 0), false, 0, 0); G8_STAGE(G8_SB(0, 1), cB + hstepB, voffB); G8_STA(G8_SA(0, 1), false, 1, 0);
    if (wr == 1) G8_BAR;
    G8_WAIT_V(4); G8_BAR;
    G8_STAGE(G8_SB(1, 0), cB + kstep, voffB); G8_STA(G8_SA(1, 0), false, 0, 1); G8_STAGE(G8_SB(1, 1), cB + hstepB + kstep, voffB);
    G8_WAIT_V(6); G8_BAR;
    for (;;) {
        const bool has_next = S.next(ui + 1, nxt);
        nA = has_next ? nxt.a : cA; const char* nB = has_next ? nxt.b : cB;
        if constexpr (GATHER) {
#pragma unroll
            for (int h = 0; h < 2; ++h)
#pragma unroll
                for (int i = 0; i < 2; ++i) gn[h][i] = has_next ? (S.row_off(nxt, h * HALF + rA[i]) + cA2[i]) : gc[h][i];
        }
        for (int t = 0; t < nt; t += 2) {
            const bool last = (t == nt - 2);
            const char* b2 = last ? nB : cB + (size_t)(t + 2) * kstep;
            const char* b3 = b2 + kstep;
            G8_LDB(B0, 0, 0); G8_SCHED; G8_LDA(At, 0, 0); G8_STA(G8_SA(1, 1), false, 1, t + 1);
            G8_WAIT_L(8); G8_BAR; G8_WAIT_L(0); G8_MMA(0, 0, At, B0); G8_BAR; G8_SCHED;
            G8_LDB(B1, 0, 1); G8_STAGE(G8_SB(0, 0), b2, voffB);
            G8_BAR; G8_WAIT_L(0); G8_MMA(0, 1, At, B1); G8_BAR;
            G8_LDA(At, 0, 1); G8_STA(G8_SA(0, 0), last, 0, last ? 0 : t + 2);
            G8_BAR; G8_WAIT_L(0); if (cur.rows > HALF) G8_MMA(1, 0, At, B0); G8_BAR; G8_SCHED;
            G8_STAGE(G8_SB(0, 1), b2 + hstepB, voffB);
            G8_WAIT_V(6); G8_BAR; if (cur.rows > HALF) G8_MMA(1, 1, At, B1); G8_BAR;
            G8_LDB(B0, 1, 0); G8_SCHED; G8_LDA(At, 1, 0); G8_STA(G8_SA(0, 1), last, 1, last ? 0 : t + 2);
            G8_WAIT_L(8); G8_BAR; G8_WAIT_L(0); G8_MMA(0, 0, At, B0); G8_BAR; G8_SCHED;
            G8_LDB(B1, 1, 1); G8_STAGE(G8_SB(1, 0), b3, voffB);
            G8_BAR; G8_WAIT_L(0); G8_MMA(0, 1, At, B1); G8_BAR;
            G8_LDA(At, 1, 1); G8_STA(G8_SA(1, 0), last, 0, last ? 1 : t + 3);
            G8_BAR; G8_WAIT_L(0); if (cur.rows > HALF) G8_MMA(1, 0, At, B0); G8_BAR; G8_SCHED;
            G8_STAGE(G8_SB(1, 1), b3 + hstepB, voffB);
            G8_WAIT_V(6); G8_BAR; if (cur.rows > HALF) G8_MMA(1, 1, At, B1); G8_BAR;
        }
        {
            asm volatile("s_nop 15\n\ts_nop 15" : "+v"(acc[1][1][0][0]), "+v"(acc[1][1][0][1]), "+v"(acc[1][1][1][0]), "+v"(acc[1][1][1][1]), "+v"(acc[1][1][2][0]), "+v"(acc[1][1][2][1]), "+v"(acc[1][1][3][0]), "+v"(acc[1][1][3][1]));
            int tz = threadIdx.x; asm volatile("" : "+v"(tz));
            const int wid2 = __builtin_amdgcn_readfirstlane(tz >> 6), lane2 = tz & 63;
            E(acc, cur, wid2 >> 2, wid2 & 3, lane2 & 15, lane2 >> 4);
        }
        if (!has_next) break;
#pragma unroll
        for (int a = 0; a < 2; ++a)
#pragma unroll
            for (int b = 0; b < 2; ++b)
#pragma unroll
                for (int m = 0; m < 4; ++m)
#pragma unroll
                    for (int n = 0; n < 2; ++n) acc[a][b][m][n] = (f32x4){0.f, 0.f, 0.f, 0.f};
        cur = nxt; cA = nA; cB = nB; ++ui;
        if constexpr (GATHER) {
#pragma unroll
            for (int h = 0; h < 2; ++h)
#pragma unroll
                for (int i = 0; i < 2; ++i) gc[h][i] = gn[h][i];
        }
    }
    G8_WAIT_V(0);
    if (wr == 0) G8_BAR;
    G8_BAR;
#undef G8_SA
#undef G8_SB
#undef G8_STAGE
#undef G8_STA
#undef G8_KO
#undef G8_LDA
#undef G8_LDB
#undef G8_MMA
#undef G8_PK8
#undef G8_WAIT_V
#undef G8_WAIT_L
#undef G8_BAR
#undef G8_SCHED
}

struct EpiProj {
    static constexpr bool PERM = true;
    bf16_t* O; bf16_t* AG;
    __device__ __forceinline__ void operator()(const f32x4 (&acc)[2][2][4][2], const Unit& u, int wr, int wc, int fr, int fq) const {
        const int row0 = u.pm * BM + wr * 64 + fr, col0 = u.pn * BM + wc * 32 + 8 * fq;
#pragma unroll
        for (int ai = 0; ai < 2; ++ai)
#pragma unroll
            for (int m = 0; m < 4; ++m) {
                const int r = row0 + ai * HALF + m * 16;
#pragma unroll
                for (int bj = 0; bj < 2; ++bj) { const f32x4 v0 = acc[ai][bj][m][0], v1 = acc[ai][bj][m][1];
                    const int c = col0 + bj * HALF;
                    const u32x4 pk = (u32x4){cvt_pk_bf16(v0[0], v0[1]), cvt_pk_bf16(v0[2], v0[3]), cvt_pk_bf16(v1[0], v1[1]), cvt_pk_bf16(v1[2], v1[3])};
                    if (u.pn < 6) *(u32x4*)(O + (size_t)r * DINP + c) = pk;
                    else if (u.pn < 8) { const int cu = c - WC_U; *(u32x4*)(AG + ((size_t)(cu >> 4) * S5_ROWS + (r >> 4)) * 512 + (r & 15) * 16 + (cu & 15)) = pk; }
                    else if (c < WC_LR + 32) *(u32x4*)(O + (size_t)r * DINP + P_LRF + (c - WC_LR)) = pk; } }
    }
};
struct EpiBf16 {
    static constexpr bool PERM = true;
    bf16_t* O;
    __device__ __forceinline__ void operator()(const f32x4 (&acc)[2][2][4][2], const Unit& u, int wr, int wc, int fr, int fq) const {
        const int row0 = u.pm * BM + wr * 64 + fr, col0 = u.pn * BM + wc * 32 + 8 * fq;
#pragma unroll
        for (int ai = 0; ai < 2; ++ai)
#pragma unroll
            for (int m = 0; m < 4; ++m) {
                const int r = row0 + ai * HALF + m * 16;
#pragma unroll
                for (int bj = 0; bj < 2; ++bj) { const f32x4 v0 = acc[ai][bj][m][0] * (8.0f / 128.0f), v1 = acc[ai][bj][m][1] * (8.0f / 128.0f);
                    int d0 = __builtin_amdgcn_cvt_pk_fp8_f32(v0[0], v0[1], 0, false); d0 = __builtin_amdgcn_cvt_pk_fp8_f32(v0[2], v0[3], d0, true);
                    int d1 = __builtin_amdgcn_cvt_pk_fp8_f32(v1[0], v1[1], 0, false); d1 = __builtin_amdgcn_cvt_pk_fp8_f32(v1[2], v1[3], d1, true);
                    *(u32x2*)((char*)O + (size_t)r * DM + col0 + bj * HALF) = (u32x2){(unsigned)d0, (unsigned)d1}; }
            }
    }
};
struct EpiGlu {
    static constexpr bool PERM = true;
    const bf16_t* Z; bf16_t* MIX; const float* bias;
    __device__ __forceinline__ void operator()(const f32x4 (&acc)[2][2][4][2], const Unit& u, int wr, int wc, int fr, int fq) const {
        const int row0 = u.pm * BM + wr * 64 + fr, col0 = u.pn * BM + wc * 32 + 8 * fq;
#pragma unroll
        for (int bj = 0; bj < 2; ++bj) {
            const int c = col0 + bj * HALF;
            const f32x4 b0 = *(const f32x4*)(bias + c), b1 = *(const f32x4*)(bias + c + 4);
            u32x4 zq[8];
#pragma unroll
            for (int ai = 0; ai < 2; ++ai)
#pragma unroll
                for (int m = 0; m < 4; ++m) zq[ai * 4 + m] = *(const u32x4*)(Z + (size_t)(row0 + ai * HALF + m * 16) * 512 + c);
#pragma unroll
            for (int ai = 0; ai < 2; ++ai)
#pragma unroll
                for (int m = 0; m < 4; ++m) {
                    const size_t r = (size_t)(row0 + ai * HALF + m * 16);
                    const u32x4 zz = zq[ai * 4 + m];
                    const f32x4 v0 = acc[ai][bj][m][0] + b0, v1 = acc[ai][bj][m][1] + b1;
                    const float o0 = bflo(zz[0]) * sigmoid_fast(v0[0]), o1 = bfhi(zz[0]) * sigmoid_fast(v0[1]), o2 = bflo(zz[1]) * sigmoid_fast(v0[2]), o3 = bfhi(zz[1]) * sigmoid_fast(v0[3]);
                    const float o4 = bflo(zz[2]) * sigmoid_fast(v1[0]), o5 = bfhi(zz[2]) * sigmoid_fast(v1[1]), o6 = bflo(zz[3]) * sigmoid_fast(v1[2]), o7 = bfhi(zz[3]) * sigmoid_fast(v1[3]);
                    *(u32x4*)(MIX + r * DM + 512 + c) = (u32x4){cvt_pk_bf16(o0, o1), cvt_pk_bf16(o2, o3), cvt_pk_bf16(o4, o5), cvt_pk_bf16(o6, o7)};
                }
        }
    }
};
struct EpiOut {
    static constexpr bool PERM = true;
    const float* X; bf16_t* X1; const float* modv;
    __device__ __forceinline__ void operator()(const f32x4 (&acc)[2][2][4][2], const Unit& u, int wr, int wc, int fr, int fq) const {
        const int row0 = u.pm * BM + wr * 64 + fr, col0 = u.pn * BM + wc * 32 + 8 * fq;
        const float* g1 = modv + ((u.pm * BM) / SEQ) * 6144 + 2048;
#pragma unroll
        for (int bj = 0; bj < 2; ++bj) {
            const int c = col0 + bj * HALF;
            const f32x4 ga = *(const f32x4*)(g1 + c), gb = *(const f32x4*)(g1 + c + 4);
#pragma unroll
            for (int ai = 0; ai < 2; ++ai) {
                f32x4 xa[4], xb[4];
#pragma unroll
                for (int m = 0; m < 4; ++m) { const float* xs = X + (size_t)(row0 + ai * HALF + m * 16) * DM + c; xa[m] = *(const f32x4*)xs; xb[m] = *(const f32x4*)(xs + 4); }
#pragma unroll
                for (int m = 0; m < 4; ++m) { const f32x4 y0 = xa[m] + ga * acc[ai][bj][m][0], y1 = xb[m] + gb * acc[ai][bj][m][1];
                    *(u32x4*)(X1 + (size_t)(row0 + ai * HALF + m * 16) * DM + c) = (u32x4){cvt_pk_bf16(y0[0], y0[1]), cvt_pk_bf16(y0[2], y0[3]), cvt_pk_bf16(y1[0], y1[1]), cvt_pk_bf16(y1[2], y1[3])}; }
            }
        }
    }
};
struct EpiScores {
    static constexpr bool PERM = false;
    float* O;
    __device__ __forceinline__ void operator()(const f32x4 (&acc)[2][2][4][2], const Unit& u, int wr, int wc, int fr, int fq) const {
        const int row0 = u.pm * BM + wr * 64 + fr, col0 = u.pn * BM + wc * 32 + 4 * fq;
#pragma unroll
        for (int ai = 0; ai < 2; ++ai)
#pragma unroll
            for (int m = 0; m < 4; ++m) { float* rowp = O + (size_t)(row0 + ai * HALF + m * 16) * 256 + col0;
#pragma unroll
                for (int bj = 0; bj < 2; ++bj)
#pragma unroll
                    for (int n = 0; n < 2; ++n) { const f32x4 v = acc[ai][bj][m][n];
                        *(f32x4*)(rowp + bj * HALF + n * 16) = (f32x4){sigmoid_fast(v[0]), sigmoid_fast(v[1]), sigmoid_fast(v[2]), sigmoid_fast(v[3])}; } }
    }
};
struct EpiGateUp {
    static constexpr bool PERM = true;
    bf16_t* O;
    __device__ __forceinline__ void operator()(const f32x4 (&acc)[2][2][4][2], const Unit& u, int wr, int wc, int fr, int fq) const {
        const int row0 = u.pm * BM + wr * 64 + fr, col0 = u.pn * HALF + wc * 32 + 8 * fq;
#pragma unroll
        for (int ai = 0; ai < 2; ++ai)
#pragma unroll
            for (int m = 0; m < 4; ++m) {
                const f32x4 g0 = acc[ai][0][m][0], g1 = acc[ai][0][m][1], u0 = acc[ai][1][m][0], u1 = acc[ai][1][m][1];
                int d0 = __builtin_amdgcn_cvt_pk_fp8_f32(silu_fast(g0[0]) * u0[0] * 8.0f, silu_fast(g0[1]) * u0[1] * 8.0f, 0, false); d0 = __builtin_amdgcn_cvt_pk_fp8_f32(silu_fast(g0[2]) * u0[2] * 8.0f, silu_fast(g0[3]) * u0[3] * 8.0f, d0, true);
                int d1 = __builtin_amdgcn_cvt_pk_fp8_f32(silu_fast(g1[0]) * u1[0] * 8.0f, silu_fast(g1[1]) * u1[1] * 8.0f, 0, false); d1 = __builtin_amdgcn_cvt_pk_fp8_f32(silu_fast(g1[2]) * u1[2] * 8.0f, silu_fast(g1[3]) * u1[3] * 8.0f, d1, true);
                *(u32x2*)((char*)O + (size_t)(row0 + ai * HALF + m * 16) * 256 + col0) = (u32x2){(unsigned)d0, (unsigned)d1};
            }
    }
};
struct EpiF32 {
    static constexpr bool PERM = false;
    float* O;
    __device__ __forceinline__ void operator()(const f32x4 (&acc)[2][2][4][2], const Unit& u, int wr, int wc, int fr, int fq) const {
        const int row0 = u.pm * BM + wr * 64 + fr, col0 = u.pn * BM + wc * 32 + 4 * fq;
#pragma unroll
        for (int ai = 0; ai < 2; ++ai)
#pragma unroll
            for (int m = 0; m < 4; ++m) { float* rowp = O + (size_t)(row0 + ai * HALF + m * 16) * DM + col0;
#pragma unroll
                for (int bj = 0; bj < 2; ++bj)
#pragma unroll
                    for (int n = 0; n < 2; ++n) *(f32x4*)(rowp + bj * HALF + n * 16) = acc[ai][bj][m][n]; }
    }
};
struct ExpertSched {
    const LAS int* toff;
    const LAS int* offs;
    const LAS int* cntl;
    const char* gbase; unsigned lda;
    const unsigned short* ltok;
    const char* Ad;
    const char* Bt; size_t bexp; unsigned ldb;
    int ncolt, G, c, total;
    __device__ __forceinline__ bool next(int i, Unit& u) const {
        const int L = i * G + c; if (L >= total) return false;
        int lo = 0, hi = 256;
        while (hi - lo > 1) { const int mid = (lo + hi) >> 1; if (__builtin_amdgcn_readfirstlane(toff[mid]) <= L) lo = mid; else hi = mid; }
        const int lt = L - __builtin_amdgcn_readfirstlane(toff[lo]);
        u.e = lo; u.pm = lt / ncolt; u.pn = lt % ncolt; u.rows = __builtin_amdgcn_readfirstlane(cntl[lo]) - u.pm * BM;
        u.b = Bt + (size_t)lo * bexp + (size_t)u.pn * BM * ldb;
        u.a = Ad ? Ad + (size_t)(__builtin_amdgcn_readfirstlane(offs[lo]) + u.pm * BM) * lda : nullptr;
        return true;
    }
    __device__ __forceinline__ unsigned row_off(const Unit& u, int rl) const {
        const int r = u.pm * BM + rl, cn = __builtin_amdgcn_readfirstlane(cntl[u.e]);
        const int tok = ltok[(size_t)u.e * CAP + (r < cn ? r : 0)];
        return (unsigned)tok * lda;
    }
};
struct EpiExpGU {
    static constexpr bool PERM = true;
    bf16_t* O; const LAS int* offs; const LAS int* cntl;
    __device__ __forceinline__ void operator()(const f32x4 (&acc)[2][2][4][2], const Unit& u, int wr, int wc, int fr, int fq) const {
        const int cn = __builtin_amdgcn_readfirstlane(cntl[u.e]), ro = __builtin_amdgcn_readfirstlane(offs[u.e]);
        const int rl0 = u.pm * BM + wr * 64 + fr, col0 = u.pn * HALF + wc * 32 + 8 * fq;
#pragma unroll
        for (int ai = 0; ai < 2; ++ai)
#pragma unroll
            for (int m = 0; m < 4; ++m) {
                const int rl = rl0 + ai * HALF + m * 16;
                const unsigned ob = (unsigned)(rl < cn ? ro + rl : NL * 8) * 256u + (unsigned)col0;
                const f32x4 g0 = acc[ai][0][m][0] * (1.0f / 32.0f), g1 = acc[ai][0][m][1] * (1.0f / 32.0f), u0 = acc[ai][1][m][0] * (8.0f / 32.0f), u1 = acc[ai][1][m][1] * (8.0f / 32.0f);
                int d0 = __builtin_amdgcn_cvt_pk_fp8_f32(silu_fast(g0[0]) * u0[0], silu_fast(g0[1]) * u0[1], 0, false); d0 = __builtin_amdgcn_cvt_pk_fp8_f32(silu_fast(g0[2]) * u0[2], silu_fast(g0[3]) * u0[3], d0, true);
                int d1 = __builtin_amdgcn_cvt_pk_fp8_f32(silu_fast(g1[0]) * u1[0], silu_fast(g1[1]) * u1[1], 0, false); d1 = __builtin_amdgcn_cvt_pk_fp8_f32(silu_fast(g1[2]) * u1[2], silu_fast(g1[3]) * u1[3], d1, true);
                *(u32x2*)((char*)O + ob) = (u32x2){(unsigned)d0, (unsigned)d1};
            }
    }
};
#define YB_SCALE 8.0f
struct EpiExpDown {
    static constexpr bool PERM = true;
    bf16_t* O; const LAS int* offs; const LAS int* cntl;
    __device__ __forceinline__ void operator()(const f32x4 (&acc)[2][2][4][2], const Unit& u, int wr, int wc, int fr, int fq) const {
        const int cn = __builtin_amdgcn_readfirstlane(cntl[u.e]), ro = __builtin_amdgcn_readfirstlane(offs[u.e]);
        const int rl0 = u.pm * BM + wr * 64 + fr, col0 = u.pn * BM + wc * 32 + 8 * fq;
#pragma unroll
        for (int ai = 0; ai < 2; ++ai)
#pragma unroll
            for (int m = 0; m < 4; ++m) {
                const int rl = rl0 + ai * HALF + m * 16;
                const unsigned ob = (unsigned)(rl < cn ? ro + rl : NL * 8) * DM + (unsigned)col0;
#pragma unroll
                for (int bj = 0; bj < 2; ++bj) { const f32x4 v0 = acc[ai][bj][m][0] * (YB_SCALE / 128.0f), v1 = acc[ai][bj][m][1] * (YB_SCALE / 128.0f);
                    int d0 = __builtin_amdgcn_cvt_pk_fp8_f32(v0[0], v0[1], 0, false); d0 = __builtin_amdgcn_cvt_pk_fp8_f32(v0[2], v0[3], d0, true);
                    int d1 = __builtin_amdgcn_cvt_pk_fp8_f32(v1[0], v1[1], 0, false); d1 = __builtin_amdgcn_cvt_pk_fp8_f32(v1[2], v1[3], d1, true);
                    *(u32x2*)((char*)O + ob + bj * HALF) = (u32x2){(unsigned)d0, (unsigned)d1}; }
            }
    }
};
struct EpiAddG2 {
    static constexpr bool PERM = false;
    float* O; const float* modv;
    __device__ __forceinline__ void operator()(const f32x4 (&acc)[2][2][4][2], const Unit& u, int wr, int wc, int fr, int fq) const {
        const int row0 = u.pm * BM + wr * 64 + fr, col0 = u.pn * BM + wc * 32 + 4 * fq;
        const float* g2 = modv + ((u.pm * BM) / SEQ) * 6144 + 5120;
#pragma unroll
        for (int bj = 0; bj < 2; ++bj)
#pragma unroll
            for (int n = 0; n < 2; ++n) {
                const int c = col0 + bj * HALF + n * 16;
                const f32x4 g = *(const f32x4*)(g2 + c);
                f32x4 xv[8];
#pragma unroll
                for (int ai = 0; ai < 2; ++ai)
#pragma unroll
                    for (int m = 0; m < 4; ++m) xv[ai * 4 + m] = *(const f32x4*)(O + (size_t)(row0 + ai * HALF + m * 16) * DM + c);
#pragma unroll
                for (int ai = 0; ai < 2; ++ai)
#pragma unroll
                    for (int m = 0; m < 4; ++m) *(f32x4*)(O + (size_t)(row0 + ai * HALF + m * 16) * DM + c) = xv[ai * 4 + m] + g * acc[ai][bj][m][n];
            }
    }
};
}

__device__ __forceinline__ float4 ld4(const float* p) { return *(const float4*)p; }
__device__ __forceinline__ float4 ld4(const bf16_t* p) { const u32x2 w = *(const u32x2*)p; return make_float4(bflo(w[0]), bfhi(w[0]), bflo(w[1]), bfhi(w[1])); }
template <bool DUAL, class AF, class EF>
__device__ __forceinline__ void gemm_naive(float* lds, int m0, int n0, int M, int N, int K, AF arow,
                                           const float* __restrict__ B0, const float* __restrict__ B1, int ldb, EF epi) {
    float* As = lds;
    float* Bs0 = lds + 16 * 132;
    float* Bs1 = Bs0 + 16 * 64;
    const int tid = threadIdx.x;
    const int ty = tid >> 4, tx = tid & 15;
    float acc0[4][4], acc1[4][4];
#pragma unroll
    for (int i = 0; i < 4; ++i)
#pragma unroll
        for (int j = 0; j < 4; ++j) { acc0[i][j] = 0.f; acc1[i][j] = 0.f; }
    const int am = tid >> 2, ak = (tid & 3) * 4;
    const int bk = (tid >> 4) & 15, bn = (tid & 15) * 4;
    const bool bthr = tid < 256;
    auto ap = arow((m0 + am < M) ? (m0 + am) : m0);
    const bool aok = (m0 + am) < M;
    const bool bok = bthr && (n0 + bn) < N;
    for (int k0 = 0; k0 < K; k0 += 16) {
        float4 av = aok ? ld4(ap + k0 + ak) : make_float4(0.f, 0.f, 0.f, 0.f);
        float4 bv0 = bok ? *(const float4*)(B0 + (size_t)(k0 + bk) * ldb + n0 + bn) : make_float4(0.f, 0.f, 0.f, 0.f);
        float4 bv1 = make_float4(0.f, 0.f, 0.f, 0.f);
        if (DUAL) bv1 = bok ? *(const float4*)(B1 + (size_t)(k0 + bk) * ldb + n0 + bn) : make_float4(0.f, 0.f, 0.f, 0.f);
        __syncthreads();
        As[(ak + 0) * 132 + am] = av.x; As[(ak + 1) * 132 + am] = av.y; As[(ak + 2) * 132 + am] = av.z; As[(ak + 3) * 132 + am] = av.w;
        if (bthr) { *(float4*)&Bs0[bk * 64 + bn] = bv0; if (DUAL) *(float4*)&Bs1[bk * 64 + bn] = bv1; }
        __syncthreads();
#pragma unroll
        for (int kk = 0; kk < 16; ++kk) {
            const float4 a = *(const float4*)&As[kk * 132 + ty * 4];
            const float4 b = *(const float4*)&Bs0[kk * 64 + tx * 4];
            const float aa[4] = {a.x, a.y, a.z, a.w};
            const float bb[4] = {b.x, b.y, b.z, b.w};
#pragma unroll
            for (int i = 0; i < 4; ++i)
#pragma unroll
                for (int j = 0; j < 4; ++j) acc0[i][j] = fmaf(aa[i], bb[j], acc0[i][j]);
            if (DUAL) {
                const float4 b1 = *(const float4*)&Bs1[kk * 64 + tx * 4];
                const float bb1[4] = {b1.x, b1.y, b1.z, b1.w};
#pragma unroll
                for (int i = 0; i < 4; ++i)
#pragma unroll
                    for (int j = 0; j < 4; ++j) acc1[i][j] = fmaf(aa[i], bb1[j], acc1[i][j]);
            }
        }
    }
#pragma unroll
    for (int i = 0; i < 4; ++i)
#pragma unroll
        for (int j = 0; j < 4; ++j) {
            const int m = m0 + ty * 4 + i, n = n0 + tx * 4 + j;
            if (m < M && n < N) epi(m, n, acc0[i][j], acc1[i][j]);
        }
    __syncthreads();
}

__device__ __forceinline__ void modv_unit(const Params& p, float* lds, int u) {
    float* red = lds + 17 * 1024;
    const int tid = threadIdx.x, col_l = tid & 31, kg = tid >> 5;
    const int col = u * 32 + col_l;
    float acc[17];
#pragma unroll
    for (int b = 0; b < 17; ++b) acc[b] = 0.f;
    for (int k = kg * 64; k < kg * 64 + 64; ++k) {
        const float w = p.ada_w[(size_t)k * 6144 + col];
#pragma unroll
        for (int b = 0; b < 17; ++b) acc[b] = fmaf(lds[b * 1024 + k], w, acc[b]);
    }
#pragma unroll
    for (int b = 0; b < 17; ++b) {
        __syncthreads();
        red[kg * 32 + col_l] = acc[b];
        __syncthreads();
        if (kg == 0) {
            float s = 0.f;
#pragma unroll
            for (int g = 0; g < 16; ++g) s += red[g * 32 + col_l];
            p.modv[b * 6144 + col] = s + p.ada_b[col];
        }
    }
}

struct CvtJob { const float* W; bf16_t* dst; int ldw, N, k0, n0, ldd, map; float f8;
};
#define NJ_DENSE 552
#define NJ_TOTAL (NJ_DENSE + 256 * 96)
__device__ __forceinline__ CvtJob cvt_decode(const Params& p, int u) {
    CvtJob j;
    const int J0 = 264, J1 = J0 + 128, J2 = J1 + 32, J3 = J2 + 32, J4 = J3 + 32, J5 = J4 + 32;
    if (u >= NJ_DENSE) {
        const int v = u - NJ_DENSE, e = v / 96, r = v % 96, which = r >> 5, l = r & 31;
        if (which < 2) { j.W = (which ? p.ew_up : p.ew_gate) + (size_t)e * DM * 256; j.dst = (bf16_t*)((char*)p.eguT + (size_t)e * 512 * DM); j.ldw = 256; j.N = 256; j.k0 = (l >> 2) * 128; j.n0 = (l & 3) * 64; j.ldd = DM; j.map = 2 + which; j.f8 = 32.0f; }
        else { j.W = p.ew_down + (size_t)e * 256 * DM; j.dst = (bf16_t*)((char*)p.edT + (size_t)e * DM * 256); j.ldw = DM; j.N = DM; j.k0 = (l >> 4) * 128; j.n0 = (l & 15) * 64; j.ldd = 256; j.map = 0; j.f8 = 16.0f; }
        return j;
    }
    j.f8 = 0.0f;
    if (u < J0) { j.W = p.w_in; j.dst = p.w_inT; j.ldw = DIN; j.N = DIN; j.k0 = (u / 33) * 128; j.n0 = (u % 33) * 64; j.ldd = DM; j.map = 1; }
    else if (u < J1) { const int l = u - J0; j.W = p.w_out; j.dst = p.w_outT; j.ldw = DM; j.N = DM; j.k0 = (l / 16) * 128; j.n0 = (l % 16) * 64; j.ldd = DM; j.map = 0; }
    else if (u < J2) { const int l = u - J1; j.W = p.glu_w; j.dst = p.gluT; j.ldw = 512; j.N = 512; j.k0 = (l / 8) * 128; j.n0 = (l % 8) * 64; j.ldd = 512; j.map = 0; }
    else if (u < J3) { const int l = u - J2; j.W = p.router_w; j.dst = p.routerT3; j.ldw = 256; j.N = 256; j.k0 = (l / 4) * 128; j.n0 = (l % 4) * 64; j.ldd = 3072; j.map = 4; }
    else if (u < J4) { const int l = u - J3; j.W = p.sw_gate; j.dst = p.shguT; j.ldw = 256; j.N = 256; j.k0 = (l / 4) * 128; j.n0 = (l % 4) * 64; j.ldd = DM; j.map = 2; }
    else if (u < J5) { const int l = u - J4; j.W = p.sw_up; j.dst = p.shguT; j.ldw = 256; j.N = 256; j.k0 = (l / 4) * 128; j.n0 = (l % 4) * 64; j.ldd = DM; j.map = 3; }
    else { const int l = u - J5; j.W = p.sw_down; j.dst = p.shdT; j.ldw = DM; j.N = DM; j.k0 = (l / 16) * 128; j.n0 = (l % 16) * 64; j.ldd = 256; j.map = 0; j.f8 = 16.0f; }
    return j;
}
__device__ __forceinline__ int cvt_rowmap(int map, int c) {
    if (map == 1) return c < S_LR ? c : (c < S_U ? (WC_LR + (c - S_LR)) : (WC_U + (c - S_U)));
    if (map == 2) return (c >> 7) * 256 + (c & 127);
    if (map == 3) return (c >> 7) * 256 + 128 + (c & 127);
    return c;
}
__device__ __forceinline__ void cvt_load(const CvtJob& j, float4 (&r)[4]) {
    const int tid = threadIdx.x;
#pragma unroll
    for (int i = 0; i < 2; ++i) {
        const int kk = (j.f8 != 0.0f) ? (tid >> 4) * 4 + 2 * i : (tid >> 4) * 2 + 64 * i, n = j.n0 + (tid & 15) * 4;
        r[2 * i] = make_float4(0.f, 0.f, 0.f, 0.f); r[2 * i + 1] = r[2 * i];
        if (n < j.N) { r[2 * i] = *(const float4*)(j.W + (size_t)(j.k0 + kk) * j.ldw + n); r[2 * i + 1] = *(const float4*)(j.W + (size_t)(j.k0 + kk + 1) * j.ldw + n); }
    }
}
__device__ __forceinline__ void cvt_fill(const CvtJob& j, const float4 (&r)[4], unsigned* T, unsigned* T2) {
    const int tid = threadIdx.x;
    if (j.f8 != 0.0f) {
        const int nl = (tid & 15) * 4, kq = tid >> 4; const float s = j.f8;
        const float a0[4] = {r[0].x, r[0].y, r[0].z, r[0].w}, a1[4] = {r[1].x, r[1].y, r[1].z, r[1].w}, a2[4] = {r[2].x, r[2].y, r[2].z, r[2].w}, a3[4] = {r[3].x, r[3].y, r[3].z, r[3].w};
#pragma unroll
        for (int q = 0; q < 4; ++q) { int w = __builtin_amdgcn_cvt_pk_fp8_f32(a0[q] * s, a1[q] * s, 0, false); w = __builtin_amdgcn_cvt_pk_fp8_f32(a2[q] * s, a3[q] * s, w, true); T[(nl + q) * 33 + kq] = (unsigned)w; }
        return;
    }
#pragma unroll
    for (int i = 0; i < 2; ++i) {
        const int kk = (tid >> 4) * 2 + 64 * i, nl = (tid & 15) * 4;
        const float av[4] = {r[2 * i].x, r[2 * i].y, r[2 * i].z, r[2 * i].w}, bv[4] = {r[2 * i + 1].x, r[2 * i + 1].y, r[2 * i + 1].z, r[2 * i + 1].w};
#pragma unroll
        for (int q = 0; q < 4; ++q) {
            const unsigned w = cvt_pk_bf16(av[q], bv[q]);
            T[(nl + q) * 65 + (kk >> 1)] = w;
            if (j.map == 4) T2[(nl + q) * 65 + (kk >> 1)] = cvt_pk_bf16(av[q] - bflo(w), bv[q] - bfhi(w));
        }
    }
}
__device__ __forceinline__ void cvt_drain(const CvtJob& j, const unsigned* T, const unsigned* T2) {
    const int tid = threadIdx.x;
    const int n_l = tid >> 3, seg = tid & 7;
    if (j.f8 != 0.0f) {
        if (j.n0 + n_l < j.N) {
            const int rr = cvt_rowmap(j.map, j.n0 + n_l);
            u32x4 w0;
#pragma unroll
            for (int w = 0; w < 4; ++w) w0[w] = T[n_l * 33 + seg * 4 + w];
            *(u32x4*)((char*)j.dst + (size_t)rr * j.ldd + j.k0 + seg * 16) = w0;
        }
        return;
    }
    if (j.n0 + n_l < j.N) {
        const int rr = cvt_rowmap(j.map, j.n0 + n_l);
        u32x4 w0, w1;
#pragma unroll
        for (int w = 0; w < 4; ++w) { w0[w] = T[n_l * 65 + seg * 8 + w]; w1[w] = T[n_l * 65 + seg * 8 + 4 + w]; }
        bf16_t* d = j.dst + (size_t)rr * j.ldd + j.k0 + seg * 16;
        *(u32x4*)d = w0; *(u32x4*)(d + 8) = w1;
        if (j.map == 4) {
            *(u32x4*)(d + 1024) = w0; *(u32x4*)(d + 1032) = w1;
#pragma unroll
            for (int w = 0; w < 4; ++w) { w0[w] = T2[n_l * 65 + seg * 8 + w]; w1[w] = T2[n_l * 65 + seg * 8 + 4 + w]; }
            *(u32x4*)(d + 2048) = w0; *(u32x4*)(d + 2056) = w1;
        }
    }
}

__device__ __forceinline__ void phase_prologue(const Params& p, float* lds, const int part) {
    const int tid = threadIdx.x, bid = blockIdx.x, nb = gridDim.x;
    if (part == 0) {
    if (bid < 192) {
        for (int i = tid; i < 17 * 1024; i += NT) {
            const int b = i >> 10, k = i & 1023;
            lds[i] = siluf_((b < 16) ? p.c[b * 1024 + k] : p.c_ctx[k]);
        }
        __syncthreads();
        for (int u = bid; u < 192; u += nb) modv_unit(p, lds, u);
        __syncthreads();
    }
    { u32x4* zp = (u32x4*)(p.w_inT + (size_t)DIN * DM); const int nz = (2304 - DIN) * DM * 2 / 16;
      for (int i = bid * NT + tid; i < nz; i += nb * NT) zp[i] = (u32x4){0u, 0u, 0u, 0u}; }
    return;
    }
    unsigned* Tb = (unsigned*)lds;
    int u = nb - 1 - bid, par = 0;
    if (u < NJ_TOTAL) {
        CvtJob jA = cvt_decode(p, u), jB = jA; float4 rA[4], rB[4];
        bool hB = (u + nb) < NJ_TOTAL;
        cvt_load(jA, rA);
        if (hB) { jB = cvt_decode(p, u + nb); cvt_load(jB, rB); } else { for (int q = 0; q < 4; ++q) rB[q] = rA[q]; }
        for (;;) {
            const int un = u + 2 * nb; const bool hnA = un < NJ_TOTAL, hnB = (un + nb) < NJ_TOTAL;
            CvtJob jnA = jA, jnB = jB; float4 rnA[4], rnB[4];
            if (hnA) { jnA = cvt_decode(p, un); cvt_load(jnA, rnA); } else { for (int q = 0; q < 4; ++q) rnA[q] = rA[q]; }
            if (hnB) { jnB = cvt_decode(p, un + nb); cvt_load(jnB, rnB); } else { for (int q = 0; q < 4; ++q) rnB[q] = rB[q]; }
            unsigned* T0 = Tb + (par * 2 + 0) * (64 * 65); unsigned* T1 = Tb + (par * 2 + 1) * (64 * 65); unsigned* T2 = Tb + 4 * (64 * 65);
            cvt_fill(jA, rA, T0, T2);
            if (hB) cvt_fill(jB, rB, T1, T2);
            __syncthreads();
            cvt_drain(jA, T0, T2);
            if (hB) cvt_drain(jB, T1, T2);
            if (jA.map == 4 || jB.map == 4) __syncthreads();
            if (!hnA) break;
            par ^= 1; u = un; jA = jnA; jB = jnB; hB = hnB;
#pragma unroll
            for (int q = 0; q < 4; ++q) { rA[q] = rnA[q]; rB[q] = rnB[q]; }
        }
    }
    __syncthreads();
}

__device__ __forceinline__ void phase_norm_mod(const Params& p, int which) {
    const int lane = threadIdx.x & 63, wave = threadIdx.x >> 6;
    const int nrows = which == 0 ? NR : NL;
    const float* g = which == 0 ? p.norm1_g : p.norm2_g;
    const int osh = which == 0 ? 0 : 3072, osc = which == 0 ? 1024 : 4096;
    auto rowsrc = [&](int r) -> const float* {
        if (which == 0) return (r < NL) ? p.x + (size_t)r * DM : p.ctx + (size_t)(r - NL) * DM;
        return p.out + (size_t)r * DM;
    };
    const int stride = gridDim.x * NWAVES, rbase = blockIdx.x * NWAVES + wave;
    float4 ring[3][4];
#pragma unroll
    for (int k = 0; k < 3; ++k) if (rbase + k * stride < nrows) { const float* s0 = rowsrc(rbase + k * stride);
#pragma unroll
        for (int i = 0; i < 2; ++i) {
            if (which == 1) ring[k][i] = __builtin_bit_cast(float4, *(const u32x4*)(p.yf + (size_t)(rbase + k * stride) * DM + i * 512 + lane * 8));
            else { ring[k][2 * i] = *(const float4*)(s0 + i * 512 + lane * 8); ring[k][2 * i + 1] = *(const float4*)(s0 + i * 512 + lane * 8 + 4); } } }
    for (int r0 = rbase; r0 < nrows; r0 += 3 * stride) {
#pragma unroll
      for (int k = 0; k < 3; ++k) {
        const int r = r0 + k * stride;
        if (r >= nrows) break;
        const int b = (which == 0 && r >= NL) ? 16 : r / SEQ;
        float4 v[4]; float ss = 0.f;
#pragma unroll
        for (int i = 0; i < 4; ++i) v[i] = ring[k][i];
        if (which == 1) {
#pragma unroll
            for (int i = 0; i < 2; ++i) { const u32x4 w_ = __builtin_bit_cast(u32x4, ring[k][i]);
                v[2 * i] = make_float4(bflo(w_[0]), bfhi(w_[0]), bflo(w_[1]), bfhi(w_[1])); v[2 * i + 1] = make_float4(bflo(w_[2]), bfhi(w_[2]), bflo(w_[3]), bfhi(w_[3])); }
        }
        {
            const int rn = r + 3 * stride;
            if (rn < nrows) { const float* s1 = rowsrc(rn);
#pragma unroll
                for (int i = 0; i < 2; ++i) {
                    if (which == 1) ring[k][i] = __builtin_bit_cast(float4, *(const u32x4*)(p.yf + (size_t)rn * DM + i * 512 + lane * 8));
                    else { ring[k][2 * i] = *(const float4*)(s1 + i * 512 + lane * 8); ring[k][2 * i + 1] = *(const float4*)(s1 + i * 512 + lane * 8 + 4); } } }
        }
#pragma unroll
        for (int i = 0; i < 4; ++i) ss += v[i].x * v[i].x + v[i].y * v[i].y + v[i].z * v[i].z + v[i].w * v[i].w;
        ss = wave_sum(ss);
        const float rstd = rsqrtf(ss * (1.0f / DM) + EPS);
        const float* mv = p.modv + b * 6144;
#pragma unroll
        for (int i = 0; i < 2; ++i) {
            const int col = i * 512 + lane * 8;
            float o[8];
#pragma unroll
            for (int h = 0; h < 2; ++h) {
                const float4 gg = *(const float4*)(g + col + 4 * h), sh = *(const float4*)(mv + osh + col + 4 * h), sc = *(const float4*)(mv + osc + col + 4 * h);
                const float4 vv = v[2 * i + h];
                o[4 * h + 0] = vv.x * rstd * gg.x * (1.f + sc.x) + sh.x; o[4 * h + 1] = vv.y * rstd * gg.y * (1.f + sc.y) + sh.y;
                o[4 * h + 2] = vv.z * rstd * gg.z * (1.f + sc.z) + sh.z; o[4 * h + 3] = vv.w * rstd * gg.w * (1.f + sc.w) + sh.w;
            }
            u32x4 hi = (u32x4){cvt_pk_bf16(o[0], o[1]), cvt_pk_bf16(o[2], o[3]), cvt_pk_bf16(o[4], o[5]), cvt_pk_bf16(o[6], o[7])};
            if (which == 0) {
                *(u32x4*)(p.hx + (size_t)r * DM + col) = hi;
            } else {
                *(u32x4*)(p.hx + (size_t)r * DM + col) = hi;
                { int d0 = __builtin_amdgcn_cvt_pk_fp8_f32(o[0], o[1], 0, false); d0 = __builtin_amdgcn_cvt_pk_fp8_f32(o[2], o[3], d0, true);
                  int d1 = __builtin_amdgcn_cvt_pk_fp8_f32(o[4], o[5], 0, false); d1 = __builtin_amdgcn_cvt_pk_fp8_f32(o[6], o[7], d1, true);
                  *(u32x2*)((char*)p.of + (size_t)r * DM + col) = (u32x2){(unsigned)d0, (unsigned)d1}; }
            }
        }
    }
    }
}

__device__ __forceinline__ int scan_row(int b, int dir, int s, bool& lat) {
    if (s < CTX) { lat = false; const int t = dir ? (CTX - 1 - s) : s; return NL + b * CTX + t; }
    lat = true; const int t = dir ? (SEQ - 1 - (s - CTX)) : (s - CTX); return b * SEQ + t;
}

#define GL_LD 72
__device__ __forceinline__ void gla_chunk_unit(const Params& p, unsigned char* lds8, int unit) {
    const int dir = unit & 1, h = (unit >> 1) & 3, b = unit >> 3;
    const int tid = threadIdx.x, lane = tid & 63, w = __builtin_amdgcn_readfirstlane(tid >> 6), fr = lane & 15, fq = lane >> 4;
    const int tc = tid >> 3, g8 = tid & 7;
    bf16_t* Qc = (bf16_t*)lds8;            bf16_t* Ki = Qc + 64 * GL_LD;   bf16_t* Pm = Ki + 64 * GL_LD;
    bf16_t* KsT = Pm + 64 * GL_LD;         bf16_t* VT = KsT + 64 * GL_LD;  bf16_t* ST = VT + 128 * GL_LD;
    float* LA = (float*)(ST + 128 * GL_LD); float* SEG = LA + 64 * 64;      float* LR = SEG + 8 * 64;
    float* WA = LR + 64 * 16;              float* BA = WA + 16 * 64;       float* DEC = BA + 64;   float* CL = DEC + 64;
    const float* wa = dir ? p.wa_b : p.wa_f;
    const float* ba = dir ? p.ba_b : p.ba_f;
    __syncthreads();
    for (int i = tid; i < 100 * 1024 / 4; i += NT) ((unsigned*)lds8)[i] = 0u;
    __syncthreads();
    f32x4 accS[4];
#pragma unroll
    for (int j = 0; j < 4; ++j) accS[j] = (f32x4){0.f, 0.f, 0.f, 0.f};
    const int tm = w >> 1, pr = w & 1;
    bf16x8 wfrag[2]; f32x4 bav[2];
#pragma unroll
    for (int j = 0; j < 2; ++j) {
        const int dk0 = (pr * 2 + j) * 16;
        u32x4 wv = (u32x4){0u, 0u, 0u, 0u};
        if (fq < 2) {
            float t8[8];
#pragma unroll
            for (int i = 0; i < 8; ++i) t8[i] = wa[(fq * 8 + i) * 256 + h * 64 + dk0 + fr];
            wv = (u32x4){cvt_pk_bf16(t8[0], t8[1]), cvt_pk_bf16(t8[2], t8[3]), cvt_pk_bf16(t8[4], t8[5]), cvt_pk_bf16(t8[6], t8[7])};
        }
        wfrag[j] = __builtin_bit_cast(bf16x8, wv);
        bav[j] = (f32x4){ba[h * 64 + dk0 + fq * 4], ba[h * 64 + dk0 + fq * 4 + 1], ba[h * 64 + dk0 + fq * 4 + 2], ba[h * 64 + dk0 + fq * 4 + 3]};
    }
    auto row_of = [&](int sc, int c) -> int {
        if (sc < 4) { const int tok = dir ? ((3 - sc) * 64 + 63 - c) : (sc * 64 + c); return NL + b * CTX + tok; }
        const int n = sc - 4; const int tok = dir ? ((31 - n) * 64 + 63 - c) : (n * 64 + c); return b * SEQ + tok;
    };
    u32x4 rq, rk, rv, rv2; unsigned rl;
    {
        const bf16_t* pr0 = p.proj + (size_t)row_of(0, tc) * DINP;
        rq = *(const u32x4*)(pr0 + P_Q + h * 64 + g8 * 8); rk = *(const u32x4*)(pr0 + P_K + h * 64 + g8 * 8);
        rv = *(const u32x4*)(pr0 + P_V + h * 128 + g8 * 16); rv2 = *(const u32x4*)(pr0 + P_V + h * 128 + g8 * 16 + 8); rl = *(const unsigned*)(pr0 + P_LRF + dir * 16 + g8 * 2);
    }
    for (int sc = 0; sc < 36; ++sc) {
        const bool lat = sc >= 4;
        const u32x4 cq = rq, ck = rk, cv = rv, cv2 = rv2; const unsigned cl_ = rl;
        if (sc + 1 < 36) {
            const bf16_t* pr1 = p.proj + (size_t)row_of(sc + 1, tc) * DINP;
            rq = *(const u32x4*)(pr1 + P_Q + h * 64 + g8 * 8); rk = *(const u32x4*)(pr1 + P_K + h * 64 + g8 * 8);
            rv = *(const u32x4*)(pr1 + P_V + h * 128 + g8 * 16); rv2 = *(const u32x4*)(pr1 + P_V + h * 128 + g8 * 16 + 8); rl = *(const unsigned*)(pr1 + P_LRF + dir * 16 + g8 * 2);
        }
        ((unsigned*)LR)[tc * 8 + g8] = cl_;
        __syncthreads();
        {
            u32x4 lv = (u32x4){0u, 0u, 0u, 0u};
            if (fq < 2) lv = *(const u32x4*)((const unsigned char*)LR + (tm * 16 + fr) * 32 + fq * 16);
            const bf16x8 lrf = __builtin_bit_cast(bf16x8, lv);
#pragma unroll
            for (int j = 0; j < 2; ++j) {
                f32x4 z = __builtin_amdgcn_mfma_f32_16x16x32_bf16(wfrag[j], lrf, (f32x4){0.f, 0.f, 0.f, 0.f}, 0, 0, 0);
                asm volatile("s_nop 15\n\ts_nop 15" : "+v"(z));
                z = z + bav[j];
                f32x4 o;
#pragma unroll
                for (int r = 0; r < 4; ++r) {
                    const float e = __builtin_amdgcn_exp2f(-fabsf(z[r]) * 1.4426950408889634f);
                    o[r] = (fminf(z[r], 0.0f) - __builtin_amdgcn_logf(1.0f + e) * 0.6931471805599453f) * (1.0f / 16.0f);
                }
                *(f32x4*)(LA + (tm * 16 + fr) * 64 + (pr * 2 + j) * 16 + fq * 4) = o;
            }
        }
        __syncthreads();
        {
            const int dk = tid & 63, sg = tid >> 6; float run = 0.f;
#pragma unroll
            for (int i = 0; i < 8; ++i) { run += LA[(sg * 8 + i) * 64 + dk]; LA[(sg * 8 + i) * 64 + dk] = run; }
            SEG[sg * 64 + dk] = run;
        }
        __syncthreads();
        if (tid < 64) {
            float run = 0.f;
#pragma unroll
            for (int s = 0; s < 8; ++s) { const float t = SEG[s * 64 + tid]; SEG[s * 64 + tid] = run; run += t; }
            CL[tid] = run; DEC[tid] = __builtin_amdgcn_exp2f(run * 1.4426950408889634f);
        }
        __syncthreads();
        {
            const float qv[8] = {bflo(cq[0]), bfhi(cq[0]), bflo(cq[1]), bfhi(cq[1]), bflo(cq[2]), bfhi(cq[2]), bflo(cq[3]), bfhi(cq[3])};
            const float kv[8] = {bflo(ck[0]), bfhi(ck[0]), bflo(ck[1]), bfhi(ck[1]), bflo(ck[2]), bfhi(ck[2]), bflo(ck[3]), bfhi(ck[3])};
            float qo[8], ko[8], ks[8];
#pragma unroll
            for (int i = 0; i < 8; ++i) {
                const int dk = g8 * 8 + i;
                const float cum = LA[tc * 64 + dk] + SEG[(tc >> 3) * 64 + dk];
                const float ec = __builtin_amdgcn_exp2f(cum * 1.4426950408889634f), en = __builtin_amdgcn_rcpf(ec), es = DEC[dk] * en;
                qo[i] = qv[i] * 0.125f * ec; ko[i] = kv[i] * en; ks[i] = kv[i] * es;
            }
#pragma unroll
            for (int i = 0; i < 8; i += 2) { const unsigned pk = cvt_pk_bf16(ks[i], ks[i + 1]);
                KsT[(g8 * 8 + i) * GL_LD + tc] = (bf16_t)(pk & 0xFFFFu); KsT[(g8 * 8 + i + 1) * GL_LD + tc] = (bf16_t)(pk >> 16); }
            *(u32x4*)(Qc + tc * GL_LD + g8 * 8) = (u32x4){cvt_pk_bf16(qo[0], qo[1]), cvt_pk_bf16(qo[2], qo[3]), cvt_pk_bf16(qo[4], qo[5]), cvt_pk_bf16(qo[6], qo[7])};
            *(u32x4*)(Ki + tc * GL_LD + g8 * 8) = (u32x4){cvt_pk_bf16(ko[0], ko[1]), cvt_pk_bf16(ko[2], ko[3]), cvt_pk_bf16(ko[4], ko[5]), cvt_pk_bf16(ko[6], ko[7])};
#pragma unroll
            for (int i = 0; i < 4; ++i) { VT[(g8 * 16 + 2 * i) * GL_LD + tc] = (bf16_t)(cv[i] & 0xFFFFu); VT[(g8 * 16 + 2 * i + 1) * GL_LD + tc] = (bf16_t)(cv[i] >> 16);
                                          VT[(g8 * 16 + 8 + 2 * i) * GL_LD + tc] = (bf16_t)(cv2[i] & 0xFFFFu); VT[(g8 * 16 + 9 + 2 * i) * GL_LD + tc] = (bf16_t)(cv2[i] >> 16); }
        }
        __syncthreads();
        f32x4 accO[4];
#pragma unroll
        for (int j = 0; j < 4; ++j) accO[j] = (f32x4){0.f, 0.f, 0.f, 0.f};
        bf16x8 yq[2];
        if (lat) {
#pragma unroll
            for (int kk = 0; kk < 2; ++kk) yq[kk] = *(const bf16x8*)(Qc + (tm * 16 + fr) * GL_LD + kk * 32 + fq * 8);
#pragma unroll
            for (int j = 0; j < 2; ++j) {
                const int ts = pr * 2 + j;
                f32x4 d = (f32x4){0.f, 0.f, 0.f, 0.f};
                if (ts <= tm) {
#pragma unroll
                    for (int kk = 0; kk < 2; ++kk) { const bf16x8 xk = *(const bf16x8*)(Ki + (ts * 16 + fr) * GL_LD + kk * 32 + fq * 8);
                        d = __builtin_amdgcn_mfma_f32_16x16x32_bf16(xk, yq[kk], d, 0, 0, 0); }
                    asm volatile("s_nop 15\n\ts_nop 15" : "+v"(d));
                    if (ts == tm) {
#pragma unroll
                        for (int r = 0; r < 4; ++r) d[r] = (fq * 4 + r <= fr) ? d[r] : 0.f;
                    }
                }
                *(u32x2*)(Pm + (tm * 16 + fr) * GL_LD + ts * 16 + fq * 4) = (u32x2){cvt_pk_bf16(d[0], d[1]), cvt_pk_bf16(d[2], d[3])};
            }
#pragma unroll
            for (int j = 0; j < 4; ++j) {
                const int tv = pr * 4 + j;
#pragma unroll
                for (int kk = 0; kk < 2; ++kk) { const bf16x8 xs = *(const bf16x8*)(ST + (tv * 16 + fr) * GL_LD + kk * 32 + fq * 8);
                    accO[j] = __builtin_amdgcn_mfma_f32_16x16x32_bf16(xs, yq[kk], accO[j], 0, 0, 0); }
            }
        }
        __syncthreads();
        {
            bf16x8 yp[2];
            if (lat) {
#pragma unroll
                for (int kk = 0; kk < 2; ++kk) yp[kk] = *(const bf16x8*)(Pm + (tm * 16 + fr) * GL_LD + kk * 32 + fq * 8);
            }
            const int orow = row_of(sc, tm * 16 + fr);
#pragma unroll
            for (int j = 0; j < 4; ++j) {
                const int tv = pr * 4 + j;
                bf16x8 xv[2];
#pragma unroll
                for (int kk = 0; kk < 2; ++kk) xv[kk] = *(const bf16x8*)(VT + (tv * 16 + fr) * GL_LD + kk * 32 + fq * 8);
                if (lat) {
#pragma unroll
                    for (int kk = 0; kk < 2; ++kk) accO[j] = __builtin_amdgcn_mfma_f32_16x16x32_bf16(xv[kk], yp[kk], accO[j], 0, 0, 0);
                    asm volatile("s_nop 15\n\ts_nop 15" : "+v"(accO[j]));
                    *(u32x2*)(p.of + ((size_t)dir * NL + orow) * 512 + h * 128 + tv * 16 + fq * 4) = (u32x2){cvt_pk_bf16(accO[j][0], accO[j][1]), cvt_pk_bf16(accO[j][2], accO[j][3])};
                }
                const f32x4 dc = *(const f32x4*)(DEC + tm * 16 + fq * 4);
                accS[j] = accS[j] * dc;
                asm volatile("s_nop 15\n\ts_nop 15" : "+v"(accS[j]));
#pragma unroll
                for (int kk = 0; kk < 2; ++kk) { const bf16x8 xks = *(const bf16x8*)(KsT + (tm * 16 + fr) * GL_LD + kk * 32 + fq * 8);
                    accS[j] = __builtin_amdgcn_mfma_f32_16x16x32_bf16(xks, xv[kk], accS[j], 0, 0, 0); }
                asm volatile("s_nop 15\n\ts_nop 15" : "+v"(accS[j]));
                *(u32x2*)(ST + (tv * 16 + fr) * GL_LD + tm * 16 + fq * 4) = (u32x2){cvt_pk_bf16(accS[j][0], accS[j][1]), cvt_pk_bf16(accS[j][2], accS[j][3])};
            }
        }
        __syncthreads();
    }
}

template <int dir> __device__ __forceinline__ void s5_wave_chain(const Params& p, int unit, unsigned char* wlds) {
    const int lane = threadIdx.x & 63, fr = lane & 15, fq = lane >> 4;
    const int g = (unit >> 1) & 31, b = unit >> 6;
    float* BU = (float*)wlds;
    bf16_t* XB = (bf16_t*)(wlds + 128 * 20 * 4);
    const float* lre = dir ? p.lam_re_b : p.lam_re_f;
    const float* lim = dir ? p.lam_im_b : p.lam_im_f;
    const float* lst = dir ? p.lstep_b : p.lstep_f;
    const float* cre = dir ? p.c_re_b : p.c_re_f;
    const float* cim = dir ? p.c_im_b : p.c_im_f;
    float a_re, a_im;
    {
        const float lam_re = lre[g * 64 + lane], lam_im = lim[g * 64 + lane];
        const float step = expf(lst[g]);
        const float mag = expf(lam_re * step);
        a_re = mag * cosf(lam_im * step); a_im = mag * sinf(lam_im * step);
    }
    bf16x8 yb[2][4];
#pragma unroll
    for (int st = 0; st < 4; ++st) {
        const int pp = st * 16 + fr;
        const float lam_re = lre[g * 64 + pp], lam_im = lim[g * 64 + pp];
        const float step = expf(lst[g]);
        const float mag = expf(lam_re * step);
        const float ar = mag * cosf(lam_im * step), ai = mag * sinf(lam_im * step);
        const float den = lam_re * lam_re + lam_im * lam_im;
        const float f_re = ((ar - 1.0f) * lam_re + ai * lam_im) / den;
        const float f_im = (ai * lam_re - (ar - 1.0f) * lam_im) / den;
        u32x4 wr_ = (u32x4){0u, 0u, 0u, 0u}, wi_ = wr_;
        if (fq < 2) {
            float vr[8], vi[8];
#pragma unroll
            for (int j = 0; j < 8; ++j) { const float br = p.b_re[(g * 64 + pp) * 16 + fq * 8 + j], bi = p.b_im[(g * 64 + pp) * 16 + fq * 8 + j];
                vr[j] = f_re * br - f_im * bi; vi[j] = f_re * bi + f_im * br; }
            wr_ = (u32x4){cvt_pk_bf16(vr[0], vr[1]), cvt_pk_bf16(vr[2], vr[3]), cvt_pk_bf16(vr[4], vr[5]), cvt_pk_bf16(vr[6], vr[7])};
            wi_ = (u32x4){cvt_pk_bf16(vi[0], vi[1]), cvt_pk_bf16(vi[2], vi[3]), cvt_pk_bf16(vi[4], vi[5]), cvt_pk_bf16(vi[6], vi[7])};
        }
        yb[0][st] = __builtin_bit_cast(bf16x8, wr_); yb[1][st] = __builtin_bit_cast(bf16x8, wi_);
    }
    bf16x8 cb[4];
#pragma unroll
    for (int kk = 0; kk < 4; ++kk) {
        float v[8];
#pragma unroll
        for (int j = 0; j < 8; ++j) { const int s = kk * 16 + fq * 4 + (j >> 1);
            v[j] = (j & 1) ? -cim[(g * 16 + fr) * 64 + s] : cre[(g * 16 + fr) * 64 + s]; }
        cb[kk] = __builtin_bit_cast(bf16x8, (u32x4){cvt_pk_bf16(v[0], v[1]), cvt_pk_bf16(v[2], v[3]), cvt_pk_bf16(v[4], v[5]), cvt_pk_bf16(v[6], v[7])});
    }
    auto crow = [&](int n) -> int { return (n < 16) ? (S5_ROWS - 256 + b * 16 + (dir ? 15 - n : n)) : (b * 128 + (dir ? 127 - (n - 16) : (n - 16))); };
    const bf16_t* Agg = p.Ag + (size_t)g * S5_ROWS * 512;
    const int tokidx = dir ? 15 - fr : fr;
    u32x4 rr[4];
#pragma unroll
    for (int k = 0; k < 4; ++k) { rr[k] = (u32x4){0u, 0u, 0u, 0u}; if (fq < 2) rr[k] = *(const u32x4*)(Agg + (size_t)crow(k) * 512 + tokidx * 16 + fq * 8); }
    f32x2_t X = {0.f, 0.f};
    const f32x2_t Are = {a_re, a_re}, Aimn = {-a_im, a_im};
    for (int i = lane; i < S5_WLDS / 4; i += 64) ((unsigned*)wlds)[i] = 0u;
    asm volatile("s_waitcnt lgkmcnt(0)" ::: "memory");
    for (int n4 = 0; n4 < 144; n4 += 4) {
#pragma unroll
      for (int k4 = 0; k4 < 4; ++k4) {
        const int n = n4 + k4;
        const bf16x8 xa = __builtin_bit_cast(bf16x8, rr[k4]);
        if (n + 4 < 144 && fq < 2) rr[k4] = *(const u32x4*)(Agg + (size_t)crow(n + 4) * 512 + tokidx * 16 + fq * 8);
        f32x4 d[2][4];
#pragma unroll
        for (int part = 0; part < 2; ++part)
#pragma unroll
            for (int st = 0; st < 4; ++st)
                d[part][st] = __builtin_amdgcn_mfma_f32_16x16x32_bf16(xa, yb[part][st], (f32x4){0.f, 0.f, 0.f, 0.f}, 0, 0, 0);
        asm volatile("s_nop 15\n\ts_nop 15" : "+v"(d[0][0]), "+v"(d[0][1]), "+v"(d[0][2]), "+v"(d[0][3]), "+v"(d[1][0]), "+v"(d[1][1]), "+v"(d[1][2]), "+v"(d[1][3]));
#pragma unroll
        for (int part = 0; part < 2; ++part)
#pragma unroll
            for (int st = 0; st < 4; ++st) if (part == 0) {
                float* bw = BU + (st * 16 + fr) * 36 + fq * 8;
                *(f32x4*)bw = (f32x4){d[0][st][0], d[1][st][0], d[0][st][1], d[1][st][1]};
                *(f32x4*)(bw + 4) = (f32x4){d[0][st][2], d[1][st][2], d[0][st][3], d[1][st][3]};
            }
        asm volatile("s_waitcnt lgkmcnt(0)" ::: "memory");
        {
            f32x4 b4[8];
#pragma unroll
            for (int q = 0; q < 8; ++q) b4[q] = *(const f32x4*)(BU + lane * 36 + q * 4);
#pragma unroll
            for (int t = 0; t < 16; ++t) {
                const f32x2_t Bt_ = {b4[t >> 1][(t & 1) * 2], b4[t >> 1][(t & 1) * 2 + 1]};
                const f32x2_t T_ = __builtin_elementwise_fma(Are, X, Bt_);
                f32x2_t Xs_ = {X[1], X[0]}; asm volatile("" : "+v"(Xs_));
                X = __builtin_elementwise_fma(Aimn, Xs_, T_);
                ((unsigned*)XB)[t * 68 + lane] = cvt_pk_bf16(X[0], X[1]);
            }
        }
        asm volatile("s_waitcnt lgkmcnt(0)" ::: "memory");
        if (n >= 16) {
            f32x4 y = (f32x4){0.f, 0.f, 0.f, 0.f};
#pragma unroll
            for (int kk = 0; kk < 4; ++kk) {
                const bf16x8 xf = *(const bf16x8*)(XB + fr * 136 + kk * 32 + fq * 8);
                y = __builtin_amdgcn_mfma_f32_16x16x32_bf16(xf, cb[kk], y, 0, 0, 0);
            }
            asm volatile("s_nop 15\n\ts_nop 15" : "+v"(y));
            const int row0 = crow(n) * 16;
#pragma unroll
            for (int r = 0; r < 4; ++r) { const int sp = fq * 4 + r, tk = dir ? 15 - sp : sp;
                p.yf[((size_t)dir * NL + row0 + tk) * 512 + g * 16 + fr] = f2bf(y[r]); }
        }
        asm volatile("s_waitcnt lgkmcnt(0)" ::: "memory");
      }
    }
}

__device__ __forceinline__ void phase_scans(const Params& p, float* lds) {
    const int bid = blockIdx.x, nb = gridDim.x;
    if (nb >= 256) {
        if (bid < 128) gla_chunk_unit(p, (unsigned char*)lds, bid);
        else {
            const int w = __builtin_amdgcn_readfirstlane(threadIdx.x >> 6), c = (bid - 128) * 8 + w;
            if (c & 1) s5_wave_chain<1>(p, c, (unsigned char*)lds + w * S5_WLDS); else s5_wave_chain<0>(p, c, (unsigned char*)lds + w * S5_WLDS);
        }
    } else {
        for (int u = bid; u < 128; u += nb) gla_chunk_unit(p, (unsigned char*)lds, u);
        __syncthreads();
        const int w = __builtin_amdgcn_readfirstlane(threadIdx.x >> 6);
        for (int c = bid * 8 + w; c < 1024; c += nb * 8) { if (c & 1) s5_wave_chain<1>(p, c, (unsigned char*)lds + w * S5_WLDS); else s5_wave_chain<0>(p, c, (unsigned char*)lds + w * S5_WLDS); }
    }
}

__device__ __forceinline__ void lr_columns(const Params& p, unsigned char* lds8) {
    const int tid = threadIdx.x, lane = tid & 63, w = tid >> 6, fr = lane & 15, fq = lane >> 4;
    bf16_t* W = (bf16_t*)lds8;
    const bool split = gridDim.x == 256;
    if (split && blockIdx.x < 128) return;
    const int wg = split ? blockIdx.x - 128 : blockIdx.x, nwg = split ? 128 : gridDim.x;
    __syncthreads();
    for (int i = tid; i < 32 * 128; i += NT) { const int n = i >> 7, c = i & 127; *(u32x4*)(W + n * 1032 + c * 8) = *(const u32x4*)(p.w_inT + (size_t)(WC_LR + n) * DM + c * 8); }
    __syncthreads();
    for (int t = wg * NWAVES + w; t < NR / 16; t += nwg * NWAVES) {
        const int tok0 = t * 16;
        f32x4 d0 = (f32x4){0.f, 0.f, 0.f, 0.f}, d1 = d0;
        const bf16_t* arow = p.hx + (size_t)(tok0 + fr) * DM + fq * 8;
#pragma unroll 8
        for (int ks = 0; ks < 32; ++ks) {
            const bf16x8 a = *(const bf16x8*)(arow + ks * 32);
            const bf16x8 b0 = *(const bf16x8*)(W + fr * 1032 + ks * 32 + fq * 8), b1 = *(const bf16x8*)(W + (16 + fr) * 1032 + ks * 32 + fq * 8);
            d0 = __builtin_amdgcn_mfma_f32_16x16x32_bf16(b0, a, d0, 0, 0, 0);
            d1 = __builtin_amdgcn_mfma_f32_16x16x32_bf16(b1, a, d1, 0, 0, 0);
        }
        asm volatile("s_nop 15\n\ts_nop 15" : "+v"(d0), "+v"(d1));
        bf16_t* o = p.proj + (size_t)(tok0 + fr) * DINP + P_LRF + fq * 4;
        *(u32x2*)o = (u32x2){cvt_pk_bf16(d0[0], d0[1]), cvt_pk_bf16(d0[2], d0[3])};
        *(u32x2*)(o + 16) = (u32x2){cvt_pk_bf16(d1[0], d1[1]), cvt_pk_bf16(d1[2], d1[3])};
    }
    __syncthreads();
}

__device__ __forceinline__ void phase_mix(const Params& p) {
    const int lane = threadIdx.x & 63, wave = threadIdx.x >> 6;
    const int stride = gridDim.x * NWAVES;
    int r = blockIdx.x * NWAVES + wave;
    if (r >= NL) return;
    const float4 gn0 = *(const float4*)(p.gnorm_g + (lane & 15) * 8), gn1 = *(const float4*)(p.gnorm_g + (lane & 15) * 8 + 4);
    const float4 sd0 = *(const float4*)(p.s5_d + lane * 8), sd1 = *(const float4*)(p.s5_d + lane * 8 + 4);
    const float gn[8] = {gn0.x, gn0.y, gn0.z, gn0.w, gn1.x, gn1.y, gn1.z, gn1.w}, sd[8] = {sd0.x, sd0.y, sd0.z, sd0.w, sd1.x, sd1.y, sd1.z, sd1.w};
    u32x4 c[6], n[6];
#define MIX_LOAD(dst, row) do { const size_t _r = (size_t)(row); \
        dst[0] = *(const u32x4*)(p.of + _r * 512 + lane * 8); dst[1] = *(const u32x4*)(p.of + ((size_t)NL + _r) * 512 + lane * 8); \
        dst[2] = *(const u32x4*)(p.proj + _r * DINP + P_G + lane * 8); \
        dst[3] = *(const u32x4*)(p.yf + _r * 512 + lane * 8); dst[4] = *(const u32x4*)(p.yf + ((size_t)NL + _r) * 512 + lane * 8); \
        dst[5] = *(const u32x4*)(p.Ag + ((size_t)(lane >> 1) * S5_ROWS + (_r >> 4)) * 512 + (_r & 15) * 16 + (lane & 1) * 8); } while (0)
    MIX_LOAD(c, r);
    for (;;) {
        const int rn = r + stride; const bool has = rn < NL;
        if (has) MIX_LOAD(n, rn);
        float o[8], g[8]; float ss = 0.f;
#pragma unroll
        for (int q = 0; q < 4; ++q) {
            o[2 * q] = bflo(c[0][q]) + bflo(c[1][q]); o[2 * q + 1] = bfhi(c[0][q]) + bfhi(c[1][q]);
            g[2 * q] = bflo(c[2][q]); g[2 * q + 1] = bfhi(c[2][q]);
            ss += o[2 * q] * o[2 * q] + o[2 * q + 1] * o[2 * q + 1];
        }
        ss += __shfl_xor(ss, 1); ss += __shfl_xor(ss, 2); ss += __shfl_xor(ss, 4); ss += __shfl_xor(ss, 8);
        const float rstd = rsqrtf(ss * (1.0f / 128.0f) + EPS);
        u32x4 mo, zo;
#pragma unroll
        for (int q = 0; q < 4; ++q) {
            const float m0 = o[2 * q] * rstd * gn[2 * q] * silu_fast(g[2 * q]), m1 = o[2 * q + 1] * rstd * gn[2 * q + 1] * silu_fast(g[2 * q + 1]);
            mo[q] = cvt_pk_bf16(m0, m1);
            const float y0 = bflo(c[3][q]) + bflo(c[4][q]) + sd[2 * q] * bflo(c[5][q]), y1 = bfhi(c[3][q]) + bfhi(c[4][q]) + sd[2 * q + 1] * bfhi(c[5][q]);
            zo[q] = cvt_pk_bf16(gelu_tanh_fast(y0), gelu_tanh_fast(y1));
        }
        *(u32x4*)(p.mix + (size_t)r * DM + lane * 8) = mo;
        *(u32x4*)(p.z + (size_t)r * 512 + lane * 8) = zo;
        if (!has) break;
        r = rn;
#pragma unroll
        for (int q = 0; q < 6; ++q) c[q] = n[q];
    }
#undef MIX_LOAD
}

__device__ __forceinline__ void phase_route(const Params& p, int* lm) {
    int* hist = lm; int* gbase = lm + 256; int* st_e = lm + 512; int* st_r = st_e + 1024; float* st_w = (float*)(st_r + 1024);
    const int tid = threadIdx.x;
    const int lane = threadIdx.x & 63, wave = threadIdx.x >> 6;
    const float* scores = p.scores;
    const float4 rb = *(const float4*)(p.router_b + lane * 4);
    for (int tb = blockIdx.x * 128; tb < NL; tb += gridDim.x * 128) {
    __syncthreads();
    if (tid < 256) hist[tid] = 0;
    __syncthreads();
    for (int tl = wave; tl < 128; tl += NWAVES) {
        const int t = tb + tl;
        const float4 sc4 = *(const float4*)(scores + (size_t)t * 256 + lane * 4);
        const float sc[4] = {sc4.x, sc4.y, sc4.z, sc4.w};
        float bv[4] = {sc4.x + rb.x, sc4.y + rb.y, sc4.z + rb.z, sc4.w + rb.w};
        float m1 = -INFINITY, m2 = -INFINITY;
#pragma unroll
        for (int j = 0; j < 4; ++j) { const float v = bv[j]; if (v > m1) { m2 = m1; m1 = v; } else if (v > m2) m2 = v; }
#pragma unroll
        for (int o = 1; o < 8; o <<= 1) {
            const float o1 = __shfl_xor(m1, o), o2 = __shfl_xor(m2, o);
            const float n1 = fmaxf(m1, o1), n2 = fmaxf(fminf(m1, o1), fmaxf(m2, o2));
            m1 = n1; m2 = n2;
        }
        const float gs = m1 + m2;
        const int myg = lane >> 3;
        int rank = 0;
#pragma unroll
        for (int j = 0; j < 8; ++j) { const float og = __shfl(gs, j * 8); rank += (og > gs || (og == gs && j < myg)) ? 1 : 0; }
        const bool sel = rank < 4;
#pragma unroll
        for (int j = 0; j < 4; ++j) if (!sel) bv[j] = -INFINITY;
        int my_e = -1; float my_s = 0.f; float ssum = 0.f;
#pragma unroll
        for (int k = 0; k < TOPK; ++k) {
            float bvv = bv[0]; int bi = 0;
#pragma unroll
            for (int j = 1; j < 4; ++j) if (bv[j] > bvv) { bvv = bv[j]; bi = j; }
            int be = lane * 4 + bi;
            float bs = (bi == 0) ? sc[0] : (bi == 1) ? sc[1] : (bi == 2) ? sc[2] : sc[3];
#pragma unroll
            for (int o = 1; o < 64; o <<= 1) {
                const float ov = __shfl_xor(bvv, o); const int oe = __shfl_xor(be, o); const float os = __shfl_xor(bs, o);
                if (ov > bvv || (ov == bvv && oe < be)) { bvv = ov; be = oe; bs = os; }
            }
            if ((be >> 2) == lane) {
#pragma unroll
                for (int j = 0; j < 4; ++j) if ((be & 3) == j) bv[j] = -INFINITY;
            }
            ssum += bs;
            if (lane == k) { my_e = be; my_s = bs; }
        }
        if (lane < TOPK) {
            st_e[tl * 8 + lane] = my_e; st_r[tl * 8 + lane] = atomicAdd(&hist[my_e], 1); st_w[tl * 8 + lane] = my_s / ssum * 2.5f;
        }
    }
    __syncthreads();
    if (tid < 256) { const int h = hist[tid]; gbase[tid] = h ? atomicAdd(&p.cnt[tid], h) : 0; }
    __syncthreads();
    for (int i = tid; i < 1024; i += NT) {
        const int e = st_e[i], pos = gbase[e] + st_r[i], t = tb + (i >> 3);
        p.ltok[(size_t)e * CAP + pos] = (unsigned short)t;
        p.tinfo[(size_t)tb * 8 + i] = ((unsigned)e << 16) | (unsigned)pos;
        p.tw[(size_t)tb * 8 + i] = st_w[i];
    }
    }
}

__device__ __forceinline__ void expert_tables(const Params& p, int* cntl, int* offs, int* toff, int ncolt) {
    const int tid = threadIdx.x;
    __syncthreads();
    if (tid < 256) cntl[tid] = p.cnt[tid];
    __syncthreads();
    if (tid < 256) {
        int s = 0, ts = 0;
        for (int e = 0; e < tid; ++e) { const int c = cntl[e]; s += c; ts += ((c + 255) >> 8) * ncolt; }
        offs[tid] = s; toff[tid] = ts;
        if (tid == 255) { const int c = cntl[255]; offs[256] = s + c; toff[256] = ts + ((c + 255) >> 8) * ncolt; }
    }
    __syncthreads();
}

__device__ __forceinline__ void phase_final(const Params& p, int* lmisc) {
    const int lane = threadIdx.x & 63, wave = threadIdx.x >> 6;
    int* cntl = lmisc; int* offs = lmisc + 256; int* toff = offs + 260;
    expert_tables(p, cntl, offs, toff, 1);
    for (int r = blockIdx.x * NWAVES + wave; r < NL; r += gridDim.x * NWAVES) {
        const int b = r / SEQ;
        const bf16_t* x1 = p.yf + (size_t)r * DM;
        const float* g2 = p.modv + b * 6144 + 5120;
        unsigned info = 0u; float wk = 0.f;
        if (lane < 8) { info = p.tinfo[(size_t)r * 8 + lane]; wk = p.tw[(size_t)r * 8 + lane]; }
        float a[16];
#pragma unroll
        for (int i = 0; i < 16; ++i) a[i] = 0.f;
#pragma unroll
        for (int k = 0; k < 8; ++k) {
            const unsigned inf = __shfl(info, k); const float w = __shfl(wk, k) * (1.0f / YB_SCALE);
            const unsigned char* row = (const unsigned char*)p.yb + (size_t)(offs[inf >> 16] + (int)(inf & 0xFFFFu)) * DM;
            const u32x4 v = *(const u32x4*)(row + lane * 16);
#pragma unroll
            for (int q = 0; q < 4; ++q) {
                const f32x2_t lo = __builtin_amdgcn_cvt_pk_f32_fp8((int)v[q], false), hi = __builtin_amdgcn_cvt_pk_f32_fp8((int)v[q], true);
                a[4 * q] = fmaf(w, lo[0], a[4 * q]); a[4 * q + 1] = fmaf(w, lo[1], a[4 * q + 1]); a[4 * q + 2] = fmaf(w, hi[0], a[4 * q + 2]); a[4 * q + 3] = fmaf(w, hi[1], a[4 * q + 3]);
            }
        }
        {
            const u32x4 v = *(const u32x4*)((const unsigned char*)p.hx + (size_t)r * DM + lane * 16);
#pragma unroll
            for (int q = 0; q < 4; ++q) {
                const f32x2_t lo = __builtin_amdgcn_cvt_pk_f32_fp8((int)v[q], false), hi = __builtin_amdgcn_cvt_pk_f32_fp8((int)v[q], true);
                a[4 * q] = fmaf(0.125f, lo[0], a[4 * q]); a[4 * q + 1] = fmaf(0.125f, lo[1], a[4 * q + 1]); a[4 * q + 2] = fmaf(0.125f, hi[0], a[4 * q + 2]); a[4 * q + 3] = fmaf(0.125f, hi[1], a[4 * q + 3]);
            }
        }
        float ss = 0.f;
#pragma unroll
        for (int h = 0; h < 4; ++h) {
            const int col = lane * 16 + 4 * h;
            const u32x2 xw = *(const u32x2*)(x1 + col); const float4 xv = make_float4(bflo(xw[0]), bfhi(xw[0]), bflo(xw[1]), bfhi(xw[1])), gg = *(const float4*)(g2 + col);
            float* aa = a + 4 * h;
            aa[0] = xv.x + gg.x * aa[0]; aa[1] = xv.y + gg.y * aa[1]; aa[2] = xv.z + gg.z * aa[2]; aa[3] = xv.w + gg.w * aa[3];
            ss += aa[0] * aa[0] + aa[1] * aa[1] + aa[2] * aa[2] + aa[3] * aa[3];
        }
        ss = wave_sum(ss);
        const float rstd = rsqrtf(ss * (1.0f / DM) + EPS);
#pragma unroll
        for (int h = 0; h < 4; ++h) {
            const int col = lane * 16 + 4 * h;
            const float4 gg = *(const float4*)(p.fnorm_g + col);
            const float* aa = a + 4 * h;
            float4 o; o.x = aa[0] * rstd * gg.x; o.y = aa[1] * rstd * gg.y; o.z = aa[2] * rstd * gg.z; o.w = aa[3] * rstd * gg.w;
            *(float4*)(p.out + (size_t)r * DM + col) = o;
        }
    }
}

__global__ void __launch_bounds__(NT, 2) mega(Params p) {
    extern __shared__ __attribute__((aligned(16))) unsigned char lds_raw[];
    float* lds = (float*)lds_raw;
    LAS unsigned char* ldsl = (LAS unsigned char*)lds_raw;
    float* lmisc = (float*)(lds_raw + STAGE_BYTES);
    volatile LAS unsigned* xbw = (volatile LAS unsigned*)(ldsl + LDS_BYTES - 16);
    if (threadIdx.x == 0) { xbw[0] = 0u; xbw[1] = 0u; xbw[2] = 0u; xbw[3] = 0u; }
    __syncthreads();
    XcdBarrier bar; bar.bar = p.bar; bar.x = 0; bar.st = xbw;
    const bool fused = (p.ph_hi - p.ph_lo) > 1;
    if (fused) bar = xcd_barrier_post(p.bar, xbw);
    const int bid = blockIdx.x, nb = gridDim.x;
#define PH(i) (p.ph_lo <= (i) && (i) < p.ph_hi)
#define SEAM(i) if (fused && p.ph_lo <= (i) && (i) + 1 < p.ph_hi) xcd_barrier(bar)

    if (PH(0)) phase_prologue(p, lds, 0);
    SEAM(0);
    if (PH(1)) { phase_norm_mod(p, 0); __syncthreads(); phase_prologue(p, lds, 1); }
    SEAM(1);
    if (PH(2)) {
        g8::DenseSched S; S.init(p.hx, p.w_inT, DM * 2, DM * 2, NR, 2048, nb, bid);
        g8::EpiProj E; E.O = p.proj; E.AG = p.Ag;
        g8::gemm_phase<g8::EpiProj, g8::DenseSched, 0>(ldsl, DM, DM * 2, DM * 2, S, E);
        lr_columns(p, (unsigned char*)lds);
    }
    SEAM(2);
    if (PH(3)) phase_scans(p, lds);
    SEAM(3);
    if (PH(4)) phase_mix(p);
    SEAM(4);
    if (PH(5)) {
        g8::DenseSched S; S.init(p.z, p.gluT, 512 * 2, 512 * 2, NL, 512, nb, bid);
        g8::EpiGlu E; E.Z = p.z; E.MIX = p.mix; E.bias = p.glu_b;
        g8::gemm_phase<g8::EpiGlu, g8::DenseSched, 0>(ldsl, 512, 512 * 2, 512 * 2, S, E);
    }
    SEAM(5);
    if (PH(6)) {
        g8::DenseSched S; S.init(p.mix, p.w_outT, DM * 2, DM * 2, NL, DM, nb, bid);
        g8::EpiOut E; E.X = p.x; E.X1 = p.yf; E.modv = p.modv;
        g8::gemm_phase<g8::EpiOut, g8::DenseSched, 0>(ldsl, DM, DM * 2, DM * 2, S, E);
    }
    SEAM(6);
    if (PH(7)) phase_norm_mod(p, 1);
    SEAM(7);
    if (PH(8)) {
        {
            g8::DenseSched S; S.init(p.hx, p.routerT3, DM * 2, 3072 * 2, NL, 256, nb, bid);
            g8::EpiScores E; E.O = p.scores;
            g8::gemm_phase<g8::EpiScores, g8::DenseSched, 0>(ldsl, DM, DM * 2, 3072 * 2, S, E);
        }
        __syncthreads();
        {
            g8::DenseSched S;
            S.init(p.hx, p.shguT, DM * 2, DM * 2, NL, 512, nb, bid);
            g8::EpiGateUp E; E.O = p.shhid;
            g8::gemm_phase<g8::EpiGateUp, g8::DenseSched, 0>(ldsl, DM, DM * 2, DM * 2, S, E);
        }
    }
    SEAM(8);
    if (PH(9)) phase_route(p, (int*)lmisc);
    SEAM(9);
    if (PH(10)) {
        int* cntl = (int*)lmisc; int* offs = cntl + 256; int* toff = offs + 260;
        expert_tables(p, cntl, offs, toff, 2);
        {
            g8::ExpertSched S;
            S.toff = (const LAS int*)toff; S.offs = (const LAS int*)offs; S.cntl = (const LAS int*)cntl;
            S.gbase = (const char*)p.of; S.lda = DM; S.ltok = p.ltok; S.Ad = nullptr;
            S.Bt = (const char*)p.eguT; S.bexp = (size_t)512 * DM; S.ldb = DM;
            S.ncolt = 2; S.G = nb; S.c = (bid & 7) * (nb >> 3) + (bid >> 3); S.total = __builtin_amdgcn_readfirstlane(toff[256]);
            g8::EpiExpGU E; E.O = p.hid; E.offs = S.offs; E.cntl = S.cntl;
            g8::gemm_phase<g8::EpiExpGU, g8::ExpertSched, 0, true, 4>(ldsl, DM / 2, DM, DM, S, E);
        }
    }
    SEAM(10);
    if (PH(11)) {
        int* cntl = (int*)lmisc; int* offs = cntl + 256; int* toff = offs + 260;
        expert_tables(p, cntl, offs, toff, 4);
        g8::ExpertSched S;
        S.toff = (const LAS int*)toff; S.offs = (const LAS int*)offs; S.cntl = (const LAS int*)cntl;
        S.gbase = nullptr; S.lda = 256; S.ltok = p.ltok; S.Ad = (const char*)p.hid;
        S.Bt = (const char*)p.edT; S.bexp = (size_t)DM * 256; S.ldb = 256;
        S.ncolt = 4; S.G = nb; S.c = (bid & 7) * (nb >> 3) + (bid >> 3); S.total = __builtin_amdgcn_readfirstlane(toff[256]);
        g8::EpiExpDown E; E.O = p.yb; E.offs = S.offs; E.cntl = S.cntl;
        g8::gemm_phase<g8::EpiExpDown, g8::ExpertSched, 0, false, 2>(ldsl, 128, 256, 256, S, E);
        __syncthreads();
        {
            g8::DenseSched S2; S2.init(p.shhid, p.shdT, 256, 256, NL, DM, nb, bid);
            g8::EpiBf16 E2; E2.O = p.hx;
            g8::gemm_phase<g8::EpiBf16, g8::DenseSched, 0, false, 1>(ldsl, 128, 256, 256, S2, E2);
        }
    }
    SEAM(11);
    if (PH(12)) phase_final(p, (int*)lmisc);
}

extern "C" void kernel_launch(void* const* d_in, const int* in_sizes, int n_in, void* d_out, int out_size, void* d_ws, size_t ws_size,
                              hipStream_t stream) {
    static int grid = 0;
    if (grid == 0) {
        int dev = 0, cus = 0, per_cu = 0;
        (void)hipGetDevice(&dev);
        (void)hipDeviceGetAttribute(&cus, hipDeviceAttributeMultiprocessorCount, dev);
        (void)hipFuncSetAttribute((const void*)mega, hipFuncAttributeMaxDynamicSharedMemorySize, LDS_BYTES);
        (void)hipOccupancyMaxActiveBlocksPerMultiprocessor(&per_cu, (const void*)mega, NT, LDS_BYTES);
        (void)hipGetLastError();
        grid = cus;
    }
    size_t off = 0;
    auto carve = [&](size_t bytes) { size_t o = off; off += (bytes + 255) & ~(size_t)255; return (char*)d_ws + o; };
    Params p{};
    const float** ins = (const float**)&p;
    for (int i = 0; i < 39; ++i) ins[i] = (const float*)d_in[i];
    p.out = (float*)d_out;
    p.bar = (unsigned*)carve(XCD_BAR_WORDS * 4);
    p.cnt = (int*)carve(256 * 4);
    const size_t zero_bytes = off;
    p.modv = (float*)carve((size_t)17 * 6144 * 4);
    p.w_inT = (bf16_t*)carve((size_t)2304 * DM * 2);
    p.w_outT = (bf16_t*)carve((size_t)DM * DM * 2);
    p.gluT = (bf16_t*)carve((size_t)512 * 512 * 2);
    p.routerT3 = (bf16_t*)carve((size_t)256 * 3072 * 2);
    p.shguT = (bf16_t*)carve((size_t)512 * DM * 2);
    p.shdT = (bf16_t*)carve((size_t)DM * 256 * 2);
    p.hx = (bf16_t*)carve((size_t)NL * 2048 * 2);
    p.scores = (float*)carve((size_t)NL * 256 * 4);
    p.shhid = (bf16_t*)carve((size_t)NL * 256 * 2);
    p.ltok = (unsigned short*)carve((size_t)NE * CAP * 2);
    p.tinfo = (unsigned*)carve((size_t)NL * 8 * 4);
    p.tw = (float*)carve((size_t)NL * 8 * 4);
    p.edT = (bf16_t*)carve((size_t)NE * DM * 256 * 2);
    p.eguT = (bf16_t*)carve((size_t)NE * 512 * DM * 2);
    char* arena = carve(0);
    p.yb = (bf16_t*)p.eguT;
    {
        size_t a = 0;
        auto acarve = [&](size_t bytes) { size_t o = a; a += (bytes + 255) & ~(size_t)255; return arena + o; };
        p.proj = (bf16_t*)acarve((size_t)NR * DINP * 2);
        p.of = (bf16_t*)acarve((size_t)2 * NL * 512 * 2);
        p.yf = (bf16_t*)acarve((size_t)2 * NL * 512 * 2);
        p.Ag = (bf16_t*)acarve((size_t)32 * S5_ROWS * 512 * 2);
        p.mix = (bf16_t*)acarve((size_t)NL * DM * 2);
        p.z = (bf16_t*)acarve((size_t)NL * 512 * 2);
        const size_t early = a;
        const size_t yb_tail = (size_t)(NL * 8 + 1) * DM * 2 - (size_t)NE * 512 * DM * 2;
        p.hid = (bf16_t*)(arena + ((yb_tail + 255) & ~(size_t)255));
        const size_t late = ((yb_tail + 255) & ~(size_t)255) + (size_t)(NL * 8 + 256) * 256 * 2;
        (void)carve(early > late ? early : late);
    }
    if (off > ws_size) { fprintf(stderr, "kernel_launch: workspace too small: need %zu have %zu\n", off, ws_size); return; }
    (void)hipMemsetAsync(d_ws, 0, zero_bytes, stream);
#if FUSED
    p.ph_lo = 0; p.ph_hi = N_PHASES;
    hipLaunchKernelGGL(mega, dim3(grid), dim3(NT), LDS_BYTES, stream, p);
#else
    for (int i = 0; i < N_PHASES; ++i) {
        p.ph_lo = i; p.ph_hi = i + 1;
        hipLaunchKernelGGL(mega, dim3(grid), dim3(NT), LDS_BYTES, stream, p);
    }
#endif
}
```

```cpp
#include <hip/hip_runtime.h>
#include <stdint.h>
#include <stdio.h>

#define DM 1024
#define NB 16
#define SEQ 2048
#define CTX 256
#define NL (NB * SEQ)
#define NCX (NB * CTX)
#define NR (NL + NCX)
#define DIN 2080
#define S_LR 1536
#define S_U 1568
#define P_Q 0
#define P_K 256
#define P_V 512
#define P_G 1024
#define WC_U 1536
#define WC_LR 2048
#define P_LRF 1536
#define P_LRB 1552
#define DINP 1568
#define S5_ROWS 2304
#define NE 256
#define TOPK 8
#define CAP 32768
#define EPS 1e-6f

#define NT 512
#define NWAVES 8
#define STAGE_BYTES 131072
#define LDS_BYTES (STAGE_BYTES + 16384)
#define N_PHASES 13
#define S5_WLDS 14592
#ifndef FUSED
#define FUSED 1
#endif

typedef unsigned short bf16_t;
typedef short bf16x8 __attribute__((ext_vector_type(8)));
typedef float f32x4 __attribute__((ext_vector_type(4)));
typedef unsigned u32x4 __attribute__((ext_vector_type(4)));
typedef unsigned u32x2 __attribute__((ext_vector_type(2)));
#define LAS __attribute__((address_space(3)))

#define XB_TMO      128
#define XB_XCNT(j)  (256  + 64 * (j))
#define XB_XSUB(j)  (1280 + 64 * (j))
#define XB_XGEN(j)  (2304 + 64 * (j))
#define XB_TOP      3328
#define XB_TOPGEN   3392
#define XCD_BAR_WORDS 3456
#define XB_SPIN_CAP (1u << 18)

__device__ __forceinline__ unsigned xb_ld(unsigned* p)              { return __hip_atomic_load(p, __ATOMIC_RELAXED, __HIP_MEMORY_SCOPE_AGENT); }
__device__ __forceinline__ unsigned xb_add(unsigned* p, unsigned v) { return __hip_atomic_fetch_add(p, v, __ATOMIC_RELAXED, __HIP_MEMORY_SCOPE_AGENT); }
__device__ __forceinline__ unsigned xb_xcc_id() { return (unsigned)__builtin_amdgcn_s_getreg((3 << 11) | 20) & 0xFu; }
#define XB_SPIN(cond, bar) do { unsigned _sp = 0; while (cond) { __builtin_amdgcn_s_sleep(1); \
    if ((++_sp & 255u) == 0u) { if (xb_ld(&(bar)[XB_TMO])) break; if (_sp > XB_SPIN_CAP) { atomicAdd(&(bar)[XB_TMO], 1u); break; } } } } while (0)

struct XcdBarrier { unsigned* bar; unsigned x; volatile LAS unsigned* st; };

__device__ __forceinline__ XcdBarrier xcd_barrier_post(unsigned* bar, volatile LAS unsigned* st) {
    XcdBarrier b; b.bar = bar; b.x = xb_xcc_id(); b.st = st;
    if (threadIdx.x == 0) (void)xb_add(&bar[XB_XCNT(b.x)], 1u);
    return b;
}
__device__ __forceinline__ void xcd_barrier_complete(unsigned* bar, unsigned x, unsigned& nloc, unsigned& nx) {
    const unsigned G = gridDim.x * gridDim.y * gridDim.z;
    unsigned sum, cnt, mine, sp = 0u;
    for (;;) {
        sum = 0u; cnt = 0u; mine = 0u;
#pragma unroll
        for (unsigned j = 0; j < 16; ++j) { const unsigned c = xb_ld(&bar[XB_XCNT(j)]); sum += c; cnt += (c > 0u) ? 1u : 0u; mine = (j == x) ? c : mine; }
        if (sum == G) break;
        __builtin_amdgcn_s_sleep(1);
        if ((++sp & 255u) == 0u) { if (xb_ld(&bar[XB_TMO])) break; if (sp > XB_SPIN_CAP) { atomicAdd(&bar[XB_TMO], 1u); break; } }
    }
    nloc = mine > 0u ? mine : 1u; nx = cnt > 0u ? cnt : 1u;
}
__device__ __forceinline__ void xcd_barrier(const XcdBarrier& b) {
    asm volatile("s_waitcnt vmcnt(0)" ::: "memory");
    __syncthreads();
    if (threadIdx.x == 0) {
        unsigned* bar = b.bar;
        __builtin_amdgcn_s_waitcnt(0);
        unsigned nloc = b.st[0], nx = b.st[1];
        if (nloc == 0u) { xcd_barrier_complete(bar, b.x, nloc, nx); b.st[0] = nloc; b.st[1] = nx; }
        const unsigned old = xb_add(&bar[XB_XSUB(b.x)], 1u);
        const unsigned gen = old / nloc;
        if (old + 1u == (gen + 1u) * nloc) {
            __builtin_amdgcn_fence(__ATOMIC_RELEASE, "agent");
            asm volatile("s_waitcnt vmcnt(0)" ::: "memory");
            const unsigned og = xb_add(&bar[XB_TOP], 1u);
            const unsigned tg = og / nx;
            if (og + 1u == (tg + 1u) * nx) xb_add(&bar[XB_TOPGEN], 1u);
            else XB_SPIN(xb_ld(&bar[XB_TOPGEN]) == tg, bar);
            __builtin_amdgcn_fence(__ATOMIC_ACQUIRE, "agent");
            xb_add(&bar[XB_XGEN(b.x)], 1u);
            asm volatile("s_waitcnt vmcnt(0)" ::: "memory");
        } else {
            XB_SPIN(xb_ld(&bar[XB_XGEN(b.x)]) == gen, bar);
            __builtin_amdgcn_fence(__ATOMIC_ACQUIRE, "agent");
            asm volatile("s_waitcnt vmcnt(0)" ::: "memory");
        }
    }
    __syncthreads();
}

struct Params {
    const float *x, *c, *ctx, *c_ctx, *ada_w, *ada_b, *norm1_g, *norm2_g, *w_in,
        *wa_f, *ba_f, *wa_b, *ba_b, *gnorm_g,
        *lam_re_f, *lam_im_f, *lstep_f, *lam_re_b, *lam_im_b, *lstep_b,
        *b_re, *b_im, *c_re_f, *c_im_f, *c_re_b, *c_im_b, *s5_d, *glu_w, *glu_b,
        *w_out, *router_w, *router_b, *ew_gate, *ew_up, *ew_down, *sw_gate, *sw_up, *sw_down, *fnorm_g;
    float* out;
    unsigned* bar;
    int* cnt;
    float* modv;
    bf16_t* w_inT;
    bf16_t* w_outT;
    bf16_t* gluT;
    bf16_t* routerT3;
    bf16_t* shguT;
    bf16_t* shdT;
    bf16_t* hx;
    bf16_t* proj;
    bf16_t* of;
    bf16_t* yf;
    bf16_t* Ag;
    bf16_t* mix;
    bf16_t* z;
    float* scores;
    bf16_t* shhid;
    bf16_t* eguT;
    bf16_t* edT;
    bf16_t* hid;
    bf16_t* yb;
    unsigned short* ltok;
    unsigned* tinfo;
    float* tw;
    int ph_lo, ph_hi;
};

__device__ __forceinline__ float sigmoidf_(float v) { return 1.0f / (1.0f + expf(-v)); }
__device__ __forceinline__ float siluf_(float v) { return v / (1.0f + expf(-v)); }
__device__ __forceinline__ float logsigmoidf_(float v) { return fminf(v, 0.0f) - log1pf(expf(-fabsf(v))); }
__device__ __forceinline__ float gelu_tanhf_(float v) { return 0.5f * v * (1.0f + tanhf(0.7978845608028654f * (v + 0.044715f * v * v * v))); }
__device__ __forceinline__ float sigmoid_fast(float v) { return __builtin_amdgcn_rcpf(1.0f + __builtin_amdgcn_exp2f(-v * 1.4426950408889634f)); }
__device__ __forceinline__ float silu_fast(float v) { return v * sigmoid_fast(v); }
__device__ __forceinline__ float gelu_tanh_fast(float v) { return v * sigmoid_fast(1.5957691216057308f * (v + 0.044715f * v * v * v)); }
__device__ __forceinline__ float wave_sum(float v) {
#pragma unroll
    for (int o = 32; o > 0; o >>= 1) v += __shfl_xor(v, o);
    return v;
}
__device__ __forceinline__ float bf2f(bf16_t b) { return __uint_as_float(((unsigned)b) << 16); }
__device__ __forceinline__ float bflo(unsigned w) { return __uint_as_float(w << 16); }
__device__ __forceinline__ float bfhi(unsigned w) { return __uint_as_float(w & 0xFFFF0000u); }
__device__ __forceinline__ bf16_t f2bf(float f) { unsigned u = __float_as_uint(f); u += 0x7FFFu + ((u >> 16) & 1u); return (bf16_t)(u >> 16); }
typedef __bf16 bf16x2_t __attribute__((ext_vector_type(2)));
typedef float f32x2_t __attribute__((ext_vector_type(2)));
__device__ __forceinline__ unsigned cvt_pk_bf16(float lo, float hi) { const f32x2_t f = {lo, hi}; return __builtin_bit_cast(unsigned, __builtin_convertvector(f, bf16x2_t)); }

namespace g8 {
constexpr int BM = 256, BK = 64, HALF = 128, HTB = HALF * BK * 2, NXCD = 8, WGM = 8;
__device__ __forceinline__ int lds_byte(int r, int c) { const int st = (r >> 4) * 2 + (c >> 5), rr = r & 15, cc = c & 31, ob = rr * 64 + cc * 2; return st * 1024 + (ob ^ (((ob >> 9) & 1) << 5)); }
__device__ __forceinline__ void stage_rc(int b, int& R, int& C) { const int st = b / 1024, sb = b % 1024, swz = sb ^ (((sb >> 9) & 1) << 5); R = (st >> 1) * 16 + swz / 64; C = (st & 1) * 32 + (swz % 64) / 2; }
__device__ __forceinline__ int perm32(int rho) { const int n = rho >> 4, i = rho & 15; return 8 * (i >> 2) + 4 * n + (i & 3); }

struct Unit { const char* a; const char* b; int pm, pn, e, rows; };

struct DenseSched {
    const char* A; const char* Bt; unsigned lda, ldb; int nM, nN, nwg, G, c;
    __device__ __forceinline__ void init(const void* A_, const void* Bt_, unsigned lda_, unsigned ldb_, int M, int N, int G_, int c_) {
        A = (const char*)A_; Bt = (const char*)Bt_; lda = lda_; ldb = ldb_; nM = M / BM; nN = N / BM; nwg = nM * nN; G = G_; c = c_; }
    __device__ __forceinline__ bool next(int i, Unit& u) const {
        if (c < 0) return false;
        const long L = (long)i * G + c; if (L >= nwg) return false;
        int wgid = (int)L; { const int q = nwg / NXCD, r = nwg % NXCD, xcd = wgid % NXCD, off = wgid / NXCD; wgid = (xcd < r ? xcd * (q + 1) : r * (q + 1) + (xcd - r) * q) + off; }
        const int nig = WGM * nN, gid = wgid / nig, fm = gid * WGM, gsz = (nM - fm) < WGM ? (nM - fm) : WGM;
        u.pm = fm + ((wgid % nig) % gsz); u.pn = (wgid % nig) / gsz; u.e = 0; u.rows = BM;
        u.a = A + (size_t)u.pm * BM * lda; u.b = Bt + (size_t)u.pn * BM * ldb;
        return true;
    }
};

typedef int v8i_t __attribute__((ext_vector_type(8)));
typedef long v2l_t __attribute__((ext_vector_type(2)));
template <class Epi, class Sched, int KWRAP, bool GATHER = false, int FP8 = 0>
__device__ __forceinline__ void gemm_phase(LAS unsigned char* lds, const int K, const unsigned lda, const unsigned ldb, const Sched& S, const Epi& E) {
    const int tid = threadIdx.x, wid = __builtin_amdgcn_readfirstlane(tid >> 6), lane = tid & 63, wr = wid >> 2, wc = wid & 3, fr = lane & 15, fq = lane >> 4;
    const int nt = K / BK;
    unsigned voffA[2], voffB[2]; int rA[2]; unsigned cA2[2];
#pragma unroll
    for (int i = 0; i < 2; ++i) { int R, C; stage_rc(tid * 16 + i * 8192, R, C); const int Rb = Epi::PERM ? ((R & ~31) + perm32(R & 31)) : R;
        voffA[i] = (unsigned)R * lda + (unsigned)C * 2u; voffB[i] = (unsigned)Rb * ldb + (unsigned)C * 2u; rA[i] = R; cA2[i] = (unsigned)C * 2u; }
    unsigned gc[2][2], gn[2][2];
    const size_t kstep = (size_t)(BK * 2);
    const size_t hstepA = (size_t)HALF * lda, hstepB = (size_t)HALF * ldb;
    const unsigned ldsw = (unsigned)wid * 1024u;
    const int aoff = lds_byte(wr * 64 + fr, fq * 8), boff = lds_byte(wc * 32 + fr, fq * 8);
#define G8_SA(b, h) (((b) * 2 + (h)) * HTB)
#define G8_SB(b, h) ((4 + (b) * 2 + (h)) * HTB)
#define G8_STAGE(bufoff, gbase, voff) do { _Pragma("unroll") for (int _i = 0; _i < 2; ++_i) \
        __builtin_amdgcn_global_load_lds((const unsigned*)((const char*)(gbase) + (voff)[_i]), (LAS unsigned*)(lds + (bufoff) + ldsw + _i * 8192), 16, 0, 0); } while (0)
#define G8_KO(kt) ((size_t)(KWRAP ? ((kt) & (KWRAP - 1)) : (kt)) * kstep)
#define G8_LDA(dst, b, h) do { _Pragma("unroll") for (int m = 0; m < 4; ++m) _Pragma("unroll") for (int k = 0; k < 2; ++k) dst[m][k] = *(const LAS bf16x8*)(lds + G8_SA(b, h) + aoff + m * 2048 + k * 1024); } while (0)
#define G8_LDB(dst, b, h) do { _Pragma("unroll") for (int n = 0; n < 2; ++n) _Pragma("unroll") for (int k = 0; k < 2; ++k) dst[n][k] = *(const LAS bf16x8*)(lds + G8_SB(b, h) + boff + n * 2048 + k * 1024); } while (0)
#define G8_PK8(x) __builtin_bit_cast(v8i_t, x)
#define G8_MMA(ai, bj, At, Bt) do { __builtin_amdgcn_s_setprio(1); _Pragma("unroll") for (int m = 0; m < 4; ++m) _Pragma("unroll") for (int n = 0; n < 2; ++n) { \
        if constexpr (FP8 == 2 || (FP8 == 4 && (ai) == 1)) { typedef int v4i_ __attribute__((ext_vector_type(4))); \
            const v8i_t b8_ = __builtin_shufflevector(__builtin_bit_cast(v4i_, Bt[n][0]), __builtin_bit_cast(v4i_, Bt[n][1]), 0, 1, 2, 3, 4, 5, 6, 7); \
            const v8i_t a8_ = __builtin_shufflevector(__builtin_bit_cast(v4i_, At[m][0]), __builtin_bit_cast(v4i_, At[m][1]), 0, 1, 2, 3, 4, 5, 6, 7); \
            acc[ai][bj][m][n] = __builtin_amdgcn_mfma_scale_f32_16x16x128_f8f6f4(b8_, a8_, acc[ai][bj][m][n], 0, 0, 0, 0x7F7F7F7F, 0, 0x7F7F7F7F); } \
        else if constexpr (FP8 == 1 || FP8 == 4) { _Pragma("unroll") for (int k = 0; k < 2; ++k) { const v2l_t b2_ = __builtin_bit_cast(v2l_t, Bt[n][k]), a2_ = __builtin_bit_cast(v2l_t, At[m][k]); \
            acc[ai][bj][m][n] = __builtin_amdgcn_mfma_f32_16x16x32_fp8_fp8(b2_[0], a2_[0], acc[ai][bj][m][n], 0, 0, 0); \
            acc[ai][bj][m][n] = __builtin_amdgcn_mfma_f32_16x16x32_fp8_fp8(b2_[1], a2_[1], acc[ai][bj][m][n], 0, 0, 0); } } \
        else { _Pragma("unroll") for (int k = 0; k < 2; ++k) acc[ai][bj][m][n] = __builtin_amdgcn_mfma_f32_16x16x32_bf16(Bt[n][k], At[m][k], acc[ai][bj][m][n], 0, 0, 0); } } \
        __builtin_amdgcn_s_setprio(0); } while (0)
#define G8_WAIT_V(n) asm volatile("s_waitcnt vmcnt(" #n ")" ::: "memory")
#define G8_WAIT_L(n) asm volatile("s_waitcnt lgkmcnt(" #n ")" ::: "memory")
#define G8_BAR __builtin_amdgcn_s_barrier()
#define G8_SCHED __builtin_amdgcn_sched_barrier(0)
    Unit cur, nxt; int ui = 0;
    if (!S.next(0, cur)) return;
    f32x4 acc[2][2][4][2];
#pragma unroll
    for (int a = 0; a < 2; ++a)
#pragma unroll
        for (int b = 0; b < 2; ++b)
#pragma unroll
            for (int m = 0; m < 4; ++m)
#pragma unroll
                for (int n = 0; n < 2; ++n) acc[a][b][m][n] = (f32x4){0.f, 0.f, 0.f, 0.f};
    bf16x8 At[4][2], B0[2][2], B1[2][2];
    const char* cA = cur.a; const char* cB = cur.b; const char* nA = cA;
#define G8_STA(bufoff, nx, h, kt) do { const size_t _ko = G8_KO(kt); _Pragma("unroll") for (int _i = 0; _i < 2; ++_i) { const char* _s; \
        if constexpr (GATHER) _s = S.gbase + (size_t)((nx) ? gn[h][_i] : gc[h][_i]) + _ko; else _s = ((nx) ? nA : cA) + ((h) ? hstepA : (size_t)0) + voffA[_i] + _ko; \
        __builtin_amdgcn_global_load_lds((const unsigned*)_s, (LAS unsigned*)(lds + (bufoff) + ldsw + _i * 8192), 16, 0, 0); } } while (0)
    if constexpr (GATHER) {
#pragma unroll
        for (int h = 0; h < 2; ++h)
#pragma unroll
            for (int i = 0; i < 2; ++i) { gc[h][i] = S.row_off(cur, h * HALF + rA[i]) + cA2[i]; gn[h][i] = gc[h][i]; }
    }
    G8_STAGE(G8_SB(0, 0), cB, voffB); G8_STA(G8_SA(0, 0), false, 0, 0); G8_STAGE(G8_SB(0, 1), cB + hstepB, voffB); G8_STA(G8_SA(0, 1), false, 1, 0);
    if (wr == 1) G8_BAR;
    G8_WAIT_V(4); G8_BAR;
    G8_STAGE(G8_SB(1, 0), cB + kstep, voffB); G8_STA(G8_SA(1, 0), false, 0, 1); G8_STAGE(G8_SB(1, 1), cB + hstepB + kstep, voffB);
    G8_WAIT_V(6); G8_BAR;
    for (;;) {
        const bool has_next = S.next(ui + 1, nxt);
        nA = has_next ? nxt.a : cA; const char* nB = has_next ? nxt.b : cB;
        if constexpr (GATHER) {
#pragma unroll
            for (int h = 0; h < 2; ++h)
#pragma unroll
                for (int i = 0; i < 2; ++i) gn[h][i] = has_next ? (S.row_off(nxt, h * HALF + rA[i]) + cA2[i]) : gc[h][i];
        }
        for (int t = 0; t < nt; t += 2) {
            const bool last = (t == nt - 2);
            const char* b2 = last ? nB : cB + (size_t)(t + 2) * kstep;
            const char* b3 = b2 + kstep;
            G8_LDB(B0, 0, 0); G8_SCHED; G8_LDA(At, 0, 0); G8_STA(G8_SA(1, 1), false, 1, t + 1);
            G8_WAIT_L(8); G8_BAR; G8_WAIT_L(0); G8_MMA(0, 0, At, B0); G8_BAR; G8_SCHED;
            G8_LDB(B1, 0, 1); G8_STAGE(G8_SB(0, 0), b2, voffB);
            G8_BAR; G8_WAIT_L(0); G8_MMA(0, 1, At, B1); G8_BAR;
            G8_LDA(At, 0, 1); G8_STA(G8_SA(0, 0), last, 0, last ? 0 : t + 2);
            G8_BAR; G8_WAIT_L(0); if (cur.rows > HALF) G8_MMA(1, 0, At, B0); G8_BAR; G8_SCHED;
            G8_STAGE(G8_SB(0, 1), b2 + hstepB, voffB);
            G8_WAIT_V(6); G8_BAR; if (cur.rows > HALF) G8_MMA(1, 1, At, B1); G8_BAR;
            G8_LDB(B0, 1, 0); G8_SCHED; G8_LDA(At, 1, 0); G8_STA(G8_SA(0, 1), last, 1, last ? 0 : t + 2);
            G8_WAIT_L(8); G8_BAR; G8_WAIT_L(0); G8_MMA(0, 0, At, B0); G8_BAR; G8_SCHED;
            G8_LDB(B1, 1, 1); G8_STAGE(G8_SB(1, 0), b3, voffB);
            G8_BAR; G8_WAIT_L(0); G8_MMA(0, 1, At, B1); G8_BAR;
            G8_LDA(At, 1, 1); G8_STA(G8_SA(1, 0), last, 0, last ? 1 : t + 3);
            G8_BAR; G8_WAIT_L(0); if (cur.rows > HALF) G8_MMA(1, 0, At, B0); G8_BAR; G8_SCHED;
            G8_STAGE(G8_SB(1, 1), b3 + hstepB, voffB);
            G8_WAIT_V(6); G8_BAR; if (cur.rows > HALF) G8_MMA(1, 1, At, B1); G8_BAR;
        }
        {
            asm volatile("s_nop 15\n\ts_nop 15" : "+v"(acc[1][1][0][0]), "+v"(acc[1][1][0][1]), "+v"(acc[1][1][1][0]), "+v"(acc[1][1][1][1]), "+v"(acc[1][1][2][0]), "+v"(acc[1][1][2][1]), "+v"(acc[1][1][3][0]), "+v"(acc[1][1][3][1]));
            int tz = threadIdx.x; asm volatile("" : "+v"(tz));
            const int wid2 = __builtin_amdgcn_readfirstlane(tz >> 6), lane2 = tz & 63;
            E(acc, cur, wid2 >> 2, wid2 & 3, lane2 & 15, lane2 >> 4);
        }
        if (!has_next) break;
#pragma unroll
        for (int a = 0; a < 2; ++a)
#pragma unroll
            for (int b = 0; b < 2; ++b)
#pragma unroll
                for (int m = 0; m < 4; ++m)
#pragma unroll
                    for (int n = 0; n < 2; ++n) acc[a][b][m][n] = (f32x4){0.f, 0.f, 0.f, 0.f};
        cur = nxt; cA = nA; cB = nB; ++ui;
        if constexpr (GATHER) {
#pragma unroll
            for (int h = 0; h < 2; ++h)
#pragma unroll
                for (int i = 0; i < 2; ++i) gc[h][i] = gn[h][i];
        }
    }
    G8_WAIT_V(0);
    if (wr == 0) G8_BAR;
    G8_BAR;
#undef G8_SA
#undef G8_SB
#undef G8_STAGE
#undef G8_STA
#undef G8_KO
#undef G8_LDA
#undef G8_LDB
#undef G8_MMA
#undef G8_PK8
#undef G8_WAIT_V
#undef G8_WAIT_L
#undef G8_BAR
#undef G8_SCHED
}

struct EpiProj {
    static constexpr bool PERM = true;
    bf16_t* O; bf16_t* AG;
    __device__ __forceinline__ void operator()(const f32x4 (&acc)[2][2][4][2], const Unit& u, int wr, int wc, int fr, int fq) const {
        const int row0 = u.pm * BM + wr * 64 + fr, col0 = u.pn * BM + wc * 32 + 8 * fq;
#pragma unroll
        for (int ai = 0; ai < 2; ++ai)
#pragma unroll
            for (int m = 0; m < 4; ++m) {
                const int r = row0 + ai * HALF + m * 16;
#pragma unroll
                for (int bj = 0; bj < 2; ++bj) { const f32x4 v0 = acc[ai][bj][m][0], v1 = acc[ai][bj][m][1];
                    const int c = col0 + bj * HALF;
                    const u32x4 pk = (u32x4){cvt_pk_bf16(v0[0], v0[1]), cvt_pk_bf16(v0[2], v0[3]), cvt_pk_bf16(v1[0], v1[1]), cvt_pk_bf16(v1[2], v1[3])};
                    if (u.pn < 6) *(u32x4*)(O + (size_t)r * DINP + c) = pk;
                    else if (u.pn < 8) { const int cu = c - WC_U; *(u32x4*)(AG + ((size_t)(cu >> 4) * S5_ROWS + (r >> 4)) * 512 + (r & 15) * 16 + (cu & 15)) = pk; }
                    else if (c < WC_LR + 32) *(u32x4*)(O + (size_t)r * DINP + P_LRF + (c - WC_LR)) = pk; } }
    }
};
struct EpiBf16 {
    static constexpr bool PERM = true;
    bf16_t* O;
    __device__ __forceinline__ void operator()(const f32x4 (&acc)[2][2][4][2], const Unit& u, int wr, int wc, int fr, int fq) const {
        const int row0 = u.pm * BM + wr * 64 + fr, col0 = u.pn * BM + wc * 32 + 8 * fq;
#pragma unroll
        for (int ai = 0; ai < 2; ++ai)
#pragma unroll
            for (int m = 0; m < 4; ++m) {
                const int r = row0 + ai * HALF + m * 16;
#pragma unroll
                for (int bj = 0; bj < 2; ++bj) { const f32x4 v0 = acc[ai][bj][m][0] * (8.0f / 128.0f), v1 = acc[ai][bj][m][1] * (8.0f / 128.0f);
                    int d0 = __builtin_amdgcn_cvt_pk_fp8_f32(v0[0], v0[1], 0, false); d0 = __builtin_amdgcn_cvt_pk_fp8_f32(v0[2], v0[3], d0, true);
                    int d1 = __builtin_amdgcn_cvt_pk_fp8_f32(v1[0], v1[1], 0, false); d1 = __builtin_amdgcn_cvt_pk_fp8_f32(v1[2], v1[3], d1, true);
                    *(u32x2*)((char*)O + (size_t)r * DM + col0 + bj * HALF) = (u32x2){(unsigned)d0, (unsigned)d1}; }
            }
    }
};
struct EpiGlu {
    static constexpr bool PERM = true;
    const bf16_t* Z; bf16_t* MIX; const float* bias;
    __device__ __forceinline__ void operator()(const f32x4 (&acc)[2][2][4][2], const Unit& u, int wr, int wc, int fr, int fq) const {
        const int row0 = u.pm * BM + wr * 64 + fr, col0 = u.pn * BM + wc * 32 + 8 * fq;
#pragma unroll
        for (int bj = 0; bj < 2; ++bj) {
            const int c = col0 + bj * HALF;
            const f32x4 b0 = *(const f32x4*)(bias + c), b1 = *(const f32x4*)(bias + c + 4);
            u32x4 zq[8];
#pragma unroll
            for (int ai = 0; ai < 2; ++ai)
#pragma unroll
                for (int m = 0; m < 4; ++m) zq[ai * 4 + m] = *(const u32x4*)(Z + (size_t)(row0 + ai * HALF + m * 16) * 512 + c);
#pragma unroll
            for (int ai = 0; ai < 2; ++ai)
#pragma unroll
                for (int m = 0; m < 4; ++m) {
                    const size_t r = (size_t)(row0 + ai * HALF + m * 16);
                    const u32x4 zz = zq[ai * 4 + m];
                    const f32x4 v0 = acc[ai][bj][m][0] + b0, v1 = acc[ai][bj][m][1] + b1;
                    const float o0 = bflo(zz[0]) * sigmoid_fast(v0[0]), o1 = bfhi(zz[0]) * sigmoid_fast(v0[1]), o2 = bflo(zz[1]) * sigmoid_fast(v0[2]), o3 = bfhi(zz[1]) * sigmoid_fast(v0[3]);
                    const float o4 = bflo(zz[2]) * sigmoid_fast(v1[0]), o5 = bfhi(zz[2]) * sigmoid_fast(v1[1]), o6 = bflo(zz[3]) * sigmoid_fast(v1[2]), o7 = bfhi(zz[3]) * sigmoid_fast(v1[3]);
                    *(u32x4*)(MIX + r * DM + 512 + c) = (u32x4){cvt_pk_bf16(o0, o1), cvt_pk_bf16(o2, o3), cvt_pk_bf16(o4, o5), cvt_pk_bf16(o6, o7)};
                }
        }
    }
};
struct EpiOut {
    static constexpr bool PERM = true;
    const float* X; bf16_t* X1; const float* modv;
    __device__ __forceinline__ void operator()(const f32x4 (&acc)[2][2][4][2], const Unit& u, int wr, int wc, int fr, int fq) const {
        const int row0 = u.pm * BM + wr * 64 + fr, col0 = u.pn * BM + wc * 32 + 8 * fq;
        const float* g1 = modv + ((u.pm * BM) / SEQ) * 6144 + 2048;
#pragma unroll
        for (int bj = 0; bj < 2; ++bj) {
            const int c = col0 + bj * HALF;
            const f32x4 ga = *(const f32x4*)(g1 + c), gb = *(const f32x4*)(g1 + c + 4);
#pragma unroll
            for (int ai = 0; ai < 2; ++ai) {
                f32x4 xa[4], xb[4];
#pragma unroll
                for (int m = 0; m < 4; ++m) { const float* xs = X + (size_t)(row0 + ai * HALF + m * 16) * DM + c; xa[m] = *(const f32x4*)xs; xb[m] = *(const f32x4*)(xs + 4); }
#pragma unroll
                for (int m = 0; m < 4; ++m) { const f32x4 y0 = xa[m] + ga * acc[ai][bj][m][0], y1 = xb[m] + gb * acc[ai][bj][m][1];
                    *(u32x4*)(X1 + (size_t)(row0 + ai * HALF + m * 16) * DM + c) = (u32x4){cvt_pk_bf16(y0[0], y0[1]), cvt_pk_bf16(y0[2], y0[3]), cvt_pk_bf16(y1[0], y1[1]), cvt_pk_bf16(y1[2], y1[3])}; }
            }
        }
    }
};
struct EpiScores {
    static constexpr bool PERM = false;
    float* O;
    __device__ __forceinline__ void operator()(const f32x4 (&acc)[2][2][4][2], const Unit& u, int wr, int wc, int fr, int fq) const {
        const int row0 = u.pm * BM + wr * 64 + fr, col0 = u.pn * BM + wc * 32 + 4 * fq;
#pragma unroll
        for (int ai = 0; ai < 2; ++ai)
#pragma unroll
            for (int m = 0; m < 4; ++m) { float* rowp = O + (size_t)(row0 + ai * HALF + m * 16) * 256 + col0;
#pragma unroll
                for (int bj = 0; bj < 2; ++bj)
#pragma unroll
                    for (int n = 0; n < 2; ++n) { const f32x4 v = acc[ai][bj][m][n];
                        *(f32x4*)(rowp + bj * HALF + n * 16) = (f32x4){sigmoid_fast(v[0]), sigmoid_fast(v[1]), sigmoid_fast(v[2]), sigmoid_fast(v[3])}; } }
    }
};
struct EpiGateUp {
    static constexpr bool PERM = true;
    bf16_t* O;
    __device__ __forceinline__ void operator()(const f32x4 (&acc)[2][2][4][2], const Unit& u, int wr, int wc, int fr, int fq) const {
        const int row0 = u.pm * BM + wr * 64 + fr, col0 = u.pn * HALF + wc * 32 + 8 * fq;
#pragma unroll
        for (int ai = 0; ai < 2; ++ai)
#pragma unroll
            for (int m = 0; m < 4; ++m) {
                const f32x4 g0 = acc[ai][0][m][0], g1 = acc[ai][0][m][1], u0 = acc[ai][1][m][0], u1 = acc[ai][1][m][1];
                int d0 = __builtin_amdgcn_cvt_pk_fp8_f32(silu_fast(g0[0]) * u0[0] * 8.0f, silu_fast(g0[1]) * u0[1] * 8.0f, 0, false); d0 = __builtin_amdgcn_cvt_pk_fp8_f32(silu_fast(g0[2]) * u0[2] * 8.0f, silu_fast(g0[3]) * u0[3] * 8.0f, d0, true);
                int d1 = __builtin_amdgcn_cvt_pk_fp8_f32(silu_fast(g1[0]) * u1[0] * 8.0f, silu_fast(g1[1]) * u1[1] * 8.0f, 0, false); d1 = __builtin_amdgcn_cvt_pk_fp8_f32(silu_fast(g1[2]) * u1[2] * 8.0f, silu_fast(g1[3]) * u1[3] * 8.0f, d1, true);
                *(u32x2*)((char*)O + (size_t)(row0 + ai * HALF + m * 16) * 256 + col0) = (u32x2){(unsigned)d0, (unsigned)d1};
            }
    }
};
struct EpiF32 {
    static constexpr bool PERM = false;
    float* O;
    __device__ __forceinline__ void operator()(const f32x4 (&acc)[2][2][4][2], const Unit& u, int wr, int wc, int fr, int fq) const {
        const int row0 = u.pm * BM + wr * 64 + fr, col0 = u.pn * BM + wc * 32 + 4 * fq;
#pragma unroll
        for (int ai = 0; ai < 2; ++ai)
#pragma unroll
            for (int m = 0; m < 4; ++m) { float* rowp = O + (size_t)(row0 + ai * HALF + m * 16) * DM + col0;
#pragma unroll
                for (int bj = 0; bj < 2; ++bj)
#pragma unroll
                    for (int n = 0; n < 2; ++n) *(f32x4*)(rowp + bj * HALF + n * 16) = acc[ai][bj][m][n]; }
    }
};
struct ExpertSched {
    const LAS int* toff;
    const LAS int* offs;
    const LAS int* cntl;
    const char* gbase; unsigned lda;
    const unsigned short* ltok;
    const char* Ad;
    const char* Bt; size_t bexp; unsigned ldb;
    int ncolt, G, c, total;
    __device__ __forceinline__ bool next(int i, Unit& u) const {
        const int L = i * G + c; if (L >= total) return false;
        int lo = 0, hi = 256;
        while (hi - lo > 1) { const int mid = (lo + hi) >> 1; if (__builtin_amdgcn_readfirstlane(toff[mid]) <= L) lo = mid; else hi = mid; }
        const int lt = L - __builtin_amdgcn_readfirstlane(toff[lo]);
        u.e = lo; u.pm = lt / ncolt; u.pn = lt % ncolt; u.rows = __builtin_amdgcn_readfirstlane(cntl[lo]) - u.pm * BM;
        u.b = Bt + (size_t)lo * bexp + (size_t)u.pn * BM * ldb;
        u.a = Ad ? Ad + (size_t)(__builtin_amdgcn_readfirstlane(offs[lo]) + u.pm * BM) * lda : nullptr;
        return true;
    }
    __device__ __forceinline__ unsigned row_off(const Unit& u, int rl) const {
        const int r = u.pm * BM + rl, cn = __builtin_amdgcn_readfirstlane(cntl[u.e]);
        const int tok = ltok[(size_t)u.e * CAP + (r < cn ? r : 0)];
        return (unsigned)tok * lda;
    }
};
struct EpiExpGU {
    static constexpr bool PERM = true;
    bf16_t* O; const LAS int* offs; const LAS int* cntl;
    __device__ __forceinline__ void operator()(const f32x4 (&acc)[2][2][4][2], const Unit& u, int wr, int wc, int fr, int fq) const {
        const int cn = __builtin_amdgcn_readfirstlane(cntl[u.e]), ro = __builtin_amdgcn_readfirstlane(offs[u.e]);
        const int rl0 = u.pm * BM + wr * 64 + fr, col0 = u.pn * HALF + wc * 32 + 8 * fq;
#pragma unroll
        for (int ai = 0; ai < 2; ++ai)
#pragma unroll
            for (int m = 0; m < 4; ++m) {
                const int rl = rl0 + ai * HALF + m * 16;
                const unsigned ob = (unsigned)(rl < cn ? ro + rl : NL * 8) * 256u + (unsigned)col0;
                const f32x4 g0 = acc[ai][0][m][0] * (1.0f / 32.0f), g1 = acc[ai][0][m][1] * (1.0f / 32.0f), u0 = acc[ai][1][m][0] * (8.0f / 32.0f), u1 = acc[ai][1][m][1] * (8.0f / 32.0f);
                int d0 = __builtin_amdgcn_cvt_pk_fp8_f32(silu_fast(g0[0]) * u0[0], silu_fast(g0[1]) * u0[1], 0, false); d0 = __builtin_amdgcn_cvt_pk_fp8_f32(silu_fast(g0[2]) * u0[2], silu_fast(g0[3]) * u0[3], d0, true);
                int d1 = __builtin_amdgcn_cvt_pk_fp8_f32(silu_fast(g1[0]) * u1[0], silu_fast(g1[1]) * u1[1], 0, false); d1 = __builtin_amdgcn_cvt_pk_fp8_f32(silu_fast(g1[2]) * u1[2], silu_fast(g1[3]) * u1[3], d1, true);
                *(u32x2*)((char*)O + ob) = (u32x2){(unsigned)d0, (unsigned)d1};
            }
    }
};
#define YB_SCALE 8.0f
struct EpiExpDown {
    static constexpr bool PERM = true;
    bf16_t* O; const LAS int* offs; const LAS int* cntl;
    __device__ __forceinline__ void operator()(const f32x4 (&acc)[2][2][4][2], const Unit& u, int wr, int wc, int fr, int fq) const {
        const int cn = __builtin_amdgcn_readfirstlane(cntl[u.e]), ro = __builtin_amdgcn_readfirstlane(offs[u.e]);
        const int rl0 = u.pm * BM + wr * 64 + fr, col0 = u.pn * BM + wc * 32 + 8 * fq;
#pragma unroll
        for (int ai = 0; ai < 2; ++ai)
#pragma unroll
            for (int m = 0; m < 4; ++m) {
                const int rl = rl0 + ai * HALF + m * 16;
                const unsigned ob = (unsigned)(rl < cn ? ro + rl : NL * 8) * DM + (unsigned)col0;
#pragma unroll
                for (int bj = 0; bj < 2; ++bj) { const f32x4 v0 = acc[ai][bj][m][0] * (YB_SCALE / 128.0f), v1 = acc[ai][bj][m][1] * (YB_SCALE / 128.0f);
                    int d0 = __builtin_amdgcn_cvt_pk_fp8_f32(v0[0], v0[1], 0, false); d0 = __builtin_amdgcn_cvt_pk_fp8_f32(v0[2], v0[3], d0, true);
                    int d1 = __builtin_amdgcn_cvt_pk_fp8_f32(v1[0], v1[1], 0, false); d1 = __builtin_amdgcn_cvt_pk_fp8_f32(v1[2], v1[3], d1, true);
                    *(u32x2*)((char*)O + ob + bj * HALF) = (u32x2){(unsigned)d0, (unsigned)d1}; }
            }
    }
};
struct EpiAddG2 {
    static constexpr bool PERM = false;
    float* O; const float* modv;
    __device__ __forceinline__ void operator()(const f32x4 (&acc)[2][2][4][2], const Unit& u, int wr, int wc, int fr, int fq) const {
        const int row0 = u.pm * BM + wr * 64 + fr, col0 = u.pn * BM + wc * 32 + 4 * fq;
        const float* g2 = modv + ((u.pm * BM) / SEQ) * 6144 + 5120;
#pragma unroll
        for (int bj = 0; bj < 2; ++bj)
#pragma unroll
            for (int n = 0; n < 2; ++n) {
                const int c = col0 + bj * HALF + n * 16;
                const f32x4 g = *(const f32x4*)(g2 + c);
                f32x4 xv[8];
#pragma unroll
                for (int ai = 0; ai < 2; ++ai)
#pragma unroll
                    for (int m = 0; m < 4; ++m) xv[ai * 4 + m] = *(const f32x4*)(O + (size_t)(row0 + ai * HALF + m * 16) * DM + c);
#pragma unroll
                for (int ai = 0; ai < 2; ++ai)
#pragma unroll
                    for (int m = 0; m < 4; ++m) *(f32x4*)(O + (size_t)(row0 + ai * HALF + m * 16) * DM + c) = xv[ai * 4 + m] + g * acc[ai][bj][m][n];
            }
    }
};
}

__device__ __forceinline__ float4 ld4(const float* p) { return *(const float4*)p; }
__device__ __forceinline__ float4 ld4(const bf16_t* p) { const u32x2 w = *(const u32x2*)p; return make_float4(bflo(w[0]), bfhi(w[0]), bflo(w[1]), bfhi(w[1])); }
template <bool DUAL, class AF, class EF>
__device__ __forceinline__ void gemm_naive(float* lds, int m0, int n0, int M, int N, int K, AF arow,
                                           const float* __restrict__ B0, const float* __restrict__ B1, int ldb, EF epi) {
    float* As = lds;
    float* Bs0 = lds + 16 * 132;
    float* Bs1 = Bs0 + 16 * 64;
    const int tid = threadIdx.x;
    const int ty = tid >> 4, tx = tid & 15;
    float acc0[4][4], acc1[4][4];
#pragma unroll
    for (int i = 0; i < 4; ++i)
#pragma unroll
        for (int j = 0; j < 4; ++j) { acc0[i][j] = 0.f; acc1[i][j] = 0.f; }
    const int am = tid >> 2, ak = (tid & 3) * 4;
    const int bk = (tid >> 4) & 15, bn = (tid & 15) * 4;
    const bool bthr = tid < 256;
    auto ap = arow((m0 + am < M) ? (m0 + am) : m0);
    const bool aok = (m0 + am) < M;
    const bool bok = bthr && (n0 + bn) < N;
    for (int k0 = 0; k0 < K; k0 += 16) {
        float4 av = aok ? ld4(ap + k0 + ak) : make_float4(0.f, 0.f, 0.f, 0.f);
        float4 bv0 = bok ? *(const float4*)(B0 + (size_t)(k0 + bk) * ldb + n0 + bn) : make_float4(0.f, 0.f, 0.f, 0.f);
        float4 bv1 = make_float4(0.f, 0.f, 0.f, 0.f);
        if (DUAL) bv1 = bok ? *(const float4*)(B1 + (size_t)(k0 + bk) * ldb + n0 + bn) : make_float4(0.f, 0.f, 0.f, 0.f);
        __syncthreads();
        As[(ak + 0) * 132 + am] = av.x; As[(ak + 1) * 132 + am] = av.y; As[(ak + 2) * 132 + am] = av.z; As[(ak + 3) * 132 + am] = av.w;
        if (bthr) { *(float4*)&Bs0[bk * 64 + bn] = bv0; if (DUAL) *(float4*)&Bs1[bk * 64 + bn] = bv1; }
        __syncthreads();
#pragma unroll
        for (int kk = 0; kk < 16; ++kk) {
            const float4 a = *(const float4*)&As[kk * 132 + ty * 4];
            const float4 b = *(const float4*)&Bs0[kk * 64 + tx * 4];
            const float aa[4] = {a.x, a.y, a.z, a.w};
            const float bb[4] = {b.x, b.y, b.z, b.w};
#pragma unroll
            for (int i = 0; i < 4; ++i)
#pragma unroll
                for (int j = 0; j < 4; ++j) acc0[i][j] = fmaf(aa[i], bb[j], acc0[i][j]);
            if (DUAL) {
                const float4 b1 = *(const float4*)&Bs1[kk * 64 + tx * 4];
                const float bb1[4] = {b1.x, b1.y, b1.z, b1.w};
#pragma unroll
                for (int i = 0; i < 4; ++i)
#pragma unroll
                    for (int j = 0; j < 4; ++j) acc1[i][j] = fmaf(aa[i], bb1[j], acc1[i][j]);
            }
        }
    }
#pragma unroll
    for (int i = 0; i < 4; ++i)
#pragma unroll
        for (int j = 0; j < 4; ++j) {
            const int m = m0 + ty * 4 + i, n = n0 + tx * 4 + j;
            if (m < M && n < N) epi(m, n, acc0[i][j], acc1[i][j]);
        }
    __syncthreads();
}

__device__ __forceinline__ void modv_unit(const Params& p, float* lds, int u) {
    float* red = lds + 17 * 1024;
    const int tid = threadIdx.x, col_l = tid & 31, kg = tid >> 5;
    const int col = u * 32 + col_l;
    float acc[17];
#pragma unroll
    for (int b = 0; b < 17; ++b) acc[b] = 0.f;
    for (int k0 = kg * 64; k0 < kg * 64 + 64; k0 += 8) {
        float w[8];
#pragma unroll
        for (int i = 0; i < 8; ++i) w[i] = p.ada_w[(size_t)(k0 + i) * 6144 + col];
#pragma unroll 1
        for (int i = 0; i < 8; ++i) {
            const float wi = (i == 0) ? w[0] : (i == 1) ? w[1] : (i == 2) ? w[2] : (i == 3) ? w[3] : (i == 4) ? w[4] : (i == 5) ? w[5] : (i == 6) ? w[6] : w[7];
#pragma unroll
            for (int b = 0; b < 17; ++b) acc[b] = fmaf(lds[b * 1024 + k0 + i], wi, acc[b]);
        }
    }
#pragma unroll
    for (int b = 0; b < 17; ++b) {
        __syncthreads();
        red[kg * 32 + col_l] = acc[b];
        __syncthreads();
        if (kg == 0) {
            float s = 0.f;
#pragma unroll
            for (int g = 0; g < 16; ++g) s += red[g * 32 + col_l];
            p.modv[b * 6144 + col] = s + p.ada_b[col];
        }
    }
}

struct CvtJob { const float* W; bf16_t* dst; int ldw, N, k0, n0, ldd, map; float f8;
};
#define NJ_DENSE 552
#define NJ_TOTAL (NJ_DENSE + 256 * 96)
__device__ __forceinline__ CvtJob cvt_decode(const Params& p, int u) {
    CvtJob j;
    const int J0 = 264, J1 = J0 + 128, J2 = J1 + 32, J3 = J2 + 32, J4 = J3 + 32, J5 = J4 + 32;
    if (u >= NJ_DENSE) {
        const int v = u - NJ_DENSE, e = v / 96, r = v % 96, which = r >> 5, l = r & 31;
        if (which < 2) { j.W = (which ? p.ew_up : p.ew_gate) + (size_t)e * DM * 256; j.dst = (bf16_t*)((char*)p.eguT + (size_t)e * 512 * DM); j.ldw = 256; j.N = 256; j.k0 = (l >> 2) * 128; j.n0 = (l & 3) * 64; j.ldd = DM; j.map = 2 + which; j.f8 = 32.0f; }
        else { j.W = p.ew_down + (size_t)e * 256 * DM; j.dst = (bf16_t*)((char*)p.edT + (size_t)e * DM * 256); j.ldw = DM; j.N = DM; j.k0 = (l >> 4) * 128; j.n0 = (l & 15) * 64; j.ldd = 256; j.map = 0; j.f8 = 16.0f; }
        return j;
    }
    j.f8 = 0.0f;
    if (u < J0) { j.W = p.w_in; j.dst = p.w_inT; j.ldw = DIN; j.N = DIN; j.k0 = (u / 33) * 128; j.n0 = (u % 33) * 64; j.ldd = DM; j.map = 1; }
    else if (u < J1) { const int l = u - J0; j.W = p.w_out; j.dst = p.w_outT; j.ldw = DM; j.N = DM; j.k0 = (l / 16) * 128; j.n0 = (l % 16) * 64; j.ldd = DM; j.map = 0; }
    else if (u < J2) { const int l = u - J1; j.W = p.glu_w; j.dst = p.gluT; j.ldw = 512; j.N = 512; j.k0 = (l / 8) * 128; j.n0 = (l % 8) * 64; j.ldd = 512; j.map = 0; }
    else if (u < J3) { const int l = u - J2; j.W = p.router_w; j.dst = p.routerT3; j.ldw = 256; j.N = 256; j.k0 = (l / 4) * 128; j.n0 = (l % 4) * 64; j.ldd = 3072; j.map = 4; }
    else if (u < J4) { const int l = u - J3; j.W = p.sw_gate; j.dst = p.shguT; j.ldw = 256; j.N = 256; j.k0 = (l / 4) * 128; j.n0 = (l % 4) * 64; j.ldd = DM; j.map = 2; }
    else if (u < J5) { const int l = u - J4; j.W = p.sw_up; j.dst = p.shguT; j.ldw = 256; j.N = 256; j.k0 = (l / 4) * 128; j.n0 = (l % 4) * 64; j.ldd = DM; j.map = 3; }
    else { const int l = u - J5; j.W = p.sw_down; j.dst = p.shdT; j.ldw = DM; j.N = DM; j.k0 = (l / 16) * 128; j.n0 = (l % 16) * 64; j.ldd = 256; j.map = 0; j.f8 = 16.0f; }
    return j;
}
__device__ __forceinline__ int cvt_rowmap(int map, int c) {
    if (map == 1) return c < S_LR ? c : (c < S_U ? (WC_LR + (c - S_LR)) : (WC_U + (c - S_U)));
    if (map == 2) return (c >> 7) * 256 + (c & 127);
    if (map == 3) return (c >> 7) * 256 + 128 + (c & 127);
    return c;
}
__device__ __forceinline__ void cvt_load(const CvtJob& j, float4 (&r)[4]) {
    const int tid = threadIdx.x;
#pragma unroll
    for (int i = 0; i < 2; ++i) {
        const int kk = (j.f8 != 0.0f) ? (tid >> 4) * 4 + 2 * i : (tid >> 4) * 2 + 64 * i, n = j.n0 + (tid & 15) * 4;
        r[2 * i] = make_float4(0.f, 0.f, 0.f, 0.f); r[2 * i + 1] = r[2 * i];
        if (n < j.N) { r[2 * i] = *(const float4*)(j.W + (size_t)(j.k0 + kk) * j.ldw + n); r[2 * i + 1] = *(const float4*)(j.W + (size_t)(j.k0 + kk + 1) * j.ldw + n); }
    }
}
__device__ __forceinline__ void cvt_fill(const CvtJob& j, const float4 (&r)[4], unsigned* T, unsigned* T2) {
    const int tid = threadIdx.x;
    if (j.f8 != 0.0f) {
        const int nl = (tid & 15) * 4, kq = tid >> 4; const float s = j.f8;
        const float a0[4] = {r[0].x, r[0].y, r[0].z, r[0].w}, a1[4] = {r[1].x, r[1].y, r[1].z, r[1].w}, a2[4] = {r[2].x, r[2].y, r[2].z, r[2].w}, a3[4] = {r[3].x, r[3].y, r[3].z, r[3].w};
#pragma unroll
        for (int q = 0; q < 4; ++q) { int w = __builtin_amdgcn_cvt_pk_fp8_f32(a0[q] * s, a1[q] * s, 0, false); w = __builtin_amdgcn_cvt_pk_fp8_f32(a2[q] * s, a3[q] * s, w, true); T[(nl + q) * 33 + kq] = (unsigned)w; }
        return;
    }
#pragma unroll
    for (int i = 0; i < 2; ++i) {
        const int kk = (tid >> 4) * 2 + 64 * i, nl = (tid & 15) * 4;
        const float av[4] = {r[2 * i].x, r[2 * i].y, r[2 * i].z, r[2 * i].w}, bv[4] = {r[2 * i + 1].x, r[2 * i + 1].y, r[2 * i + 1].z, r[2 * i + 1].w};
#pragma unroll
        for (int q = 0; q < 4; ++q) {
            const unsigned w = cvt_pk_bf16(av[q], bv[q]);
            T[(nl + q) * 65 + (kk >> 1)] = w;
            if (j.map == 4) T2[(nl + q) * 65 + (kk >> 1)] = cvt_pk_bf16(av[q] - bflo(w), bv[q] - bfhi(w));
        }
    }
}
__device__ __forceinline__ void cvt_drain(const CvtJob& j, const unsigned* T, const unsigned* T2) {
    const int tid = threadIdx.x;
    const int n_l = tid >> 3, seg = tid & 7;
    if (j.f8 != 0.0f) {
        if (j.n0 + n_l < j.N) {
            const int rr = cvt_rowmap(j.map, j.n0 + n_l);
            u32x4 w0;
#pragma unroll
            for (int w = 0; w < 4; ++w) w0[w] = T[n_l * 33 + seg * 4 + w];
            *(u32x4*)((char*)j.dst + (size_t)rr * j.ldd + j.k0 + seg * 16) = w0;
        }
        return;
    }
    if (j.n0 + n_l < j.N) {
        const int rr = cvt_rowmap(j.map, j.n0 + n_l);
        u32x4 w0, w1;
#pragma unroll
        for (int w = 0; w < 4; ++w) { w0[w] = T[n_l * 65 + seg * 8 + w]; w1[w] = T[n_l * 65 + seg * 8 + 4 + w]; }
        bf16_t* d = j.dst + (size_t)rr * j.ldd + j.k0 + seg * 16;
        *(u32x4*)d = w0; *(u32x4*)(d + 8) = w1;
        if (j.map == 4) {
            *(u32x4*)(d + 1024) = w0; *(u32x4*)(d + 1032) = w1;
#pragma unroll
            for (int w = 0; w < 4; ++w) { w0[w] = T2[n_l * 65 + seg * 8 + w]; w1[w] = T2[n_l * 65 + seg * 8 + 4 + w]; }
            *(u32x4*)(d + 2048) = w0; *(u32x4*)(d + 2056) = w1;
        }
    }
}

__device__ __forceinline__ void phase_prologue(const Params& p, float* lds, const int part) {
    const int tid = threadIdx.x, bid = blockIdx.x, nb = gridDim.x;
    if (part == 0) {
    if (bid < 192) {
        for (int i = tid; i < 17 * 1024; i += NT) {
            const int b = i >> 10, k = i & 1023;
            lds[i] = siluf_((b < 16) ? p.c[b * 1024 + k] : p.c_ctx[k]);
        }
        __syncthreads();
        for (int u = bid; u < 192; u += nb) modv_unit(p, lds, u);
        __syncthreads();
    }
    { u32x4* zp = (u32x4*)(p.w_inT + (size_t)DIN * DM); const int nz = (2304 - DIN) * DM * 2 / 16;
      for (int i = bid * NT + tid; i < nz; i += nb * NT) zp[i] = (u32x4){0u, 0u, 0u, 0u}; }
    return;
    }
    unsigned* Tb = (unsigned*)lds;
    int u = nb - 1 - bid, par = 0;
    if (u < NJ_TOTAL) {
        CvtJob jA = cvt_decode(p, u), jB = jA; float4 rA[4], rB[4];
        bool hB = (u + nb) < NJ_TOTAL;
        cvt_load(jA, rA);
        if (hB) { jB = cvt_decode(p, u + nb); cvt_load(jB, rB); } else { for (int q = 0; q < 4; ++q) rB[q] = rA[q]; }
        for (;;) {
            const int un = u + 2 * nb; const bool hnA = un < NJ_TOTAL, hnB = (un + nb) < NJ_TOTAL;
            CvtJob jnA = jA, jnB = jB; float4 rnA[4], rnB[4];
            if (hnA) { jnA = cvt_decode(p, un); cvt_load(jnA, rnA); } else { for (int q = 0; q < 4; ++q) rnA[q] = rA[q]; }
            if (hnB) { jnB = cvt_decode(p, un + nb); cvt_load(jnB, rnB); } else { for (int q = 0; q < 4; ++q) rnB[q] = rB[q]; }
            unsigned* T0 = Tb + (par * 2 + 0) * (64 * 65); unsigned* T1 = Tb + (par * 2 + 1) * (64 * 65); unsigned* T2 = Tb + 4 * (64 * 65);
            cvt_fill(jA, rA, T0, T2);
            if (hB) cvt_fill(jB, rB, T1, T2);
            __syncthreads();
            cvt_drain(jA, T0, T2);
            if (hB) cvt_drain(jB, T1, T2);
            if (jA.map == 4 || jB.map == 4) __syncthreads();
            if (!hnA) break;
            par ^= 1; u = un; jA = jnA; jB = jnB; hB = hnB;
#pragma unroll
            for (int q = 0; q < 4; ++q) { rA[q] = rnA[q]; rB[q] = rnB[q]; }
        }
    }
    __syncthreads();
}

__device__ __forceinline__ void phase_norm_mod(const Params& p, int which) {
    const int lane = threadIdx.x & 63, wave = threadIdx.x >> 6;
    const int nrows = which == 0 ? NR : NL;
    const float* g = which == 0 ? p.norm1_g : p.norm2_g;
    const int osh = which == 0 ? 0 : 3072, osc = which == 0 ? 1024 : 4096;
    auto rowsrc = [&](int r) -> const float* {
        if (which == 0) return (r < NL) ? p.x + (size_t)r * DM : p.ctx + (size_t)(r - NL) * DM;
        return p.out + (size_t)r * DM;
    };
    const int stride = gridDim.x * NWAVES, rbase = blockIdx.x * NWAVES + wave;
    float4 ring[3][4];
#pragma unroll
    for (int k = 0; k < 3; ++k) if (rbase + k * stride < nrows) { const float* s0 = rowsrc(rbase + k * stride);
#pragma unroll
        for (int i = 0; i < 2; ++i) {
            if (which == 1) ring[k][i] = __builtin_bit_cast(float4, *(const u32x4*)(p.yf + (size_t)(rbase + k * stride) * DM + i * 512 + lane * 8));
            else { ring[k][2 * i] = *(const float4*)(s0 + i * 512 + lane * 8); ring[k][2 * i + 1] = *(const float4*)(s0 + i * 512 + lane * 8 + 4); } } }
    for (int r0 = rbase; r0 < nrows; r0 += 3 * stride) {
#pragma unroll
      for (int k = 0; k < 3; ++k) {
        const int r = r0 + k * stride;
        if (r >= nrows) break;
        const int b = (which == 0 && r >= NL) ? 16 : r / SEQ;
        float4 v[4]; float ss = 0.f;
#pragma unroll
        for (int i = 0; i < 4; ++i) v[i] = ring[k][i];
        if (which == 1) {
#pragma unroll
            for (int i = 0; i < 2; ++i) { const u32x4 w_ = __builtin_bit_cast(u32x4, ring[k][i]);
                v[2 * i] = make_float4(bflo(w_[0]), bfhi(w_[0]), bflo(w_[1]), bfhi(w_[1])); v[2 * i + 1] = make_float4(bflo(w_[2]), bfhi(w_[2]), bflo(w_[3]), bfhi(w_[3])); }
        }
        {
            const int rn = r + 3 * stride;
            if (rn < nrows) { const float* s1 = rowsrc(rn);
#pragma unroll
                for (int i = 0; i < 2; ++i) {
                    if (which == 1) ring[k][i] = __builtin_bit_cast(float4, *(const u32x4*)(p.yf + (size_t)rn * DM + i * 512 + lane * 8));
                    else { ring[k][2 * i] = *(const float4*)(s1 + i * 512 + lane * 8); ring[k][2 * i + 1] = *(const float4*)(s1 + i * 512 + lane * 8 + 4); } } }
        }
#pragma unroll
        for (int i = 0; i < 4; ++i) ss += v[i].x * v[i].x + v[i].y * v[i].y + v[i].z * v[i].z + v[i].w * v[i].w;
        ss = wave_sum(ss);
        const float rstd = rsqrtf(ss * (1.0f / DM) + EPS);
        const float* mv = p.modv + b * 6144;
#pragma unroll
        for (int i = 0; i < 2; ++i) {
            const int col = i * 512 + lane * 8;
            float o[8];
#pragma unroll
            for (int h = 0; h < 2; ++h) {
                const float4 gg = *(const float4*)(g + col + 4 * h), sh = *(const float4*)(mv + osh + col + 4 * h), sc = *(const float4*)(mv + osc + col + 4 * h);
                const float4 vv = v[2 * i + h];
                o[4 * h + 0] = vv.x * rstd * gg.x * (1.f + sc.x) + sh.x; o[4 * h + 1] = vv.y * rstd * gg.y * (1.f + sc.y) + sh.y;
                o[4 * h + 2] = vv.z * rstd * gg.z * (1.f + sc.z) + sh.z; o[4 * h + 3] = vv.w * rstd * gg.w * (1.f + sc.w) + sh.w;
            }
            u32x4 hi = (u32x4){cvt_pk_bf16(o[0], o[1]), cvt_pk_bf16(o[2], o[3]), cvt_pk_bf16(o[4], o[5]), cvt_pk_bf16(o[6], o[7])};
            if (which == 0) {
                *(u32x4*)(p.hx + (size_t)r * DM + col) = hi;
            } else {
                *(u32x4*)(p.hx + (size_t)r * DM + col) = hi;
                { int d0 = __builtin_amdgcn_cvt_pk_fp8_f32(o[0], o[1], 0, false); d0 = __builtin_amdgcn_cvt_pk_fp8_f32(o[2], o[3], d0, true);
                  int d1 = __builtin_amdgcn_cvt_pk_fp8_f32(o[4], o[5], 0, false); d1 = __builtin_amdgcn_cvt_pk_fp8_f32(o[6], o[7], d1, true);
                  *(u32x2*)((char*)p.of + (size_t)r * DM + col) = (u32x2){(unsigned)d0, (unsigned)d1}; }
            }
        }
    }
    }
}

__device__ __forceinline__ int scan_row(int b, int dir, int s, bool& lat) {
    if (s < CTX) { lat = false; const int t = dir ? (CTX - 1 - s) : s; return NL + b * CTX + t; }
    lat = true; const int t = dir ? (SEQ - 1 - (s - CTX)) : (s - CTX); return b * SEQ + t;
}

#define GL_LD 72
__device__ __forceinline__ void gla_chunk_unit(const Params& p, unsigned char* lds8, int unit) {
    const int dir = unit & 1, h = (unit >> 1) & 3, b = unit >> 3;
    const int tid = threadIdx.x, lane = tid & 63, w = __builtin_amdgcn_readfirstlane(tid >> 6), fr = lane & 15, fq = lane >> 4;
    const int tc = tid >> 3, g8 = tid & 7;
    bf16_t* Qc = (bf16_t*)lds8;            bf16_t* Ki = Qc + 64 * GL_LD;   bf16_t* Pm = Ki + 64 * GL_LD;
    bf16_t* KsT = Pm + 64 * GL_LD;         bf16_t* VT = KsT + 64 * GL_LD;  bf16_t* ST = VT + 128 * GL_LD;
    float* LA = (float*)(ST + 128 * GL_LD); float* SEG = LA + 64 * 64;      float* LR = SEG + 8 * 64;
    float* WA = LR + 64 * 16;              float* BA = WA + 16 * 64;       float* DEC = BA + 64;   float* CL = DEC + 64;
    const float* wa = dir ? p.wa_b : p.wa_f;
    const float* ba = dir ? p.ba_b : p.ba_f;
    __syncthreads();
    for (int i = tid; i < 100 * 1024 / 4; i += NT) ((unsigned*)lds8)[i] = 0u;
    __syncthreads();
    f32x4 accS[4];
#pragma unroll
    for (int j = 0; j < 4; ++j) accS[j] = (f32x4){0.f, 0.f, 0.f, 0.f};
    const int tm = w >> 1, pr = w & 1;
    bf16x8 wfrag[2]; f32x4 bav[2];
#pragma unroll
    for (int j = 0; j < 2; ++j) {
        const int dk0 = (pr * 2 + j) * 16;
        u32x4 wv = (u32x4){0u, 0u, 0u, 0u};
        if (fq < 2) {
            float t8[8];
#pragma unroll
            for (int i = 0; i < 8; ++i) t8[i] = wa[(fq * 8 + i) * 256 + h * 64 + dk0 + fr];
            wv = (u32x4){cvt_pk_bf16(t8[0], t8[1]), cvt_pk_bf16(t8[2], t8[3]), cvt_pk_bf16(t8[4], t8[5]), cvt_pk_bf16(t8[6], t8[7])};
        }
        wfrag[j] = __builtin_bit_cast(bf16x8, wv);
        bav[j] = (f32x4){ba[h * 64 + dk0 + fq * 4], ba[h * 64 + dk0 + fq * 4 + 1], ba[h * 64 + dk0 + fq * 4 + 2], ba[h * 64 + dk0 + fq * 4 + 3]};
    }
    auto row_of = [&](int sc, int c) -> int {
        if (sc < 4) { const int tok = dir ? ((3 - sc) * 64 + 63 - c) : (sc * 64 + c); return NL + b * CTX + tok; }
        const int n = sc - 4; const int tok = dir ? ((31 - n) * 64 + 63 - c) : (n * 64 + c); return b * SEQ + tok;
    };
    u32x4 rq, rk, rv, rv2; unsigned rl;
    {
        const bf16_t* pr0 = p.proj + (size_t)row_of(0, tc) * DINP;
        rq = *(const u32x4*)(pr0 + P_Q + h * 64 + g8 * 8); rk = *(const u32x4*)(pr0 + P_K + h * 64 + g8 * 8);
        rv = *(const u32x4*)(pr0 + P_V + h * 128 + g8 * 16); rv2 = *(const u32x4*)(pr0 + P_V + h * 128 + g8 * 16 + 8); rl = *(const unsigned*)(pr0 + P_LRF + dir * 16 + g8 * 2);
    }
    for (int sc = 0; sc < 36; ++sc) {
        const bool lat = sc >= 4;
        const u32x4 cq = rq, ck = rk, cv = rv, cv2 = rv2; const unsigned cl_ = rl;
        if (sc + 1 < 36) {
            const bf16_t* pr1 = p.proj + (size_t)row_of(sc + 1, tc) * DINP;
            rq = *(const u32x4*)(pr1 + P_Q + h * 64 + g8 * 8); rk = *(const u32x4*)(pr1 + P_K + h * 64 + g8 * 8);
            rv = *(const u32x4*)(pr1 + P_V + h * 128 + g8 * 16); rv2 = *(const u32x4*)(pr1 + P_V + h * 128 + g8 * 16 + 8); rl = *(const unsigned*)(pr1 + P_LRF + dir * 16 + g8 * 2);
        }
        ((unsigned*)LR)[tc * 8 + g8] = cl_;
        __syncthreads();
        {
            u32x4 lv = (u32x4){0u, 0u, 0u, 0u};
            if (fq < 2) lv = *(const u32x4*)((const unsigned char*)LR + (tm * 16 + fr) * 32 + fq * 16);
            const bf16x8 lrf = __builtin_bit_cast(bf16x8, lv);
#pragma unroll
            for (int j = 0; j < 2; ++j) {
                f32x4 z = __builtin_amdgcn_mfma_f32_16x16x32_bf16(wfrag[j], lrf, (f32x4){0.f, 0.f, 0.f, 0.f}, 0, 0, 0);
                asm volatile("s_nop 15\n\ts_nop 15" : "+v"(z));
                z = z + bav[j];
                f32x4 o;
#pragma unroll
                for (int r = 0; r < 4; ++r) {
                    const float e = __builtin_amdgcn_exp2f(-fabsf(z[r]) * 1.4426950408889634f);
                    o[r] = (fminf(z[r], 0.0f) - __builtin_amdgcn_logf(1.0f + e) * 0.6931471805599453f) * (1.0f / 16.0f);
                }
                *(f32x4*)(LA + (tm * 16 + fr) * 64 + (pr * 2 + j) * 16 + fq * 4) = o;
            }
        }
        __syncthreads();
        {
            const int dk = tid & 63, sg = tid >> 6; float run = 0.f;
#pragma unroll
            for (int i = 0; i < 8; ++i) { run += LA[(sg * 8 + i) * 64 + dk]; LA[(sg * 8 + i) * 64 + dk] = run; }
            SEG[sg * 64 + dk] = run;
        }
        __syncthreads();
        if (tid < 64) {
            float run = 0.f;
#pragma unroll
            for (int s = 0; s < 8; ++s) { const float t = SEG[s * 64 + tid]; SEG[s * 64 + tid] = run; run += t; }
            CL[tid] = run; DEC[tid] = __builtin_amdgcn_exp2f(run * 1.4426950408889634f);
        }
        __syncthreads();
        {
            const float qv[8] = {bflo(cq[0]), bfhi(cq[0]), bflo(cq[1]), bfhi(cq[1]), bflo(cq[2]), bfhi(cq[2]), bflo(cq[3]), bfhi(cq[3])};
            const float kv[8] = {bflo(ck[0]), bfhi(ck[0]), bflo(ck[1]), bfhi(ck[1]), bflo(ck[2]), bfhi(ck[2]), bflo(ck[3]), bfhi(ck[3])};
            float qo[8], ko[8], ks[8];
#pragma unroll
            for (int i = 0; i < 8; ++i) {
                const int dk = g8 * 8 + i;
                const float cum = LA[tc * 64 + dk] + SEG[(tc >> 3) * 64 + dk];
                const float ec = __builtin_amdgcn_exp2f(cum * 1.4426950408889634f), en = __builtin_amdgcn_rcpf(ec), es = DEC[dk] * en;
                qo[i] = qv[i] * 0.125f * ec; ko[i] = kv[i] * en; ks[i] = kv[i] * es;
            }
#pragma unroll
            for (int i = 0; i < 8; i += 2) { const unsigned pk = cvt_pk_bf16(ks[i], ks[i + 1]);
                KsT[(g8 * 8 + i) * GL_LD + tc] = (bf16_t)(pk & 0xFFFFu); KsT[(g8 * 8 + i + 1) * GL_LD + tc] = (bf16_t)(pk >> 16); }
            *(u32x4*)(Qc + tc * GL_LD + g8 * 8) = (u32x4){cvt_pk_bf16(qo[0], qo[1]), cvt_pk_bf16(qo[2], qo[3]), cvt_pk_bf16(qo[4], qo[5]), cvt_pk_bf16(qo[6], qo[7])};
            *(u32x4*)(Ki + tc * GL_LD + g8 * 8) = (u32x4){cvt_pk_bf16(ko[0], ko[1]), cvt_pk_bf16(ko[2], ko[3]), cvt_pk_bf16(ko[4], ko[5]), cvt_pk_bf16(ko[6], ko[7])};
#pragma unroll
            for (int i = 0; i < 4; ++i) { VT[(g8 * 16 + 2 * i) * GL_LD + tc] = (bf16_t)(cv[i] & 0xFFFFu); VT[(g8 * 16 + 2 * i + 1) * GL_LD + tc] = (bf16_t)(cv[i] >> 16);
                                          VT[(g8 * 16 + 8 + 2 * i) * GL_LD + tc] = (bf16_t)(cv2[i] & 0xFFFFu); VT[(g8 * 16 + 9 + 2 * i) * GL_LD + tc] = (bf16_t)(cv2[i] >> 16); }
        }
        __syncthreads();
        f32x4 accO[4];
#pragma unroll
        for (int j = 0; j < 4; ++j) accO[j] = (f32x4){0.f, 0.f, 0.f, 0.f};
        bf16x8 yq[2];
        if (lat) {
#pragma unroll
            for (int kk = 0; kk < 2; ++kk) yq[kk] = *(const bf16x8*)(Qc + (tm * 16 + fr) * GL_LD + kk * 32 + fq * 8);
#pragma unroll
            for (int j = 0; j < 2; ++j) {
                const int ts = pr * 2 + j;
                f32x4 d = (f32x4){0.f, 0.f, 0.f, 0.f};
                if (ts <= tm) {
#pragma unroll
                    for (int kk = 0; kk < 2; ++kk) { const bf16x8 xk = *(const bf16x8*)(Ki + (ts * 16 + fr) * GL_LD + kk * 32 + fq * 8);
                        d = __builtin_amdgcn_mfma_f32_16x16x32_bf16(xk, yq[kk], d, 0, 0, 0); }
                    asm volatile("s_nop 15\n\ts_nop 15" : "+v"(d));
                    if (ts == tm) {
#pragma unroll
                        for (int r = 0; r < 4; ++r) d[r] = (fq * 4 + r <= fr) ? d[r] : 0.f;
                    }
                }
                *(u32x2*)(Pm + (tm * 16 + fr) * GL_LD + ts * 16 + fq * 4) = (u32x2){cvt_pk_bf16(d[0], d[1]), cvt_pk_bf16(d[2], d[3])};
            }
#pragma unroll
            for (int j = 0; j < 4; ++j) {
                const int tv = pr * 4 + j;
#pragma unroll
                for (int kk = 0; kk < 2; ++kk) { const bf16x8 xs = *(const bf16x8*)(ST + (tv * 16 + fr) * GL_LD + kk * 32 + fq * 8);
                    accO[j] = __builtin_amdgcn_mfma_f32_16x16x32_bf16(xs, yq[kk], accO[j], 0, 0, 0); }
            }
        }
        __syncthreads();
        {
            bf16x8 yp[2];
            if (lat) {
#pragma unroll
                for (int kk = 0; kk < 2; ++kk) yp[kk] = *(const bf16x8*)(Pm + (tm * 16 + fr) * GL_LD + kk * 32 + fq * 8);
            }
            const int orow = row_of(sc, tm * 16 + fr);
#pragma unroll
            for (int j = 0; j < 4; ++j) {
                const int tv = pr * 4 + j;
                bf16x8 xv[2];
#pragma unroll
                for (int kk = 0; kk < 2; ++kk) xv[kk] = *(const bf16x8*)(VT + (tv * 16 + fr) * GL_LD + kk * 32 + fq * 8);
                if (lat) {
#pragma unroll
                    for (int kk = 0; kk < 2; ++kk) accO[j] = __builtin_amdgcn_mfma_f32_16x16x32_bf16(xv[kk], yp[kk], accO[j], 0, 0, 0);
                    asm volatile("s_nop 15\n\ts_nop 15" : "+v"(accO[j]));
                    *(u32x2*)(p.of + ((size_t)dir * NL + orow) * 512 + h * 128 + tv * 16 + fq * 4) = (u32x2){cvt_pk_bf16(accO[j][0], accO[j][1]), cvt_pk_bf16(accO[j][2], accO[j][3])};
                }
                const f32x4 dc = *(const f32x4*)(DEC + tm * 16 + fq * 4);
                accS[j] = accS[j] * dc;
                asm volatile("s_nop 15\n\ts_nop 15" : "+v"(accS[j]));
#pragma unroll
                for (int kk = 0; kk < 2; ++kk) { const bf16x8 xks = *(const bf16x8*)(KsT + (tm * 16 + fr) * GL_LD + kk * 32 + fq * 8);
                    accS[j] = __builtin_amdgcn_mfma_f32_16x16x32_bf16(xks, xv[kk], accS[j], 0, 0, 0); }
                asm volatile("s_nop 15\n\ts_nop 15" : "+v"(accS[j]));
                *(u32x2*)(ST + (tv * 16 + fr) * GL_LD + tm * 16 + fq * 4) = (u32x2){cvt_pk_bf16(accS[j][0], accS[j][1]), cvt_pk_bf16(accS[j][2], accS[j][3])};
            }
        }
        __syncthreads();
    }
}

template <int dir> __device__ __forceinline__ void s5_wave_chain(const Params& p, int unit, unsigned char* wlds) {
    const int lane = threadIdx.x & 63, fr = lane & 15, fq = lane >> 4;
    const int g = (unit >> 1) & 31, b = unit >> 6;
    float* BU = (float*)wlds;
    bf16_t* XB = (bf16_t*)(wlds + 128 * 20 * 4);
    const float* lre = dir ? p.lam_re_b : p.lam_re_f;
    const float* lim = dir ? p.lam_im_b : p.lam_im_f;
    const float* lst = dir ? p.lstep_b : p.lstep_f;
    const float* cre = dir ? p.c_re_b : p.c_re_f;
    const float* cim = dir ? p.c_im_b : p.c_im_f;
    float a_re, a_im;
    {
        const float lam_re = lre[g * 64 + lane], lam_im = lim[g * 64 + lane];
        const float step = expf(lst[g]);
        const float mag = expf(lam_re * step);
        a_re = mag * cosf(lam_im * step); a_im = mag * sinf(lam_im * step);
    }
    bf16x8 yb[2][4];
#pragma unroll
    for (int st = 0; st < 4; ++st) {
        const int pp = st * 16 + fr;
        const float lam_re = lre[g * 64 + pp], lam_im = lim[g * 64 + pp];
        const float step = expf(lst[g]);
        const float mag = expf(lam_re * step);
        const float ar = mag * cosf(lam_im * step), ai = mag * sinf(lam_im * step);
        const float den = lam_re * lam_re + lam_im * lam_im;
        const float f_re = ((ar - 1.0f) * lam_re + ai * lam_im) / den;
        const float f_im = (ai * lam_re - (ar - 1.0f) * lam_im) / den;
        u32x4 wr_ = (u32x4){0u, 0u, 0u, 0u}, wi_ = wr_;
        if (fq < 2) {
            float vr[8], vi[8];
#pragma unroll
            for (int j = 0; j < 8; ++j) { const float br = p.b_re[(g * 64 + pp) * 16 + fq * 8 + j], bi = p.b_im[(g * 64 + pp) * 16 + fq * 8 + j];
                vr[j] = f_re * br - f_im * bi; vi[j] = f_re * bi + f_im * br; }
            wr_ = (u32x4){cvt_pk_bf16(vr[0], vr[1]), cvt_pk_bf16(vr[2], vr[3]), cvt_pk_bf16(vr[4], vr[5]), cvt_pk_bf16(vr[6], vr[7])};
            wi_ = (u32x4){cvt_pk_bf16(vi[0], vi[1]), cvt_pk_bf16(vi[2], vi[3]), cvt_pk_bf16(vi[4], vi[5]), cvt_pk_bf16(vi[6], vi[7])};
        }
        yb[0][st] = __builtin_bit_cast(bf16x8, wr_); yb[1][st] = __builtin_bit_cast(bf16x8, wi_);
    }
    bf16x8 cb[4];
#pragma unroll
    for (int kk = 0; kk < 4; ++kk) {
        float v[8];
#pragma unroll
        for (int j = 0; j < 8; ++j) { const int s = kk * 16 + fq * 4 + (j >> 1);
            v[j] = (j & 1) ? -cim[(g * 16 + fr) * 64 + s] : cre[(g * 16 + fr) * 64 + s]; }
        cb[kk] = __builtin_bit_cast(bf16x8, (u32x4){cvt_pk_bf16(v[0], v[1]), cvt_pk_bf16(v[2], v[3]), cvt_pk_bf16(v[4], v[5]), cvt_pk_bf16(v[6], v[7])});
    }
    auto crow = [&](int n) -> int { return (n < 16) ? (S5_ROWS - 256 + b * 16 + (dir ? 15 - n : n)) : (b * 128 + (dir ? 127 - (n - 16) : (n - 16))); };
    const bf16_t* Agg = p.Ag + (size_t)g * S5_ROWS * 512;
    const int tokidx = dir ? 15 - fr : fr;
    u32x4 rr[4];
#pragma unroll
    for (int k = 0; k < 4; ++k) { rr[k] = (u32x4){0u, 0u, 0u, 0u}; if (fq < 2) rr[k] = *(const u32x4*)(Agg + (size_t)crow(k) * 512 + tokidx * 16 + fq * 8); }
    f32x2_t X = {0.f, 0.f};
    const f32x2_t Are = {a_re, a_re}, Aimn = {-a_im, a_im};
    for (int i = lane; i < S5_WLDS / 4; i += 64) ((unsigned*)wlds)[i] = 0u;
    asm volatile("s_waitcnt lgkmcnt(0)" ::: "memory");
    for (int n4 = 0; n4 < 144; n4 += 4) {
#pragma unroll
      for (int k4 = 0; k4 < 4; ++k4) {
        const int n = n4 + k4;
        const bf16x8 xa = __builtin_bit_cast(bf16x8, rr[k4]);
        if (n + 4 < 144 && fq < 2) rr[k4] = *(const u32x4*)(Agg + (size_t)crow(n + 4) * 512 + tokidx * 16 + fq * 8);
        f32x4 d[2][4];
#pragma unroll
        for (int part = 0; part < 2; ++part)
#pragma unroll
            for (int st = 0; st < 4; ++st)
                d[part][st] = __builtin_amdgcn_mfma_f32_16x16x32_bf16(xa, yb[part][st], (f32x4){0.f, 0.f, 0.f, 0.f}, 0, 0, 0);
        asm volatile("s_nop 15\n\ts_nop 15" : "+v"(d[0][0]), "+v"(d[0][1]), "+v"(d[0][2]), "+v"(d[0][3]), "+v"(d[1][0]), "+v"(d[1][1]), "+v"(d[1][2]), "+v"(d[1][3]));
#pragma unroll
        for (int part = 0; part < 2; ++part)
#pragma unroll
            for (int st = 0; st < 4; ++st) if (part == 0) {
                float* bw = BU + (st * 16 + fr) * 36 + fq * 8;
                *(f32x4*)bw = (f32x4){d[0][st][0], d[1][st][0], d[0][st][1], d[1][st][1]};
                *(f32x4*)(bw + 4) = (f32x4){d[0][st][2], d[1][st][2], d[0][st][3], d[1][st][3]};
            }
        asm volatile("s_waitcnt lgkmcnt(0)" ::: "memory");
        {
            f32x4 b4[8];
#pragma unroll
            for (int q = 0; q < 8; ++q) b4[q] = *(const f32x4*)(BU + lane * 36 + q * 4);
#pragma unroll
            for (int t = 0; t < 16; ++t) {
                const f32x2_t Bt_ = {b4[t >> 1][(t & 1) * 2], b4[t >> 1][(t & 1) * 2 + 1]};
                const f32x2_t T_ = __builtin_elementwise_fma(Are, X, Bt_);
                f32x2_t Xs_ = {X[1], X[0]}; asm volatile("" : "+v"(Xs_));
                X = __builtin_elementwise_fma(Aimn, Xs_, T_);
                ((unsigned*)XB)[t * 68 + lane] = cvt_pk_bf16(X[0], X[1]);
            }
        }
        asm volatile("s_waitcnt lgkmcnt(0)" ::: "memory");
        if (n >= 16) {
            f32x4 y = (f32x4){0.f, 0.f, 0.f, 0.f};
#pragma unroll
            for (int kk = 0; kk < 4; ++kk) {
                const bf16x8 xf = *(const bf16x8*)(XB + fr * 136 + kk * 32 + fq * 8);
                y = __builtin_amdgcn_mfma_f32_16x16x32_bf16(xf, cb[kk], y, 0, 0, 0);
            }
            asm volatile("s_nop 15\n\ts_nop 15" : "+v"(y));
            const int row0 = crow(n) * 16;
#pragma unroll
            for (int r = 0; r < 4; ++r) { const int sp = fq * 4 + r, tk = dir ? 15 - sp : sp;
                p.yf[((size_t)dir * NL + row0 + tk) * 512 + g * 16 + fr] = f2bf(y[r]); }
        }
        asm volatile("s_waitcnt lgkmcnt(0)" ::: "memory");
      }
    }
}

__device__ __forceinline__ void phase_scans(const Params& p, float* lds) {
    const int bid = blockIdx.x, nb = gridDim.x;
    if (nb >= 256) {
        if (bid < 128) gla_chunk_unit(p, (unsigned char*)lds, bid);
        else {
            const int w = __builtin_amdgcn_readfirstlane(threadIdx.x >> 6), c = (bid - 128) * 8 + w;
            if (c & 1) s5_wave_chain<1>(p, c, (unsigned char*)lds + w * S5_WLDS); else s5_wave_chain<0>(p, c, (unsigned char*)lds + w * S5_WLDS);
        }
    } else {
        for (int u = bid; u < 128; u += nb) gla_chunk_unit(p, (unsigned char*)lds, u);
        __syncthreads();
        const int w = __builtin_amdgcn_readfirstlane(threadIdx.x >> 6);
        for (int c = bid * 8 + w; c < 1024; c += nb * 8) { if (c & 1) s5_wave_chain<1>(p, c, (unsigned char*)lds + w * S5_WLDS); else s5_wave_chain<0>(p, c, (unsigned char*)lds + w * S5_WLDS); }
    }
}

__device__ __forceinline__ void lr_columns(const Params& p, unsigned char* lds8) {
    const int tid = threadIdx.x, lane = tid & 63, w = tid >> 6, fr = lane & 15, fq = lane >> 4;
    bf16_t* W = (bf16_t*)lds8;
    const bool split = gridDim.x == 256;
    if (split && blockIdx.x < 128) return;
    const int wg = split ? blockIdx.x - 128 : blockIdx.x, nwg = split ? 128 : gridDim.x;
    __syncthreads();
    for (int i = tid; i < 32 * 128; i += NT) { const int n = i >> 7, c = i & 127; *(u32x4*)(W + n * 1032 + c * 8) = *(const u32x4*)(p.w_inT + (size_t)(WC_LR + n) * DM + c * 8); }
    __syncthreads();
    for (int t = wg * NWAVES + w; t < NR / 16; t += nwg * NWAVES) {
        const int tok0 = t * 16;
        f32x4 d0 = (f32x4){0.f, 0.f, 0.f, 0.f}, d1 = d0;
        const bf16_t* arow = p.hx + (size_t)(tok0 + fr) * DM + fq * 8;
#pragma unroll 16
        for (int ks = 0; ks < 32; ++ks) {
            const bf16x8 a = *(const bf16x8*)(arow + ks * 32);
            const bf16x8 b0 = *(const bf16x8*)(W + fr * 1032 + ks * 32 + fq * 8), b1 = *(const bf16x8*)(W + (16 + fr) * 1032 + ks * 32 + fq * 8);
            d0 = __builtin_amdgcn_mfma_f32_16x16x32_bf16(b0, a, d0, 0, 0, 0);
            d1 = __builtin_amdgcn_mfma_f32_16x16x32_bf16(b1, a, d1, 0, 0, 0);
        }
        asm volatile("s_nop 15\n\ts_nop 15" : "+v"(d0), "+v"(d1));
        bf16_t* o = p.proj + (size_t)(tok0 + fr) * DINP + P_LRF + fq * 4;
        *(u32x2*)o = (u32x2){cvt_pk_bf16(d0[0], d0[1]), cvt_pk_bf16(d0[2], d0[3])};
        *(u32x2*)(o + 16) = (u32x2){cvt_pk_bf16(d1[0], d1[1]), cvt_pk_bf16(d1[2], d1[3])};
    }
    __syncthreads();
}

__device__ __forceinline__ void phase_mix(const Params& p) {
    const int lane = threadIdx.x & 63, wave = threadIdx.x >> 6;
    const int stride = gridDim.x * NWAVES;
    int r = blockIdx.x * NWAVES + wave;
    if (r >= NL) return;
    const float4 gn0 = *(const float4*)(p.gnorm_g + (lane & 15) * 8), gn1 = *(const float4*)(p.gnorm_g + (lane & 15) * 8 + 4);
    const float4 sd0 = *(const float4*)(p.s5_d + lane * 8), sd1 = *(const float4*)(p.s5_d + lane * 8 + 4);
    const float gn[8] = {gn0.x, gn0.y, gn0.z, gn0.w, gn1.x, gn1.y, gn1.z, gn1.w}, sd[8] = {sd0.x, sd0.y, sd0.z, sd0.w, sd1.x, sd1.y, sd1.z, sd1.w};
    u32x4 c[6], n[6];
#define MIX_LOAD(dst, row) do { const size_t _r = (size_t)(row); \
        dst[0] = *(const u32x4*)(p.of + _r * 512 + lane * 8); dst[1] = *(const u32x4*)(p.of + ((size_t)NL + _r) * 512 + lane * 8); \
        dst[2] = *(const u32x4*)(p.proj + _r * DINP + P_G + lane * 8); \
        dst[3] = *(const u32x4*)(p.yf + _r * 512 + lane * 8); dst[4] = *(const u32x4*)(p.yf + ((size_t)NL + _r) * 512 + lane * 8); \
        dst[5] = *(const u32x4*)(p.Ag + ((size_t)(lane >> 1) * S5_ROWS + (_r >> 4)) * 512 + (_r & 15) * 16 + (lane & 1) * 8); } while (0)
    MIX_LOAD(c, r);
    for (;;) {
        const int rn = r + stride; const bool has = rn < NL;
        if (has) MIX_LOAD(n, rn);
        float o[8], g[8]; float ss = 0.f;
#pragma unroll
        for (int q = 0; q < 4; ++q) {
            o[2 * q] = bflo(c[0][q]) + bflo(c[1][q]); o[2 * q + 1] = bfhi(c[0][q]) + bfhi(c[1][q]);
            g[2 * q] = bflo(c[2][q]); g[2 * q + 1] = bfhi(c[2][q]);
            ss += o[2 * q] * o[2 * q] + o[2 * q + 1] * o[2 * q + 1];
        }
        ss += __shfl_xor(ss, 1); ss += __shfl_xor(ss, 2); ss += __shfl_xor(ss, 4); ss += __shfl_xor(ss, 8);
        const float rstd = rsqrtf(ss * (1.0f / 128.0f) + EPS);
        u32x4 mo, zo;
#pragma unroll
        for (int q = 0; q < 4; ++q) {
            const float m0 = o[2 * q] * rstd * gn[2 * q] * silu_fast(g[2 * q]), m1 = o[2 * q + 1] * rstd * gn[2 * q + 1] * silu_fast(g[2 * q + 1]);
            mo[q] = cvt_pk_bf16(m0, m1);
            const float y0 = bflo(c[3][q]) + bflo(c[4][q]) + sd[2 * q] * bflo(c[5][q]), y1 = bfhi(c[3][q]) + bfhi(c[4][q]) + sd[2 * q + 1] * bfhi(c[5][q]);
            zo[q] = cvt_pk_bf16(gelu_tanh_fast(y0), gelu_tanh_fast(y1));
        }
        *(u32x4*)(p.mix + (size_t)r * DM + lane * 8) = mo;
        *(u32x4*)(p.z + (size_t)r * 512 + lane * 8) = zo;
        if (!has) break;
        r = rn;
#pragma unroll
        for (int q = 0; q < 6; ++q) c[q] = n[q];
    }
#undef MIX_LOAD
}

__device__ __forceinline__ void phase_route(const Params& p, int* lm) {
    int* hist = lm; int* gbase = lm + 256; int* st_e = lm + 512; int* st_r = st_e + 1024; float* st_w = (float*)(st_r + 1024);
    const int tid = threadIdx.x;
    const int lane = threadIdx.x & 63, wave = threadIdx.x >> 6;
    const float* scores = p.scores;
    const float4 rb = *(const float4*)(p.router_b + lane * 4);
    for (int tb = blockIdx.x * 128; tb < NL; tb += gridDim.x * 128) {
    __syncthreads();
    if (tid < 256) hist[tid] = 0;
    __syncthreads();
    float4 scn = *(const float4*)(scores + (size_t)(tb + wave) * 256 + lane * 4);
    for (int tl = wave; tl < 128; tl += NWAVES) {
        const int t = tb + tl;
        const float4 sc4 = scn;
        if (tl + NWAVES < 128) scn = *(const float4*)(scores + (size_t)(t + NWAVES) * 256 + lane * 4);
        const float sc[4] = {sc4.x, sc4.y, sc4.z, sc4.w};
        float bv[4] = {sc4.x + rb.x, sc4.y + rb.y, sc4.z + rb.z, sc4.w + rb.w};
        float m1 = -INFINITY, m2 = -INFINITY;
#pragma unroll
        for (int j = 0; j < 4; ++j) { const float v = bv[j]; if (v > m1) { m2 = m1; m1 = v; } else if (v > m2) m2 = v; }
#pragma unroll
        for (int o = 1; o < 8; o <<= 1) {
            const float o1 = __shfl_xor(m1, o), o2 = __shfl_xor(m2, o);
            const float n1 = fmaxf(m1, o1), n2 = fmaxf(fminf(m1, o1), fmaxf(m2, o2));
            m1 = n1; m2 = n2;
        }
        const float gs = m1 + m2;
        const int myg = lane >> 3;
        int rank = 0;
#pragma unroll
        for (int j = 0; j < 8; ++j) { const float og = __shfl(gs, j * 8); rank += (og > gs || (og == gs && j < myg)) ? 1 : 0; }
        const bool sel = rank < 4;
#pragma unroll
        for (int j = 0; j < 4; ++j) if (!sel) bv[j] = -INFINITY;
        int my_e = -1; float my_s = 0.f; float ssum = 0.f;
        unsigned key[4];
#pragma unroll
        for (int j = 0; j < 4; ++j) key[j] = sel ? ((__float_as_uint(bv[j] + 1.0f) & 0xFFFFFF00u) | (unsigned)(255 - (lane * 4 + j))) : 0u;
#pragma unroll
        for (int k = 0; k < TOPK; ++k) {
            unsigned wk = max(max(key[0], key[1]), max(key[2], key[3]));
#pragma unroll
            for (int o = 1; o < 64; o <<= 1) wk = max(wk, (unsigned)__shfl_xor((int)wk, o));
            const int be = 255 - (int)(wk & 255u);
            const int bj = be & 3;
            const float mine = (bj == 0) ? sc[0] : (bj == 1) ? sc[1] : (bj == 2) ? sc[2] : sc[3];
            const float bs = __shfl(mine, be >> 2);
            if ((be >> 2) == lane) {
#pragma unroll
                for (int j = 0; j < 4; ++j) if (bj == j) key[j] = 0u;
            }
            ssum += bs;
            if (lane == k) { my_e = be; my_s = bs; }
        }
        if (lane < TOPK) {
            st_e[tl * 8 + lane] = my_e; st_r[tl * 8 + lane] = atomicAdd(&hist[my_e], 1); st_w[tl * 8 + lane] = my_s / ssum * 2.5f;
        }
    }
    __syncthreads();
    if (tid < 256) { const int h = hist[tid]; gbase[tid] = h ? atomicAdd(&p.cnt[tid], h) : 0; }
    __syncthreads();
    for (int i = tid; i < 1024; i += NT) {
        const int e = st_e[i], pos = gbase[e] + st_r[i], t = tb + (i >> 3);
        p.ltok[(size_t)e * CAP + pos] = (unsigned short)t;
        p.tinfo[(size_t)tb * 8 + i] = ((unsigned)e << 16) | (unsigned)pos;
        p.tw[(size_t)tb * 8 + i] = st_w[i];
    }
    }
}

__device__ __forceinline__ void expert_tables(const Params& p, int* cntl, int* offs, int* toff, int ncolt) {
    const int tid = threadIdx.x;
    __syncthreads();
    if (tid < 256) cntl[tid] = p.cnt[tid];
    __syncthreads();
    if (tid < 256) {
        int s = 0, ts = 0;
        for (int e = 0; e < tid; ++e) { const int c = cntl[e]; s += c; ts += ((c + 255) >> 8) * ncolt; }
        offs[tid] = s; toff[tid] = ts;
        if (tid == 255) { const int c = cntl[255]; offs[256] = s + c; toff[256] = ts + ((c + 255) >> 8) * ncolt; }
    }
    __syncthreads();
}

__device__ __forceinline__ void phase_final(const Params& p, int* lmisc) {
    const int lane = threadIdx.x & 63, wave = threadIdx.x >> 6;
    int* cntl = lmisc; int* offs = lmisc + 256; int* toff = offs + 260;
    expert_tables(p, cntl, offs, toff, 1);
    const int stride = gridDim.x * NWAVES, rbase = blockIdx.x * NWAVES + wave;
    unsigned info_n = 0u; float wk_n = 0.f;
    u32x4 ny[8], nsh, nx[2]; float nwk = 0.f;
    if (rbase < NL && lane < 8) { info_n = p.tinfo[(size_t)rbase * 8 + lane]; wk_n = p.tw[(size_t)rbase * 8 + lane]; }
#define FIN_ISSUE(row) do { \
        _Pragma("unroll") for (int k = 0; k < 8; ++k) { const unsigned inf_ = __shfl(info_n, k); \
            ny[k] = *(const u32x4*)((const unsigned char*)p.yb + (size_t)(offs[inf_ >> 16] + (int)(inf_ & 0xFFFFu)) * DM + lane * 16); } \
        nsh = *(const u32x4*)((const unsigned char*)p.hx + (size_t)(row) * DM + lane * 16); \
        nx[0] = *(const u32x4*)(p.yf + (size_t)(row) * DM + lane * 16); nx[1] = *(const u32x4*)(p.yf + (size_t)(row) * DM + lane * 16 + 8); \
        nwk = wk_n; } while (0)
    if (rbase < NL) {
        FIN_ISSUE(rbase);
        const int r1 = rbase + stride;
        if (r1 < NL && lane < 8) { info_n = p.tinfo[(size_t)r1 * 8 + lane]; wk_n = p.tw[(size_t)r1 * 8 + lane]; }
    }
    for (int r = rbase; r < NL; r += stride) {
        const int b = r / SEQ;
        const float* g2 = p.modv + b * 6144 + 5120;
        u32x4 cy[8], csh, cx[2]; const float wk = nwk;
#pragma unroll
        for (int k = 0; k < 8; ++k) cy[k] = ny[k];
        csh = nsh; cx[0] = nx[0]; cx[1] = nx[1];
        {
            const int rn = r + stride;
            if (rn < NL) {
                FIN_ISSUE(rn);
                const int rn2 = rn + stride;
                if (rn2 < NL && lane < 8) { info_n = p.tinfo[(size_t)rn2 * 8 + lane]; wk_n = p.tw[(size_t)rn2 * 8 + lane]; }
            }
        }
        float a[16];
#pragma unroll
        for (int i = 0; i < 16; ++i) a[i] = 0.f;
#pragma unroll
        for (int k = 0; k < 8; ++k) {
            const float w = __shfl(wk, k) * (1.0f / YB_SCALE);
            const u32x4 v = cy[k];
#pragma unroll
            for (int q = 0; q < 4; ++q) {
                const f32x2_t lo = __builtin_amdgcn_cvt_pk_f32_fp8((int)v[q], false), hi = __builtin_amdgcn_cvt_pk_f32_fp8((int)v[q], true);
                a[4 * q] = fmaf(w, lo[0], a[4 * q]); a[4 * q + 1] = fmaf(w, lo[1], a[4 * q + 1]); a[4 * q + 2] = fmaf(w, hi[0], a[4 * q + 2]); a[4 * q + 3] = fmaf(w, hi[1], a[4 * q + 3]);
            }
        }
        {
            const u32x4 v = csh;
#pragma unroll
            for (int q = 0; q < 4; ++q) {
                const f32x2_t lo = __builtin_amdgcn_cvt_pk_f32_fp8((int)v[q], false), hi = __builtin_amdgcn_cvt_pk_f32_fp8((int)v[q], true);
                a[4 * q] = fmaf(0.125f, lo[0], a[4 * q]); a[4 * q + 1] = fmaf(0.125f, lo[1], a[4 * q + 1]); a[4 * q + 2] = fmaf(0.125f, hi[0], a[4 * q + 2]); a[4 * q + 3] = fmaf(0.125f, hi[1], a[4 * q + 3]);
            }
        }
        float ss = 0.f;
#pragma unroll
        for (int h = 0; h < 4; ++h) {
            const int col = lane * 16 + 4 * h;
            const unsigned xw0 = cx[h >> 1][(h & 1) * 2], xw1 = cx[h >> 1][(h & 1) * 2 + 1]; const float4 xv = make_float4(bflo(xw0), bfhi(xw0), bflo(xw1), bfhi(xw1)), gg = *(const float4*)(g2 + col);
            float* aa = a + 4 * h;
            aa[0] = xv.x + gg.x * aa[0]; aa[1] = xv.y + gg.y * aa[1]; aa[2] = xv.z + gg.z * aa[2]; aa[3] = xv.w + gg.w * aa[3];
            ss += aa[0] * aa[0] + aa[1] * aa[1] + aa[2] * aa[2] + aa[3] * aa[3];
        }
        ss = wave_sum(ss);
        const float rstd = rsqrtf(ss * (1.0f / DM) + EPS);
#pragma unroll
        for (int h = 0; h < 4; ++h) {
            const int col = lane * 16 + 4 * h;
            const float4 gg = *(const float4*)(p.fnorm_g + col);
            const float* aa = a + 4 * h;
            float4 o; o.x = aa[0] * rstd * gg.x; o.y = aa[1] * rstd * gg.y; o.z = aa[2] * rstd * gg.z; o.w = aa[3] * rstd * gg.w;
            *(float4*)(p.out + (size_t)r * DM + col) = o;
        }
    }
#undef FIN_ISSUE
}

__global__ void __launch_bounds__(NT, 2) mega(Params p) {
    extern __shared__ __attribute__((aligned(16))) unsigned char lds_raw[];
    float* lds = (float*)lds_raw;
    LAS unsigned char* ldsl = (LAS unsigned char*)lds_raw;
    float* lmisc = (float*)(lds_raw + STAGE_BYTES);
    volatile LAS unsigned* xbw = (volatile LAS unsigned*)(ldsl + LDS_BYTES - 16);
    if (threadIdx.x == 0) { xbw[0] = 0u; xbw[1] = 0u; xbw[2] = 0u; xbw[3] = 0u; }
    __syncthreads();
    XcdBarrier bar; bar.bar = p.bar; bar.x = 0; bar.st = xbw;
    const bool fused = (p.ph_hi - p.ph_lo) > 1;
    if (fused) bar = xcd_barrier_post(p.bar, xbw);
    const int bid = blockIdx.x, nb = gridDim.x;
#define PH(i) (p.ph_lo <= (i) && (i) < p.ph_hi)
#define SEAM(i) if (fused && p.ph_lo <= (i) && (i) + 1 < p.ph_hi) xcd_barrier(bar)

    if (PH(0)) phase_prologue(p, lds, 0);
    SEAM(0);
    if (PH(1)) { phase_norm_mod(p, 0); __syncthreads(); phase_prologue(p, lds, 1); }
    SEAM(1);
    if (PH(2)) {
        g8::DenseSched S; S.init(p.hx, p.w_inT, DM * 2, DM * 2, NR, 2048, nb, bid);
        g8::EpiProj E; E.O = p.proj; E.AG = p.Ag;
        g8::gemm_phase<g8::EpiProj, g8::DenseSched, 0>(ldsl, DM, DM * 2, DM * 2, S, E);
        lr_columns(p, (unsigned char*)lds);
    }
    SEAM(2);
    if (PH(3)) phase_scans(p, lds);
    SEAM(3);
    if (PH(4)) phase_mix(p);
    SEAM(4);
    if (PH(5)) {
        g8::DenseSched S; S.init(p.z, p.gluT, 512 * 2, 512 * 2, NL, 512, nb, bid);
        g8::EpiGlu E; E.Z = p.z; E.MIX = p.mix; E.bias = p.glu_b;
        g8::gemm_phase<g8::EpiGlu, g8::DenseSched, 0>(ldsl, 512, 512 * 2, 512 * 2, S, E);
    }
    SEAM(5);
    if (PH(6)) {
        g8::DenseSched S; S.init(p.mix, p.w_outT, DM * 2, DM * 2, NL, DM, nb, bid);
        g8::EpiOut E; E.X = p.x; E.X1 = p.yf; E.modv = p.modv;
        g8::gemm_phase<g8::EpiOut, g8::DenseSched, 0>(ldsl, DM, DM * 2, DM * 2, S, E);
    }
    SEAM(6);
    if (PH(7)) phase_norm_mod(p, 1);
    SEAM(7);
    if (PH(8)) {
        {
            g8::DenseSched S; S.init(p.hx, p.routerT3, DM * 2, 3072 * 2, NL, 256, nb, bid);
            g8::EpiScores E; E.O = p.scores;
            g8::gemm_phase<g8::EpiScores, g8::DenseSched, 0>(ldsl, DM, DM * 2, 3072 * 2, S, E);
        }
        __syncthreads();
        {
            g8::DenseSched S;
            S.init(p.hx, p.shguT, DM * 2, DM * 2, NL, 512, nb, bid);
            g8::EpiGateUp E; E.O = p.shhid;
            g8::gemm_phase<g8::EpiGateUp, g8::DenseSched, 0>(ldsl, DM, DM * 2, DM * 2, S, E);
        }
    }
    SEAM(8);
    if (PH(9)) phase_route(p, (int*)lmisc);
    SEAM(9);
    if (PH(10)) {
        int* cntl = (int*)lmisc; int* offs = cntl + 256; int* toff = offs + 260;
        expert_tables(p, cntl, offs, toff, 2);
        {
            g8::ExpertSched S;
            S.toff = (const LAS int*)toff; S.offs = (const LAS int*)offs; S.cntl = (const LAS int*)cntl;
            S.gbase = (const char*)p.of; S.lda = DM; S.ltok = p.ltok; S.Ad = nullptr;
            S.Bt = (const char*)p.eguT; S.bexp = (size_t)512 * DM; S.ldb = DM;
            S.ncolt = 2; S.G = nb; S.c = (bid & 7) * (nb >> 3) + (bid >> 3); S.total = __builtin_amdgcn_readfirstlane(toff[256]);
            g8::EpiExpGU E; E.O = p.hid; E.offs = S.offs; E.cntl = S.cntl;
            g8::gemm_phase<g8::EpiExpGU, g8::ExpertSched, 0, true, 4>(ldsl, DM / 2, DM, DM, S, E);
        }
    }
    SEAM(10);
    if (PH(11)) {
        int* cntl = (int*)lmisc; int* offs = cntl + 256; int* toff = offs + 260;
        expert_tables(p, cntl, offs, toff, 4);
        g8::ExpertSched S;
        S.toff = (const LAS int*)toff; S.offs = (const LAS int*)offs; S.cntl = (const LAS int*)cntl;
        S.gbase = nullptr; S.lda = 256; S.ltok = p.ltok; S.Ad = (const char*)p.hid;
        S.Bt = (const char*)p.edT; S.bexp = (size_t)DM * 256; S.ldb = 256;
        S.ncolt = 4; S.G = nb; S.c = (bid & 7) * (nb >> 3) + (bid >> 3); S.total = __builtin_amdgcn_readfirstlane(toff[256]);
        g8::EpiExpDown E; E.O = p.yb; E.offs = S.offs; E.cntl = S.cntl;
        g8::gemm_phase<g8::EpiExpDown, g8::ExpertSched, 0, false, 2>(ldsl, 128, 256, 256, S, E);
        __syncthreads();
        {
            g8::DenseSched S2; S2.init(p.shhid, p.shdT, 256, 256, NL, DM, nb, bid);
            g8::EpiBf16 E2; E2.O = p.hx;
            g8::gemm_phase<g8::EpiBf16, g8::DenseSched, 0, false, 4>(ldsl, 128, 256, 256, S2, E2);
        }
    }
    SEAM(11);
    if (PH(12)) phase_final(p, (int*)lmisc);
}

extern "C" void kernel_launch(void* const* d_in, const int* in_sizes, int n_in, void* d_out, int out_size, void* d_ws, size_t ws_size,
                              hipStream_t stream) {
    static int grid = 0;
    if (grid == 0) {
        int dev = 0, cus = 0, per_cu = 0;
        (void)hipGetDevice(&dev);
        (void)hipDeviceGetAttribute(&cus, hipDeviceAttributeMultiprocessorCount, dev);
        (void)hipFuncSetAttribute((const void*)mega, hipFuncAttributeMaxDynamicSharedMemorySize, LDS_BYTES);
        (void)hipOccupancyMaxActiveBlocksPerMultiprocessor(&per_cu, (const void*)mega, NT, LDS_BYTES);
        (void)hipGetLastError();
        grid = cus;
    }
    size_t off = 0;
    auto carve = [&](size_t bytes) { size_t o = off; off += (bytes + 255) & ~(size_t)255; return (char*)d_ws + o; };
    Params p{};
    const float** ins = (const float**)&p;
    for (int i = 0; i < 39; ++i) ins[i] = (const float*)d_in[i];
    p.out = (float*)d_out;
    p.bar = (unsigned*)carve(XCD_BAR_WORDS * 4);
    p.cnt = (int*)carve(256 * 4);
    const size_t zero_bytes = off;
    p.modv = (float*)carve((size_t)17 * 6144 * 4);
    p.w_inT = (bf16_t*)carve((size_t)2304 * DM * 2);
    p.w_outT = (bf16_t*)carve((size_t)DM * DM * 2);
    p.gluT = (bf16_t*)carve((size_t)512 * 512 * 2);
    p.routerT3 = (bf16_t*)carve((size_t)256 * 3072 * 2);
    p.shguT = (bf16_t*)carve((size_t)512 * DM * 2);
    p.shdT = (bf16_t*)carve((size_t)DM * 256 * 2);
    p.hx = (bf16_t*)carve((size_t)NL * 2048 * 2);
    p.scores = (float*)carve((size_t)NL * 256 * 4);
    p.shhid = (bf16_t*)carve((size_t)NL * 256 * 2);
    p.ltok = (unsigned short*)carve((size_t)NE * CAP * 2);
    p.tinfo = (unsigned*)carve((size_t)NL * 8 * 4);
    p.tw = (float*)carve((size_t)NL * 8 * 4);
    p.edT = (bf16_t*)carve((size_t)NE * DM * 256 * 2);
    p.eguT = (bf16_t*)carve((size_t)NE * 512 * DM * 2);
    char* arena = carve(0);
    p.yb = (bf16_t*)p.eguT;
    {
        size_t a = 0;
        auto acarve = [&](size_t bytes) { size_t o = a; a += (bytes + 255) & ~(size_t)255; return arena + o; };
        p.proj = (bf16_t*)acarve((size_t)NR * DINP * 2);
        p.of = (bf16_t*)acarve((size_t)2 * NL * 512 * 2);
        p.yf = (bf16_t*)acarve((size_t)2 * NL * 512 * 2);
        p.Ag = (bf16_t*)acarve((size_t)32 * S5_ROWS * 512 * 2);
        p.mix = (bf16_t*)acarve((size_t)NL * DM * 2);
        p.z = (bf16_t*)acarve((size_t)NL * 512 * 2);
        const size_t early = a;
        const size_t yb_tail = (size_t)(NL * 8 + 1) * DM * 2 - (size_t)NE * 512 * DM * 2;
        p.hid = (bf16_t*)(arena + ((yb_tail + 255) & ~(size_t)255));
        const size_t late = ((yb_tail + 255) & ~(size_t)255) + (size_t)(NL * 8 + 256) * 256 * 2;
        (void)carve(early > late ? early : late);
    }
    if (off > ws_size) { fprintf(stderr, "kernel_launch: workspace too small: need %zu have %zu\n", off, ws_size); return; }
    (void)hipMemsetAsync(d_ws, 0, zero_bytes, stream);
#if FUSED
    p.ph_lo = 0; p.ph_hi = N_PHASES;
    hipLaunchKernelGGL(mega, dim3(grid), dim3(NT), LDS_BYTES, stream, p);
#else
    for (int i = 0; i < N_PHASES; ++i) {
        p.ph_lo = i; p.ph_hi = i + 1;
        hipLaunchKernelGGL(mega, dim3(grid), dim3(NT), LDS_BYTES, stream, p);
    }
#endif
}
```
